# Optimizing an MI355X kernel written in HIP

```python
import math
import jax, jax.numpy as jnp
from jax import lax
import numpy as np


D_MODEL = 1024
BATCH = 2
SEQ = 8192
DEPTH = 4

CONV_WIDTH = D_MODEL // 2
CONV_K = 3
N_HEADS = 4
HEAD_DIM = D_MODEL // 16
V_DIM = 2 * HEAD_DIM
ATTN_WIDTH = N_HEADS * V_DIM
N_BRANCH = 2
D_FF = 4 * D_MODEL
Q_BLOCK = 128
EPS = 1e-6
IN_WIDTH = 3 * CONV_WIDTH + 3 * ATTN_WIDTH + N_BRANCH * D_MODEL

kernel_name = "hybrid_shortconv_diffattn_alibi_encoder"


def rmsnorm(x, g):
    xf = x.astype(jnp.float32)
    y = xf * lax.rsqrt(jnp.mean(xf * xf, axis=-1, keepdims=True) + EPS)
    return (y * g.astype(jnp.float32)).astype(x.dtype)


def alibi_slopes():
    i = jnp.arange(1, N_HEADS + 1, dtype=jnp.float32)
    return jnp.exp2(-8.0 * i / N_HEADS)


def diff_attention(q1, q2, k1, k2, v, lam):
    b, h, s, _ = q1.shape
    nb = s // Q_BLOCK
    scale = HEAD_DIM ** -0.5
    slopes = alibi_slopes()
    kpos = jnp.arange(s, dtype=jnp.float32)

    def to_blocks(q):
        return q.reshape(b, h, nb, Q_BLOCK, HEAD_DIM).transpose(2, 0, 1, 3, 4)

    starts = jnp.arange(nb, dtype=jnp.int32) * Q_BLOCK

    def block(args):
        q1b, q2b, start = args
        qpos = (start + jnp.arange(Q_BLOCK, dtype=jnp.int32)).astype(jnp.float32)
        bias = -slopes[:, None, None] * jnp.abs(qpos[:, None] - kpos[None, :])
        s1 = jnp.einsum('bhqd,bhkd->bhqk', q1b, k1).astype(jnp.float32) * scale + bias
        s2 = jnp.einsum('bhqd,bhkd->bhqk', q2b, k2).astype(jnp.float32) * scale + bias
        a = jax.nn.softmax(s1, axis=-1) - lam * jax.nn.softmax(s2, axis=-1)
        return jnp.einsum('bhqk,bhkv->bhqv', a.astype(v.dtype), v)

    o = lax.map(block, (to_blocks(q1), to_blocks(q2), starts))
    return o.transpose(1, 2, 0, 3, 4).reshape(b, h, s, V_DIM)


def mixing_block(u, w_in, b_gate, conv_w, w_conv_out, lambda_qk, subln_g,
                 w_attn_out, w_o, lam_init):
    b, s, _ = u.shape
    proj = u @ w_in
    cw, aw = CONV_WIDTH, ATTN_WIDTH
    offs = [cw, 2 * cw, 3 * cw, 3 * cw + aw, 3 * cw + 2 * aw, 3 * cw + 3 * aw]
    hc, bc, cc, q, k, v, gates = jnp.split(proj, offs, axis=-1)

    inner = cc * hc
    pad = jnp.pad(inner, ((0, 0), (CONV_K // 2, CONV_K // 2), (0, 0)))
    conv = pad[:, 0:s] * conv_w[0]
    for tap in range(1, CONV_K):
        conv = conv + pad[:, tap:tap + s] * conv_w[tap]
    y_conv = (bc * conv) @ w_conv_out

    q = q.reshape(b, s, N_HEADS, 2, HEAD_DIM)
    k = k.reshape(b, s, N_HEADS, 2, HEAD_DIM)
    q1 = q[:, :, :, 0].transpose(0, 2, 1, 3)
    q2 = q[:, :, :, 1].transpose(0, 2, 1, 3)
    k1 = k[:, :, :, 0].transpose(0, 2, 1, 3)
    k2 = k[:, :, :, 1].transpose(0, 2, 1, 3)
    vh = v.reshape(b, s, N_HEADS, V_DIM).transpose(0, 2, 1, 3)
    lq = lambda_qk.astype(jnp.float32)
    lam = (jnp.exp(jnp.sum(lq[0] * lq[1])) - jnp.exp(jnp.sum(lq[2] * lq[3]))
           + lam_init)
    o = diff_attention(q1, q2, k1, k2, vh, lam)
    o = rmsnorm(o, subln_g) * (1.0 - lam_init)
    o = o.transpose(0, 2, 1, 3).reshape(b, s, ATTN_WIDTH)
    y_attn = o @ w_attn_out

    g = jax.nn.sigmoid((gates + b_gate.reshape(-1)).astype(jnp.float32))
    g = g.reshape(b, s, N_BRANCH, D_MODEL)
    merged = (g[:, :, 0] * y_conv + g[:, :, 1] * y_attn).astype(u.dtype)
    return merged @ w_o


def setup_inputs(seed: int = 0) -> dict:
    key = jax.random.key(seed)
    ks = jax.random.split(key, 12)
    f32 = jnp.float32
    n = lambda k, shp: jax.random.normal(k, shp, dtype=f32)
    return {
        "x": n(ks[0], (BATCH, SEQ, D_MODEL)),
        "w_in": n(ks[1], (DEPTH, D_MODEL, IN_WIDTH)) * D_MODEL ** -0.5,
        "b_gate": 0.01 * n(ks[2], (DEPTH, N_BRANCH, D_MODEL)),
        "conv_w": n(ks[3], (DEPTH, CONV_K, CONV_WIDTH)) * CONV_K ** -0.5,
        "w_conv_out": n(ks[4], (DEPTH, CONV_WIDTH, D_MODEL)) * CONV_WIDTH ** -0.5,
        "lambda_qk": 0.1 * n(ks[5], (DEPTH, 4, HEAD_DIM)),
        "subln_g": 1.0 + 0.02 * n(ks[6], (DEPTH, V_DIM)),
        "w_attn_out": n(ks[7], (DEPTH, ATTN_WIDTH, D_MODEL)) * ATTN_WIDTH ** -0.5,
        "w_o": n(ks[8], (DEPTH, D_MODEL, D_MODEL)) * D_MODEL ** -0.5,
        "norm_g": 1.0 + 0.02 * n(ks[9], (DEPTH, 4, D_MODEL)),
        "w_ff1": n(ks[10], (DEPTH, D_MODEL, D_FF)) * D_MODEL ** -0.5,
        "w_ff2": n(ks[11], (DEPTH, D_FF, D_MODEL)) * D_FF ** -0.5,
    }


def reference(x, w_in, b_gate, conv_w, w_conv_out, lambda_qk, subln_g,
              w_attn_out, w_o, norm_g, w_ff1, w_ff2):
    h = x
    for l in range(DEPTH):
        lam_init = 0.8 - 0.6 * math.exp(-0.3 * l)
        u = rmsnorm(h, norm_g[l, 0])
        m = mixing_block(u, w_in[l], b_gate[l], conv_w[l], w_conv_out[l],
                         lambda_qk[l], subln_g[l], w_attn_out[l], w_o[l], lam_init)
        h = h + rmsnorm(m, norm_g[l, 1])
        u = rmsnorm(h, norm_g[l, 2])
        f = jnp.square(jax.nn.relu(u @ w_ff1[l])) @ w_ff2[l]
        h = h + rmsnorm(f, norm_g[l, 3])
    return h
```

```cpp
#include <hip/hip_runtime.h>
#include <hip/hip_cooperative_groups.h>
#include <cstdio>
#include <cstdint>
namespace cg = cooperative_groups;
namespace pg8 {
#define PG8_LAS __attribute__((address_space(3)))
typedef unsigned short bf16_t;
typedef short bf16x8 __attribute__((ext_vector_type(8)));
typedef float f32x4 __attribute__((ext_vector_type(4)));
typedef unsigned u32x4 __attribute__((ext_vector_type(4)));
constexpr int BM = 256, BK = 64, HALF = 128, HTB = HALF * BK * 2  , STAGE_BYTES = 8 * HTB, NXCD = 8, WGM = 8;

__host__ __device__ __forceinline__ int lds_byte(int r, int c) { const int st = (r >> 4) * 2 + (c >> 5), rr = r & 15, cc = c & 31, ob = rr * 64 + cc * 2; return st * 1024 + (ob ^ (((ob >> 9) & 1) << 5)); }
__host__ __device__ __forceinline__ void stage_rc(int b, int& R, int& C) { const int st = b / 1024, sb = b % 1024, swz = sb ^ (((sb >> 9) & 1) << 5); R = (st >> 1) * 16 + swz / 64; C = (st & 1) * 32 + (swz % 64) / 2; }
__host__ __device__ __forceinline__ int perm32(int rho) { const int n = rho >> 4, i = rho & 15; return 8 * (i >> 2) + 4 * n + (i & 3); }

struct Unit { int pm, pn; };
struct Gemm { const bf16_t* A; const bf16_t* Bt; int M, N, K; };

struct StaticOrder {
    int nM, nN, nwg, G, c;
    __host__ __device__ void init(int M, int N, int G_, int c_) { nM = M / BM; nN = N / BM; nwg = nM * nN; G = G_; c = c_; }
    __host__ __device__ bool next(int i, Unit& u) const {
        const long L = (long)i * G + c; if (L >= nwg) return false;
        int wgid = (int)L; { const int q = nwg / NXCD, r = nwg % NXCD, xcd = wgid % NXCD, off = wgid / NXCD; wgid = (xcd < r ? xcd * (q + 1) : r * (q + 1) + (xcd - r) * q) + off; }
        const int nig = WGM * nN, gid = wgid / nig, fm = gid * WGM, gsz = (nM - fm) < WGM ? (nM - fm) : WGM;
        u.pm = fm + ((wgid % nig) % gsz); u.pn = (wgid % nig) / gsz; return true;
    }
    __device__ __forceinline__ void a_ready(const Unit&) const {}
    __device__ __forceinline__ void done(const Unit&) const {}
};

__device__ __forceinline__ unsigned cvt_pk_bf16(float lo, float hi) { unsigned r; asm volatile("v_cvt_pk_bf16_f32 %0, %1, %2" : "=v"(r) : "v"(lo), "v"(hi)); return r; }
typedef float f32x2 __attribute__((ext_vector_type(2)));

typedef unsigned u32x4 __attribute__((ext_vector_type(4)));
__device__ __forceinline__ float bf_lo(unsigned w) { return __uint_as_float(w << 16); }
__device__ __forceinline__ float bf_hi(unsigned w) { return __uint_as_float(w & 0xffff0000u); }
__device__ __forceinline__ float fast_sigmoid(float x) { return __builtin_amdgcn_rcpf(1.0f + __builtin_amdgcn_exp2f(-1.4426950408889634f * x)); }

constexpr int SEQ_ = 8192;
struct EpiWin {
    static constexpr bool PERM = true, AFTER_DRAIN = false;
    bf16_t *CONV, *Q, *Kt, *Vt, *G; const float* bgate; float qscale;
    __device__ __forceinline__ void operator()(const f32x4 (&acc)[2][2][4][2], const Unit& u, int wr, int wc, int fr_, int fq_) const {
        int fr = fr_, fq = fq_; asm volatile("" : "+v"(fr), "+v"(fq));
        const int pn = u.pn; const int row0 = u.pm * BM + wr * 64 + fr; const int cl0 = wc * 32 + 8 * fq;
        bf16_t* base; int s_ai, s_m, s_bj; float sc = 1.f; bool gate = false;
        if (pn < 6) { base = CONV + (size_t)row0 * 1536 + pn * 256 + cl0; s_ai = HALF * 1536; s_m = 16 * 1536; s_bj = HALF; }
        else if (pn < 8) { base = Q + (size_t)row0 * 512 + (pn - 6) * 256 + cl0; s_ai = HALF * 512; s_m = 16 * 512; s_bj = HALF; sc = qscale; }
        else if (pn < 10) { const int h0 = (pn - 8) * 2, chunk = cl0 >> 3; const int b = row0 >> 13, s = row0 & (SEQ_ - 1), t = s >> 6, key = s & 63;
            base = Kt + ((size_t)((b * 4 + h0) * 128 + t)) * 8192 + chunk * 512 + key * 8; s_ai = 2 * 8192; s_m = 16 * 8; s_bj = 128 * 8192; }
        else if (pn < 12) { const int h0 = (pn - 10) * 2; const int b = row0 >> 13, s = row0 & (SEQ_ - 1), t = s >> 6, key = s & 63, kg = key >> 3;
            base = Vt + ((size_t)((b * 4 + h0) * 128 + t)) * 8192 + (kg * 4 + wc) * 256 + (key & 7) * 32 + 8 * fq; s_ai = 2 * 8192; s_m = 2 * 4 * 256; s_bj = 128 * 8192; }
        else { base = G + (size_t)row0 * 2048 + (pn - 12) * 256 + cl0; s_ai = HALF * 2048; s_m = 16 * 2048; s_bj = HALF; gate = true; }
        f32x4 bv[2][2];
#pragma unroll
        for (int bj = 0; bj < 2; ++bj)
#pragma unroll
            for (int n = 0; n < 2; ++n) bv[bj][n] = gate ? *(const f32x4*)(bgate + (pn - 12) * 256 + cl0 + bj * HALF + 4 * n) : (f32x4){0.f, 0.f, 0.f, 0.f};
#pragma unroll
        for (int ai = 0; ai < 2; ++ai)
#pragma unroll
            for (int m = 0; m < 4; ++m) {
#pragma unroll
                for (int bj = 0; bj < 2; ++bj) {
                    f32x4 v0 = acc[ai][bj][m][0] * sc, v1 = acc[ai][bj][m][1] * sc;
                    if (gate) { v0 = v0 + bv[bj][0]; v1 = v1 + bv[bj][1];
#pragma unroll
                        for (int e = 0; e < 4; ++e) { v0[e] = fast_sigmoid(v0[e]); v1[e] = fast_sigmoid(v1[e]); } }
                    u32x4 w; w.x = cvt_pk_bf16(v0[0], v0[1]); w.y = cvt_pk_bf16(v0[2], v0[3]); w.z = cvt_pk_bf16(v1[0], v1[1]); w.w = cvt_pk_bf16(v1[2], v1[3]);
                    *(u32x4*)(base + (size_t)ai * s_ai + (size_t)m * s_m + (size_t)bj * s_bj) = w;
                }
                asm volatile("" ::: "memory");
            }
    }
};
struct EpiGate1 {
    static constexpr bool PERM = true, AFTER_DRAIN = false;
    float* T; const bf16_t* G;
    __device__ __forceinline__ void operator()(const f32x4 (&acc)[2][2][4][2], const Unit& u, int wr, int wc, int fr_, int fq_) const {
        int fr = fr_, fq = fq_; asm volatile("" : "+v"(fr), "+v"(fq));
        const int row0 = u.pm * BM + wr * 64 + fr;
#pragma unroll
        for (int ai = 0; ai < 2; ++ai)
#pragma unroll
            for (int m = 0; m < 4; ++m) {
                const int row = row0 + ai * HALF + m * 16;
#pragma unroll
                for (int bj = 0; bj < 2; ++bj) {
                    const int col = u.pn * BM + bj * HALF + wc * 32 + 8 * fq;
                    const u32x4 g = *(const u32x4*)(G + (size_t)row * 2048 + col);
                    f32x4 v0 = acc[ai][bj][m][0], v1 = acc[ai][bj][m][1];
                    v0[0] *= bf_lo(g.x); v0[1] *= bf_hi(g.x); v0[2] *= bf_lo(g.y); v0[3] *= bf_hi(g.y);
                    v1[0] *= bf_lo(g.z); v1[1] *= bf_hi(g.z); v1[2] *= bf_lo(g.w); v1[3] *= bf_hi(g.w);
                    float* d = T + (size_t)row * 1024 + col; *(f32x4*)d = v0; *(f32x4*)(d + 4) = v1;
                }
                asm volatile("" ::: "memory");
            }
    }
};
struct EpiGate2 {
    static constexpr bool PERM = true, AFTER_DRAIN = false;
    const float* T; const bf16_t* G; bf16_t* O;
    __device__ __forceinline__ void operator()(const f32x4 (&acc)[2][2][4][2], const Unit& u, int wr, int wc, int fr_, int fq_) const {
        int fr = fr_, fq = fq_; asm volatile("" : "+v"(fr), "+v"(fq));
        const int row0 = u.pm * BM + wr * 64 + fr;
#pragma unroll
        for (int ai = 0; ai < 2; ++ai)
#pragma unroll
            for (int m = 0; m < 4; ++m) {
                const int row = row0 + ai * HALF + m * 16;
#pragma unroll
                for (int bj = 0; bj < 2; ++bj) {
                    const int col = u.pn * BM + bj * HALF + wc * 32 + 8 * fq;
                    const u32x4 g = *(const u32x4*)(G + (size_t)row * 2048 + 1024 + col);
                    const float* d = T + (size_t)row * 1024 + col; const f32x4 t0 = *(const f32x4*)d, t1 = *(const f32x4*)(d + 4);
                    f32x4 v0 = acc[ai][bj][m][0], v1 = acc[ai][bj][m][1];
                    v0[0] = t0[0] + v0[0] * bf_lo(g.x); v0[1] = t0[1] + v0[1] * bf_hi(g.x); v0[2] = t0[2] + v0[2] * bf_lo(g.y); v0[3] = t0[3] + v0[3] * bf_hi(g.y);
                    v1[0] = t1[0] + v1[0] * bf_lo(g.z); v1[1] = t1[1] + v1[1] * bf_hi(g.z); v1[2] = t1[2] + v1[2] * bf_lo(g.w); v1[3] = t1[3] + v1[3] * bf_hi(g.w);
                    u32x4 w; w.x = cvt_pk_bf16(v0[0], v0[1]); w.y = cvt_pk_bf16(v0[2], v0[3]); w.z = cvt_pk_bf16(v1[0], v1[1]); w.w = cvt_pk_bf16(v1[2], v1[3]);
                    *(u32x4*)(O + (size_t)row * 1024 + col) = w;
                }
                asm volatile("" ::: "memory");
            }
    }
};
struct EpiF32 {
    static constexpr bool PERM = false, AFTER_DRAIN = false;
    float* O; int ldc;
    __device__ __forceinline__ void operator()(const f32x4 (&acc)[2][2][4][2], const Unit& u, int wr, int wc, int fr_, int fq_) const {
        int fr = fr_, fq = fq_; asm volatile("" : "+v"(fr), "+v"(fq));
        const int row0 = u.pm * BM + wr * 64 + fr, col0 = u.pn * BM + wc * 32 + 4 * fq;
#pragma unroll
        for (int ai = 0; ai < 2; ++ai)
#pragma unroll
            for (int m = 0; m < 4; ++m) {
                float* rowp = O + (size_t)(row0 + ai * HALF + m * 16) * ldc + col0;
#pragma unroll
                for (int bj = 0; bj < 2; ++bj)
#pragma unroll
                    for (int n = 0; n < 2; ++n) *(f32x4*)(rowp + bj * HALF + n * 16) = acc[ai][bj][m][n];
            }
    }
};
struct EpiRelu2 {
    static constexpr bool PERM = true, AFTER_DRAIN = false;
    bf16_t* O; int ldc;
    __device__ __forceinline__ void operator()(const f32x4 (&acc)[2][2][4][2], const Unit& u, int wr, int wc, int fr_, int fq_) const {
        int fr = fr_, fq = fq_; asm volatile("" : "+v"(fr), "+v"(fq));
        const int row0 = u.pm * BM + wr * 64 + fr, col0 = u.pn * BM + wc * 32 + 8 * fq;
#pragma unroll
        for (int ai = 0; ai < 2; ++ai)
#pragma unroll
            for (int m = 0; m < 4; ++m) {
                bf16_t* rowp = O + (size_t)(row0 + ai * HALF + m * 16) * ldc + col0;
#pragma unroll
                for (int bj = 0; bj < 2; ++bj) {
                    f32x4 v0 = acc[ai][bj][m][0], v1 = acc[ai][bj][m][1];
#pragma unroll
                    for (int e = 0; e < 4; ++e) { const float a = fmaxf(v0[e], 0.f), b = fmaxf(v1[e], 0.f); v0[e] = a * a; v1[e] = b * b; }
                    u32x4 w; w.x = cvt_pk_bf16(v0[0], v0[1]); w.y = cvt_pk_bf16(v0[2], v0[3]); w.z = cvt_pk_bf16(v1[0], v1[1]); w.w = cvt_pk_bf16(v1[2], v1[3]);
                    *(u32x4*)(rowp + bj * HALF) = w;
                }
            }
    }
};

template <class Epi, class Sched, bool ALIGN_EPI = false, bool SP2 = false>
__device__ __forceinline__ void gemm_phase(PG8_LAS unsigned char* lds, const Gemm g, const Sched& S, const Epi& E) {
    int tid_ = threadIdx.x; asm volatile("" : "+v"(tid_));
    const int tid = tid_, wid = __builtin_amdgcn_readfirstlane(tid >> 6), lane = tid & 63, wr = wid >> 2, wc = wid & 3, fr = lane & 15, fq = lane >> 4;
    const int K = g.K, nt = K / BK;
    unsigned voffA[2], voffB[2];
#pragma unroll
    for (int i = 0; i < 2; ++i) { int R, C; stage_rc(tid * 16 + i * 8192, R, C); const int Rb = Epi::PERM ? ((R & ~31) + perm32(R & 31)) : R;
        voffA[i] = (unsigned)(R * K + C) * 2u; voffB[i] = (unsigned)(Rb * K + C) * 2u; }
    const size_t kstep = (size_t)(BK * 2);
    const size_t hstep = (size_t)HALF * K * 2;
    const size_t tstep = 2 * hstep;
    const unsigned ldsw = (unsigned)wid * 1024u;
    const int aoff = lds_byte(wr * 64 + fr, fq * 8), boff = lds_byte(wc * 32 + fr, fq * 8);
#define PG8_SA(b, h) (((b) * 2 + (h)) * HTB)
#define PG8_SB(b, h) ((4 + (b) * 2 + (h)) * HTB)
#define PG8_STAGE(bufoff, gbase, voff) do { _Pragma("unroll") for (int _i = 0; _i < 2; ++_i) \
        __builtin_amdgcn_global_load_lds((const unsigned*)((const char*)(gbase) + (voff)[_i]), (PG8_LAS unsigned*)(lds + (bufoff) + ldsw + _i * 8192), 16, 0, 0); } while (0)
#define PG8_LDA(dst, b, h) do { _Pragma("unroll") for (int m = 0; m < 4; ++m) _Pragma("unroll") for (int k = 0; k < 2; ++k) dst[m][k] = *(const PG8_LAS bf16x8*)(lds + PG8_SA(b, h) + aoff + m * 2048 + k * 1024); } while (0)
#define PG8_LDB(dst, b, h) do { _Pragma("unroll") for (int n = 0; n < 2; ++n) _Pragma("unroll") for (int k = 0; k < 2; ++k) dst[n][k] = *(const PG8_LAS bf16x8*)(lds + PG8_SB(b, h) + boff + n * 2048 + k * 1024); } while (0)
#define PG8_MMA(ai, bj, At, Bt) do { __builtin_amdgcn_s_setprio(1); _Pragma("unroll") for (int m = 0; m < 4; ++m) _Pragma("unroll") for (int n = 0; n < 2; ++n) _Pragma("unroll") for (int k = 0; k < 2; ++k) \
        acc[ai][bj][m][n] = __builtin_amdgcn_mfma_f32_16x16x32_bf16(Bt[n][k], At[m][k], acc[ai][bj][m][n], 0, 0, 0); __builtin_amdgcn_s_setprio(0); } while (0)
#define PG8_WAIT_V(n) asm volatile("s_waitcnt vmcnt(" #n ")" ::: "memory")
#define PG8_WAIT_L(n) asm volatile("s_waitcnt lgkmcnt(" #n ")" ::: "memory")
#define PG8_BAR __builtin_amdgcn_s_barrier()
#define PG8_SCHED __builtin_amdgcn_sched_barrier(0)
    Unit cur, nxt; int ui = 0;
    if (!S.next(0, cur)) return;
    f32x4 acc[2][2][4][2];
#pragma unroll
    for (int a = 0; a < 2; ++a)
#pragma unroll
        for (int b = 0; b < 2; ++b)
#pragma unroll
            for (int m = 0; m < 4; ++m)
#pragma unroll
                for (int n = 0; n < 2; ++n) acc[a][b][m][n] = (f32x4){0.f, 0.f, 0.f, 0.f};
    bf16x8 At[4][2], B0[2][2], B1[2][2];
    const char* cA = (const char*)g.A + (size_t)cur.pm * tstep; const char* cB = (const char*)g.Bt + (size_t)cur.pn * tstep;
    S.a_ready(cur);
    if constexpr (SP2) {
        PG8_STAGE(PG8_SB(0, 0), cB, voffB); PG8_STAGE(PG8_SB(0, 1), cB + hstep, voffB); PG8_STAGE(PG8_SA(0, 0), cA, voffA); PG8_STAGE(PG8_SA(0, 1), cA + hstep, voffA);
        if (wr == 1) PG8_BAR;
        PG8_WAIT_V(2); PG8_BAR;
        PG8_STAGE(PG8_SB(1, 0), cB + kstep, voffB); PG8_STAGE(PG8_SA(1, 0), cA + kstep, voffA); PG8_STAGE(PG8_SB(1, 1), cB + hstep + kstep, voffB);
        PG8_WAIT_V(6); PG8_BAR;
    } else {
        PG8_STAGE(PG8_SB(0, 0), cB, voffB); PG8_STAGE(PG8_SA(0, 0), cA, voffA); PG8_STAGE(PG8_SB(0, 1), cB + hstep, voffB); PG8_STAGE(PG8_SA(0, 1), cA + hstep, voffA);
        if (wr == 1) PG8_BAR;
        PG8_WAIT_V(4); PG8_BAR;
        PG8_STAGE(PG8_SB(1, 0), cB + kstep, voffB); PG8_STAGE(PG8_SA(1, 0), cA + kstep, voffA); PG8_STAGE(PG8_SB(1, 1), cB + hstep + kstep, voffB);
        PG8_WAIT_V(6); PG8_BAR;
    }
    for (;;) {
        const bool has_next = S.next(ui + 1, nxt);
        const char* nA = has_next ? (const char*)g.A + (size_t)nxt.pm * tstep : cA; const char* nB = has_next ? (const char*)g.Bt + (size_t)nxt.pn * tstep : cB;
        for (int t = 0; t < nt; t += 2) {
            const bool last = (t == nt - 2);
            const char* a1 = cA + (size_t)(t + 1) * kstep;
            const char* a2 = last ? nA : cA + (size_t)(t + 2) * kstep; const char* b2 = last ? nB : cB + (size_t)(t + 2) * kstep;
            const char* a3 = a2 + kstep; const char* b3 = b2 + kstep;
            if (last && has_next) S.a_ready(nxt);
            if constexpr (SP2) {
            PG8_LDB(B0, 0, 0); PG8_LDB(B1, 0, 1); PG8_SCHED; PG8_LDA(At, 0, 0); PG8_STAGE(PG8_SA(1, 1), a1 + hstep, voffA);
            PG8_WAIT_V(8); PG8_WAIT_L(0); PG8_BAR; PG8_MMA(0, 0, At, B0); PG8_MMA(0, 1, At, B1); PG8_BAR; PG8_SCHED;
            PG8_LDA(At, 0, 1); PG8_STAGE(PG8_SB(0, 0), b2, voffB); PG8_STAGE(PG8_SB(0, 1), b2 + hstep, voffB); PG8_STAGE(PG8_SA(0, 0), a2, voffA);
            PG8_WAIT_V(8); PG8_WAIT_L(0); PG8_BAR; PG8_MMA(1, 0, At, B0); PG8_MMA(1, 1, At, B1); PG8_BAR; PG8_SCHED;
            PG8_LDB(B0, 1, 0); PG8_LDB(B1, 1, 1); PG8_SCHED; PG8_LDA(At, 1, 0); PG8_STAGE(PG8_SA(0, 1), a2 + hstep, voffA);
            PG8_WAIT_V(8); PG8_WAIT_L(0); PG8_BAR; PG8_MMA(0, 0, At, B0); PG8_MMA(0, 1, At, B1); PG8_BAR; PG8_SCHED;
            PG8_LDA(At, 1, 1); PG8_STAGE(PG8_SB(1, 0), b3, voffB); PG8_STAGE(PG8_SB(1, 1), b3 + hstep, voffB); PG8_STAGE(PG8_SA(1, 0), a3, voffA);
            PG8_WAIT_V(8); PG8_WAIT_L(0); PG8_BAR; PG8_MMA(1, 0, At, B0); PG8_MMA(1, 1, At, B1); PG8_BAR; PG8_SCHED;
            } else {
            PG8_LDB(B0, 0, 0); PG8_SCHED; PG8_LDA(At, 0, 0); PG8_STAGE(PG8_SA(1, 1), a1 + hstep, voffA);
            PG8_WAIT_L(8); PG8_BAR; PG8_WAIT_L(0); PG8_MMA(0, 0, At, B0); PG8_BAR; PG8_SCHED;
            PG8_LDB(B1, 0, 1); PG8_STAGE(PG8_SB(0, 0), b2, voffB);
            PG8_BAR; PG8_WAIT_L(0); PG8_MMA(0, 1, At, B1); PG8_BAR;
            PG8_LDA(At, 0, 1); PG8_STAGE(PG8_SA(0, 0), a2, voffA);
            PG8_BAR; PG8_WAIT_L(0); PG8_MMA(1, 0, At, B0); PG8_BAR; PG8_SCHED;
            PG8_STAGE(PG8_SB(0, 1), b2 + hstep, voffB);
            PG8_WAIT_V(6); PG8_BAR; PG8_MMA(1, 1, At, B1); PG8_BAR;
            PG8_LDB(B0, 1, 0); PG8_SCHED; PG8_LDA(At, 1, 0); PG8_STAGE(PG8_SA(0, 1), a2 + hstep, voffA);
            PG8_WAIT_L(8); PG8_BAR; PG8_WAIT_L(0); PG8_MMA(0, 0, At, B0); PG8_BAR; PG8_SCHED;
            PG8_LDB(B1, 1, 1); PG8_STAGE(PG8_SB(1, 0), b3, voffB);
            PG8_BAR; PG8_WAIT_L(0); PG8_MMA(0, 1, At, B1); PG8_BAR;
            PG8_LDA(At, 1, 1); PG8_STAGE(PG8_SA(1, 0), a3, voffA);
            PG8_BAR; PG8_WAIT_L(0); PG8_MMA(1, 0, At, B0); PG8_BAR; PG8_SCHED;
            PG8_STAGE(PG8_SB(1, 1), b3 + hstep, voffB);
            PG8_WAIT_V(6); PG8_BAR; PG8_MMA(1, 1, At, B1); PG8_BAR;
            }
        }
        if constexpr (ALIGN_EPI) { if (wr == 0) PG8_BAR; }
        if constexpr (!Epi::AFTER_DRAIN) { E(acc, cur, wr, wc, fr, fq); S.done(cur); }
        if (!has_next) break;
#pragma unroll
        for (int a = 0; a < 2; ++a)
#pragma unroll
            for (int b = 0; b < 2; ++b)
#pragma unroll
                for (int m = 0; m < 4; ++m)
#pragma unroll
                    for (int n = 0; n < 2; ++n) acc[a][b][m][n] = (f32x4){0.f, 0.f, 0.f, 0.f};
        cur = nxt; cA = nA; cB = nB; ++ui;
        if constexpr (ALIGN_EPI) { if (wr == 1) PG8_BAR; }
    }
    PG8_WAIT_V(0);
    if constexpr (!ALIGN_EPI) { if (wr == 0) PG8_BAR; }
    PG8_BAR;
    if constexpr (Epi::AFTER_DRAIN) { E.fused(acc, cur, wr, wc, fr, fq, lds, wid, lane); S.done(cur); }
#undef PG8_SA
#undef PG8_SB
#undef PG8_STAGE
#undef PG8_LDA
#undef PG8_LDB
#undef PG8_MMA
#undef PG8_WAIT_V
#undef PG8_WAIT_L
#undef PG8_BAR
#undef PG8_SCHED
}
}

constexpr int D_MODEL = 1024, BATCH = 2, SEQ = 8192, DEPTH = 4, M = BATCH * SEQ;
constexpr int CONV_W = 512, NHEAD = 4, HEAD_DIM = 64, V_DIM = 128, ATTN_W = 512, D_FF = 4096, IN_W = 5120;
constexpr float EPS = 1e-6f;
constexpr float LOG2E = 1.4426950408889634f;

#define LAS __attribute__((address_space(3)))
typedef unsigned short bf16;
typedef short bf16x8 __attribute__((ext_vector_type(8)));
typedef short s16x4 __attribute__((ext_vector_type(4)));
typedef float f32x4 __attribute__((ext_vector_type(4)));
typedef float f32x16 __attribute__((ext_vector_type(16)));
typedef unsigned u32x4 __attribute__((ext_vector_type(4)));
typedef unsigned u32x2 __attribute__((ext_vector_type(2)));

constexpr size_t MiB = 1u << 20;
constexpr size_t WS_W = 1 * MiB;
constexpr size_t W_IN_OFF = 0, W_CO_OFF = W_IN_OFF + (size_t)IN_W * D_MODEL * 2, W_AO_OFF = W_CO_OFF + (size_t)D_MODEL * CONV_W * 2,
                 W_O_OFF = W_AO_OFF + (size_t)D_MODEL * ATTN_W * 2, W_F1_OFF = W_O_OFF + (size_t)D_MODEL * D_MODEL * 2,
                 W_F2_OFF = W_F1_OFF + (size_t)D_FF * D_MODEL * 2, W_END_OFF = W_F2_OFF + (size_t)D_MODEL * D_FF * 2;
static_assert(WS_W + W_END_OFF <= 32 * MiB, "weights region");
constexpr size_t WS_U = 32 * MiB;
constexpr size_t WS_CONV = 64 * MiB;
constexpr size_t WS_Q = 112 * MiB;
constexpr size_t WS_K = 128 * MiB;
constexpr size_t WS_V = 144 * MiB;
constexpr size_t WS_G = 160 * MiB;
constexpr size_t WS_Z = 224 * MiB;
constexpr size_t WS_ON = 240 * MiB;
constexpr size_t WS_T = 64 * MiB;
constexpr size_t WS_MO = 128 * MiB;
constexpr size_t WS_A = 64 * MiB;
constexpr size_t WS_F = 192 * MiB;
constexpr size_t WS_END = 256 * MiB;

constexpr int LDS_BYTES = 135168;

__device__ __forceinline__ float wave_sum(float v) {
#pragma unroll
    for (int o = 1; o < 64; o <<= 1) v += __shfl_xor(v, o);
    return v;
}
__device__ __forceinline__ unsigned f2bf(float f) { unsigned u = __builtin_bit_cast(unsigned, f); return (u + 0x7fffu + ((u >> 16) & 1u)) >> 16; }
__device__ __forceinline__ unsigned pk2(float lo, float hi) { return f2bf(lo) | (f2bf(hi) << 16); }
__device__ __forceinline__ float bflo(unsigned w) { return __uint_as_float(w << 16); }
__device__ __forceinline__ float bfhi(unsigned w) { return __uint_as_float(w & 0xffff0000u); }

__device__ __forceinline__ void transpose_item(const float* W, int K, int N, bf16* WT, LAS float* scr, int item, int lane) {
    const int nblk = N / 32, kb = item / nblk, nb = item % nblk, k0 = 64 * kb, n0 = 32 * nb;
#pragma unroll 8
    for (int i = 0; i < 32; ++i) { const int kk = 2 * i + (lane >> 5); scr[kk * 33 + (lane & 31)] = W[(size_t)(k0 + kk) * N + n0 + (lane & 31)]; }
    asm volatile("s_waitcnt lgkmcnt(0)" ::: "memory");
    const int c = lane & 7;
#pragma unroll
    for (int j = 0; j < 4; ++j) { const int n = (lane >> 3) + 8 * j; const LAS float* s = scr + (8 * c) * 33 + n;
        u32x4 o; o.x = pk2(s[0 * 33], s[1 * 33]); o.y = pk2(s[2 * 33], s[3 * 33]); o.z = pk2(s[4 * 33], s[5 * 33]); o.w = pk2(s[6 * 33], s[7 * 33]);
        *(u32x4*)(WT + (size_t)(n0 + n) * K + k0 + 8 * c) = o; }
    asm volatile("s_waitcnt lgkmcnt(0)" ::: "memory");
}

struct Args { const float* in[12]; float* out; unsigned char* ws; int ph_lo, ph_hi; };

__device__ __forceinline__ void convert_weights(const Args& a, int l, LAS unsigned char* lds, int gw, int NGW, int wave, int lane) {
    LAS float* scr = (LAS float*)(lds + wave * 16384);
    bf16* wb = (bf16*)(a.ws + WS_W);
    constexpr int I_IN = (D_MODEL / 64) * (IN_W / 32), I_CO = (CONV_W / 64) * (D_MODEL / 32), I_AO = (ATTN_W / 64) * (D_MODEL / 32),
                  I_O = (D_MODEL / 64) * (D_MODEL / 32), I_F1 = (D_MODEL / 64) * (D_FF / 32), I_F2 = (D_FF / 64) * (D_MODEL / 32);
    constexpr int NITEMS = I_IN + I_CO + I_AO + I_O + I_F1 + I_F2;
    const float* w_in = a.in[1] + (size_t)l * D_MODEL * IN_W;
    const float* w_co = a.in[4] + (size_t)l * CONV_W * D_MODEL;
    const float* w_ao = a.in[7] + (size_t)l * ATTN_W * D_MODEL;
    const float* w_o = a.in[8] + (size_t)l * D_MODEL * D_MODEL;
    const float* w_f1 = a.in[10] + (size_t)l * D_MODEL * D_FF;
    const float* w_f2 = a.in[11] + (size_t)l * D_FF * D_MODEL;
    for (int it = gw; it < NITEMS; it += NGW) {
        int r = it;
        if (r < I_IN) { transpose_item(w_in, D_MODEL, IN_W, (bf16*)((unsigned char*)wb + W_IN_OFF), scr, r, lane); continue; } r -= I_IN;
        if (r < I_CO) { transpose_item(w_co, CONV_W, D_MODEL, (bf16*)((unsigned char*)wb + W_CO_OFF), scr, r, lane); continue; } r -= I_CO;
        if (r < I_AO) { transpose_item(w_ao, ATTN_W, D_MODEL, (bf16*)((unsigned char*)wb + W_AO_OFF), scr, r, lane); continue; } r -= I_AO;
        if (r < I_O) { transpose_item(w_o, D_MODEL, D_MODEL, (bf16*)((unsigned char*)wb + W_O_OFF), scr, r, lane); continue; } r -= I_O;
        if (r < I_F1) { transpose_item(w_f1, D_MODEL, D_FF, (bf16*)((unsigned char*)wb + W_F1_OFF), scr, r, lane); continue; } r -= I_F1;
        transpose_item(w_f2, D_FF, D_MODEL, (bf16*)((unsigned char*)wb + W_F2_OFF), scr, r, lane);
    }
}

template <bool ADD, bool NORM>
__device__ __forceinline__ void row_phase(const float* hin, const float* F, const float* gA, float* hout, const float* gB, bf16* U, int gw, int NGW, int lane) {
    f32x4 ga[4], gb[4];
#pragma unroll
    for (int j = 0; j < 4; ++j) { ga[j] = ADD ? ((const f32x4*)gA)[lane + 64 * j] : (f32x4){0.f, 0.f, 0.f, 0.f}; gb[j] = NORM ? ((const f32x4*)gB)[lane + 64 * j] : (f32x4){0.f, 0.f, 0.f, 0.f}; }
    for (int m = gw; m < M; m += NGW) {
        f32x4 v[4];
#pragma unroll
        for (int j = 0; j < 4; ++j) v[j] = ((const f32x4*)(hin + (size_t)m * D_MODEL))[lane + 64 * j];
        if (ADD) {
            f32x4 f[4]; float ss = 0.f;
#pragma unroll
            for (int j = 0; j < 4; ++j) { f[j] = ((const f32x4*)(F + (size_t)m * D_MODEL))[lane + 64 * j]; ss += (f[j].x * f[j].x + f[j].y * f[j].y) + (f[j].z * f[j].z + f[j].w * f[j].w); }
            const float r = 1.0f / sqrtf(wave_sum(ss) * (1.0f / D_MODEL) + EPS);
#pragma unroll
            for (int j = 0; j < 4; ++j) v[j] = v[j] + f[j] * r * ga[j];
        }
#pragma unroll
        for (int j = 0; j < 4; ++j) ((f32x4*)(hout + (size_t)m * D_MODEL))[lane + 64 * j] = v[j];
        if (NORM) {
            float ss = 0.f;
#pragma unroll
            for (int j = 0; j < 4; ++j) ss += (v[j].x * v[j].x + v[j].y * v[j].y) + (v[j].z * v[j].z + v[j].w * v[j].w);
            const float r = 1.0f / sqrtf(wave_sum(ss) * (1.0f / D_MODEL) + EPS);
            u32x2* o8 = (u32x2*)(U + (size_t)m * D_MODEL) + lane;
#pragma unroll
            for (int j = 0; j < 4; ++j) { const f32x4 y = v[j] * r * gb[j]; u32x2 w; w.x = pk2(y.x, y.y); w.y = pk2(y.z, y.w); o8[64 * j] = w; }
        }
    }
}

__device__ __forceinline__ void conv_items(const bf16* CONV, const float* cw, bf16* Z, int gw, int NGW, int lane) {
    const int c = lane * 8;
    float w0[8], w1[8], w2[8];
#pragma unroll
    for (int e = 0; e < 8; ++e) { w0[e] = cw[c + e]; w1[e] = cw[CONV_W + c + e]; w2[e] = cw[2 * CONV_W + c + e]; }
    for (int it = gw; it < M / 8; it += NGW) {
        const int t0 = it * 8, s0 = t0 & (SEQ - 1);
        float prev[8], cur[8], nxt[8];
#define INNER(dst, t) do { const u32x4 hh = *(const u32x4*)(CONV + (size_t)(t) * 1536 + c), cc = *(const u32x4*)(CONV + (size_t)(t) * 1536 + 1024 + c); \
            dst[0] = bflo(hh.x) * bflo(cc.x); dst[1] = bfhi(hh.x) * bfhi(cc.x); dst[2] = bflo(hh.y) * bflo(cc.y); dst[3] = bfhi(hh.y) * bfhi(cc.y); \
            dst[4] = bflo(hh.z) * bflo(cc.z); dst[5] = bfhi(hh.z) * bfhi(cc.z); dst[6] = bflo(hh.w) * bflo(cc.w); dst[7] = bfhi(hh.w) * bfhi(cc.w); } while (0)
        if (s0 > 0) { INNER(prev, t0 - 1); } else {
#pragma unroll
            for (int e = 0; e < 8; ++e) prev[e] = 0.f; }
        INNER(cur, t0);
#pragma unroll
        for (int j = 0; j < 8; ++j) {
            const int t = t0 + j;
            if (s0 + j + 1 < SEQ) { INNER(nxt, t + 1); } else {
#pragma unroll
                for (int e = 0; e < 8; ++e) nxt[e] = 0.f; }
            const u32x4 bb = *(const u32x4*)(CONV + (size_t)t * 1536 + 512 + c);
            float z[8];
#pragma unroll
            for (int e = 0; e < 8; ++e) z[e] = prev[e] * w0[e] + cur[e] * w1[e] + nxt[e] * w2[e];
            z[0] *= bflo(bb.x); z[1] *= bfhi(bb.x); z[2] *= bflo(bb.y); z[3] *= bfhi(bb.y); z[4] *= bflo(bb.z); z[5] *= bfhi(bb.z); z[6] *= bflo(bb.w); z[7] *= bfhi(bb.w);
            u32x4 o; o.x = pk2(z[0], z[1]); o.y = pk2(z[2], z[3]); o.z = pk2(z[4], z[5]); o.w = pk2(z[6], z[7]);
            *(u32x4*)(Z + (size_t)t * CONV_W + c) = o;
#pragma unroll
            for (int e = 0; e < 8; ++e) { prev[e] = cur[e]; cur[e] = nxt[e]; }
        }
#undef INNER
    }
}

__device__ __forceinline__ int crow(int r, int hi) { return (r & 3) + 8 * (r >> 2) + 4 * hi; }
typedef float f32x2_t __attribute__((ext_vector_type(2))); typedef __bf16 bf16x2_t __attribute__((ext_vector_type(2)));
__device__ __forceinline__ unsigned cvtpk(float lo, float hi) { f32x2_t v = {lo, hi}; bf16x2_t b = __builtin_convertvector(v, bf16x2_t); return __builtin_bit_cast(unsigned, b); }
typedef short v4i16_t __attribute__((ext_vector_type(4)));
__device__ __forceinline__ s16x4 vtr(const LAS unsigned char* p) { return __builtin_bit_cast(s16x4, __builtin_amdgcn_ds_read_tr16_b64_v4i16((LAS v4i16_t*)p)); }
#define MFMA32(a, b, c) __builtin_amdgcn_mfma_f32_32x32x16_bf16((a), (b), (c), 0, 0, 0)

__device__ __forceinline__ void attn_unit(int b, int h, int qb, int t_lo, int t_hi, const bf16* Q, const bf16* Kt, const bf16* Vt, bf16* ON, LAS unsigned char* lds,
                                          float lam, float slope2, const float* subg, float post) {
    int tid_ = threadIdx.x; asm volatile("" : "+v"(tid_));
    const int tid = tid_, lane = tid & 63, r = lane & 31, hi = lane >> 5;
    const int wid = __builtin_amdgcn_readfirstlane(tid >> 6), map = wid >> 2, qs = wid & 3;
    const int q0 = qb * 128 + qs * 32;
    const size_t tokbase = (size_t)b * SEQ;
    bf16x8 qf[4];
    { const bf16* qp = Q + (tokbase + q0 + r) * ATTN_W + h * 128 + map * 64 + hi * 8;
#pragma unroll
      for (int ks = 0; ks < 4; ++ks) qf[ks] = *(const bf16x8*)(qp + ks * 16); }
    const unsigned char* ktg = (const unsigned char*)Kt + (size_t)((b * 4 + h) * 128) * 16384 + wid * 1024 + lane * 16;
    const unsigned char* vtg = (const unsigned char*)Vt + (size_t)((b * 4 + h) * 128) * 16384 + wid * 1024 + lane * 16;
#define ISSUE(t, buf) do { const size_t go_ = (size_t)(t) * 16384; LAS unsigned char* lb_ = lds + (buf) * 32768 + wid * 1024; \
        __builtin_amdgcn_global_load_lds((const unsigned*)(ktg + go_), (LAS unsigned*)(lb_), 16, 0, 0); \
        __builtin_amdgcn_global_load_lds((const unsigned*)(ktg + go_ + 8192), (LAS unsigned*)(lb_ + 8192), 16, 0, 0); \
        __builtin_amdgcn_global_load_lds((const unsigned*)(vtg + go_), (LAS unsigned*)(lb_ + 16384), 16, 0, 0); \
        __builtin_amdgcn_global_load_lds((const unsigned*)(vtg + go_ + 8192), (LAS unsigned*)(lb_ + 16384 + 8192), 16, 0, 0); } while (0)
    f32x16 o[4];
#pragma unroll
    for (int cb = 0; cb < 4; ++cb)
#pragma unroll
        for (int i = 0; i < 16; ++i) o[cb][i] = 0.f;
    float mrun = -1e30f, lsum = 0.f;
    LAS float* wsf = (LAS float*)(lds + 65536) + wid * 64;
    const LAS unsigned char* kfb = lds + (map * 8 + hi) * 1024 + r * 16;
    const LAS unsigned char* vfb = lds + 16384 + (4 * hi + ((lane & 15) >> 2)) * 64 + ((lane >> 4) & 1) * 32 + (lane & 3) * 8;
    ISSUE(t_lo, 0);
    asm volatile("s_waitcnt vmcnt(0)" ::: "memory");
    __syncthreads();
    for (int t = t_lo; t < t_hi; ++t) {
        const int cur = (t - t_lo) & 1;
        if (t + 1 < t_hi) ISSUE(t + 1, cur ^ 1);
        f32x16 p0, p1;
#pragma unroll
        for (int i = 0; i < 16; ++i) { p0[i] = 0.f; p1[i] = 0.f; }
        const LAS unsigned char* kc = kfb + cur * 32768;
#pragma unroll
        for (int ks = 0; ks < 4; ++ks) {
            const bf16x8 a0 = *(const LAS bf16x8*)(kc + ks * 2048), a1 = *(const LAS bf16x8*)(kc + ks * 2048 + 512);
            p0 = MFMA32(a0, qf[ks], p0); p1 = MFMA32(a1, qf[ks], p1);
        }
        const float dq = (float)(q0 + r - t * 64 - 4 * hi);
        float tmax = -1e30f;
#pragma unroll
        for (int i = 0; i < 16; ++i) {
            const float c0 = (float)((i & 3) + 8 * (i >> 2));
            p0[i] = __builtin_fmaf(-slope2, __builtin_fabsf(dq - c0), p0[i]);
            p1[i] = __builtin_fmaf(-slope2, __builtin_fabsf(dq - (c0 + 32.f)), p1[i]);
            tmax = fmaxf(tmax, fmaxf(p0[i], p1[i]));
        }
        tmax = fmaxf(tmax, __shfl_xor(tmax, 32));
        if (__any(tmax > mrun)) {
            const float mnew = fmaxf(mrun, tmax), alpha = __builtin_amdgcn_exp2f(mrun - mnew);
            lsum *= alpha; mrun = mnew;
            if (hi == 0) wsf[r] = alpha;
            asm volatile("s_waitcnt lgkmcnt(0)" ::: "memory");
#pragma unroll
            for (int i = 0; i < 16; ++i) { const float ai = wsf[crow(i, hi)];
#pragma unroll
                for (int cb = 0; cb < 4; ++cb) o[cb][i] *= ai; }
            asm volatile("s_waitcnt lgkmcnt(0)" ::: "memory");
        }
        float ls = 0.f;
#pragma unroll
        for (int i = 0; i < 16; ++i) { p0[i] = __builtin_amdgcn_exp2f(p0[i] - mrun); p1[i] = __builtin_amdgcn_exp2f(p1[i] - mrun); ls += p0[i] + p1[i]; }
        lsum += ls;
        bf16x8 pk[4];
        { u32x4 w;
          w.x = cvtpk(p0[0], p0[1]); w.y = cvtpk(p0[2], p0[3]); w.z = cvtpk(p0[4], p0[5]); w.w = cvtpk(p0[6], p0[7]); pk[0] = __builtin_bit_cast(bf16x8, w);
          w.x = cvtpk(p0[8], p0[9]); w.y = cvtpk(p0[10], p0[11]); w.z = cvtpk(p0[12], p0[13]); w.w = cvtpk(p0[14], p0[15]); pk[1] = __builtin_bit_cast(bf16x8, w);
          w.x = cvtpk(p1[0], p1[1]); w.y = cvtpk(p1[2], p1[3]); w.z = cvtpk(p1[4], p1[5]); w.w = cvtpk(p1[6], p1[7]); pk[2] = __builtin_bit_cast(bf16x8, w);
          w.x = cvtpk(p1[8], p1[9]); w.y = cvtpk(p1[10], p1[11]); w.z = cvtpk(p1[12], p1[13]); w.w = cvtpk(p1[14], p1[15]); pk[3] = __builtin_bit_cast(bf16x8, w); }
        const LAS unsigned char* vc = vfb + cur * 32768;
#pragma unroll
        for (int S = 0; S < 4; ++S)
#pragma unroll
            for (int cb = 0; cb < 4; ++cb) {
                const s16x4 lo = vtr(vc + ((2 * S) * 4 + cb) * 512), hh = vtr(vc + ((2 * S + 1) * 4 + cb) * 512);
                const bf16x8 vf = __builtin_shufflevector(lo, hh, 0, 1, 2, 3, 4, 5, 6, 7);
                o[cb] = MFMA32(pk[S], vf, o[cb]);
            }
        asm volatile("s_waitcnt vmcnt(0)" ::: "memory");
        __syncthreads();
    }
#undef ISSUE
    lsum += __shfl_xor(lsum, 32);
    float inv = 1.0f / lsum; if (map == 1) inv *= lam;
    if (hi == 0) wsf[r] = inv;
    asm volatile("s_waitcnt lgkmcnt(0)" ::: "memory");
#pragma unroll
    for (int i = 0; i < 16; ++i) { const float si = wsf[crow(i, hi)];
#pragma unroll
        for (int cb = 0; cb < 4; ++cb) o[cb][i] *= si; }
    LAS float* xch = (LAS float*)lds + qs * 4096;
    if (map == 1) {
#pragma unroll
        for (int cb = 0; cb < 4; ++cb)
#pragma unroll
            for (int i = 0; i < 16; ++i) xch[(cb * 16 + i) * 64 + lane] = o[cb][i];
    }
    __syncthreads();
    if (map == 0) {
        float ss[16];
#pragma unroll
        for (int i = 0; i < 16; ++i) { ss[i] = 0.f;
#pragma unroll
            for (int cb = 0; cb < 4; ++cb) { o[cb][i] -= xch[(cb * 16 + i) * 64 + lane]; ss[i] += o[cb][i] * o[cb][i]; } }
#pragma unroll
        for (int i = 0; i < 16; ++i) {
#pragma unroll
            for (int sft = 1; sft < 32; sft <<= 1) ss[i] += __shfl_xor(ss[i], sft);
            ss[i] = post / sqrtf(ss[i] * (1.0f / V_DIM) + EPS);
        }
#pragma unroll
        for (int cb = 0; cb < 4; ++cb) { const float g = subg[cb * 32 + r];
#pragma unroll
            for (int i = 0; i < 16; ++i) ON[(tokbase + q0 + crow(i, hi)) * ATTN_W + h * 128 + cb * 32 + r] = (bf16)f2bf(o[cb][i] * ss[i] * g); }
    }
    __syncthreads();
}

#ifndef PHM
#define PHM 127
#endif
__global__ void __launch_bounds__(512) mk_fwd(Args a) {
    extern __shared__ __attribute__((aligned(16))) unsigned char lds_raw[];
    LAS unsigned char* lds = (LAS unsigned char*)lds_raw;
    const int G = gridDim.x, bx = blockIdx.x;
    for (int p = a.ph_lo; p < a.ph_hi; ++p) {
        const int l = p >> 3, k = p & 7;
        int tid_ = threadIdx.x; asm volatile("" : "+v"(tid_));
        const int tid = tid_, lane = tid & 63, wave = __builtin_amdgcn_readfirstlane(tid >> 6);
        const int gw = bx * 8 + wave, NGW = G * 8;
    unsigned char* ws = a.ws; asm volatile("" : "+s"(ws));
    bf16* U = (bf16*)(ws + WS_U); bf16* CONV = (bf16*)(ws + WS_CONV); bf16* Qb = (bf16*)(ws + WS_Q); bf16* Kt = (bf16*)(ws + WS_K); bf16* Vt = (bf16*)(ws + WS_V);
    bf16* Gt = (bf16*)(ws + WS_G); bf16* Z = (bf16*)(ws + WS_Z); bf16* ON = (bf16*)(ws + WS_ON); float* T = (float*)(ws + WS_T); float* MO = (float*)(ws + WS_MO);
    bf16* Ah = (bf16*)(ws + WS_A); float* Fo = (float*)(ws + WS_F); bf16* MERGED = U;
    const unsigned char* wb = ws + WS_W;
    float* hbuf = a.out;
    const float* norm_g = a.in[9];
        if ((PHM & 1) && k == 0) {
            if (l < DEPTH) convert_weights(a, l, lds, gw, NGW, wave, lane);
            if (l == 0) row_phase<false, true>(a.in[0], nullptr, nullptr, hbuf, norm_g + (size_t)(0 * 4 + 0) * D_MODEL, U, gw, NGW, lane);
            else if (l < DEPTH) row_phase<true, true>(hbuf, Fo, norm_g + (size_t)((l - 1) * 4 + 3) * D_MODEL, hbuf, norm_g + (size_t)(l * 4 + 0) * D_MODEL, U, gw, NGW, lane);
            else row_phase<true, false>(hbuf, Fo, norm_g + (size_t)((l - 1) * 4 + 3) * D_MODEL, hbuf, nullptr, nullptr, gw, NGW, lane);
        } else if ((PHM & 2) && k == 1) {
            pg8::Gemm g{U, (const bf16*)(wb + W_IN_OFF), M, IN_W, D_MODEL}; pg8::StaticOrder S; S.init(M, IN_W, G, bx);
            pg8::EpiWin E{CONV, Qb, Kt, Vt, Gt, a.in[2] + (size_t)l * 2 * D_MODEL, 0.125f * LOG2E};
            pg8::gemm_phase<pg8::EpiWin, pg8::StaticOrder, true, true>(lds, g, S, E);
        } else if ((PHM & 4) && k == 2) {
            conv_items(CONV, a.in[3] + (size_t)l * 3 * CONV_W, Z, gw, NGW, lane);
            const float lam_init = 0.8f - 0.6f * expf(-0.3f * (float)l);
            const float* lq = a.in[5] + (size_t)l * 4 * HEAD_DIM;
            const float s1 = wave_sum(lq[lane] * lq[64 + lane]), s2 = wave_sum(lq[128 + lane] * lq[192 + lane]);
            const float lam = expf(s1) - expf(s2) + lam_init;
            const float* subg = a.in[6] + (size_t)l * V_DIM;
            const int bh = bx & 7, j = bx >> 3, nj = G >> 3;
            for (int qb = j; qb < SEQ / 128; qb += nj) {
                const int b = bh >> 2, h = bh & 3;
                const float slope2 = exp2f(-2.0f * (float)(h + 1)) * LOG2E;
                attn_unit(b, h, qb, 0, SEQ / 64, Qb, Kt, Vt, ON, lds, lam, slope2, subg, 1.0f - lam_init);
            }
        } else if ((PHM & 8) && k == 3) {
            { pg8::Gemm g{Z, (const bf16*)(wb + W_CO_OFF), M, D_MODEL, CONV_W}; pg8::StaticOrder S; S.init(M, D_MODEL, G, bx);
              pg8::EpiGate1 E{T, Gt};
              pg8::gemm_phase<pg8::EpiGate1, pg8::StaticOrder, false, true>(lds, g, S, E); }
            __syncthreads();
            { pg8::Gemm g{ON, (const bf16*)(wb + W_AO_OFF), M, D_MODEL, ATTN_W}; pg8::StaticOrder S; S.init(M, D_MODEL, G, bx);
              pg8::EpiGate2 E{T, Gt, MERGED};
              pg8::gemm_phase<pg8::EpiGate2, pg8::StaticOrder, false, true>(lds, g, S, E); }
        } else if ((PHM & 16) && (k == 4 || k == 7)) {
            const bool ff = (k == 7);
            pg8::Gemm g{ff ? Ah : MERGED, (const bf16*)(wb + (ff ? W_F2_OFF : W_O_OFF)), M, D_MODEL, ff ? D_FF : D_MODEL}; pg8::StaticOrder S; S.init(M, D_MODEL, G, bx);
            pg8::EpiF32 E{ff ? Fo : MO, D_MODEL};
            pg8::gemm_phase<pg8::EpiF32, pg8::StaticOrder, false, true>(lds, g, S, E);
        } else if ((PHM & 32) && k == 5) {
            row_phase<true, true>(hbuf, MO, norm_g + (size_t)(l * 4 + 1) * D_MODEL, hbuf, norm_g + (size_t)(l * 4 + 2) * D_MODEL, U, gw, NGW, lane);
        } else if ((PHM & 64) && k == 6) {
            pg8::Gemm g{U, (const bf16*)(wb + W_F1_OFF), M, D_FF, D_MODEL}; pg8::StaticOrder S; S.init(M, D_FF, G, bx);
            pg8::EpiRelu2 E{Ah, D_FF};
            pg8::gemm_phase<pg8::EpiRelu2, pg8::StaticOrder, true, true>(lds, g, S, E);
        }
        if (p + 1 < a.ph_hi) cg::this_grid().sync();
    }
}

constexpr int N_PHASES = DEPTH * 8 + 1;
#ifndef MK_MULTI
#define MK_MULTI 0
#endif

extern "C" void kernel_launch(void* const* d_in, const int* in_sizes, int n_in, void* d_out, int out_size, void* d_ws, size_t ws_size, hipStream_t stream) {
    static int grid = 0;
    if (grid == 0) {
        if (n_in != 12 || out_size != M * D_MODEL || ws_size < WS_END) { fprintf(stderr, "kernel_launch: unexpected shapes (n_in %d out %d ws %zu)\n", n_in, out_size, ws_size); grid = -1; return; }
        int dev = 0, cus = 0, per_cu = 0;
        hipGetDevice(&dev); hipDeviceGetAttribute(&cus, hipDeviceAttributeMultiprocessorCount, dev);
        hipFuncSetAttribute((const void*)mk_fwd, hipFuncAttributeMaxDynamicSharedMemorySize, LDS_BYTES);
        hipOccupancyMaxActiveBlocksPerMultiprocessor(&per_cu, (const void*)mk_fwd, 512, LDS_BYTES);
        (void)hipGetLastError();
        if (per_cu < 1) per_cu = 1;
        grid = cus * 1;
        if (grid != 256) fprintf(stderr, "kernel_launch: note: %d CUs\n", grid);
    }
    if (grid < 0) return;
    Args a{};
    for (int i = 0; i < 12; ++i) a.in[i] = (const float*)d_in[i];
    a.out = (float*)d_out; a.ws = (unsigned char*)d_ws;
#if MK_MULTI
    for (int p = 0; p < N_PHASES; ++p) {
        a.ph_lo = p; a.ph_hi = p + 1;
        hipLaunchKernelGGL(mk_fwd, dim3(grid), dim3(512), LDS_BYTES, stream, a);
    }
#else
    a.ph_lo = 0; a.ph_hi = N_PHASES;
    void* args[] = {&a};
    hipError_t e = hipLaunchCooperativeKernel((const void*)mk_fwd, dim3(grid), dim3(512), args, LDS_BYTES, stream);
    if (e != hipSuccess) fprintf(stderr, "cooperative launch failed: %s (grid %d)\n", hipGetErrorString(e), grid);
#endif
}
```

```cpp
#include <hip/hip_runtime.h>
#include <hip/hip_cooperative_groups.h>
#include <cstdio>
#include <cstdint>
namespace cg = cooperative_groups;
namespace pg8 {
#define PG8_LAS __attribute__((address_space(3)))
typedef unsigned short bf16_t;
typedef short bf16x8 __attribute__((ext_vector_type(8)));
typedef float f32x4 __attribute__((ext_vector_type(4)));
typedef unsigned u32x4 __attribute__((ext_vector_type(4)));
constexpr int BM = 256, BK = 64, HALF = 128, HTB = HALF * BK * 2  , STAGE_BYTES = 8 * HTB, NXCD = 8, WGM = 8;

__host__ __device__ __forceinline__ int lds_byte(int r, int c) { const int st = (r >> 4) * 2 + (c >> 5), rr = r & 15, cc = c & 31, ob = rr * 64 + cc * 2; return st * 1024 + (ob ^ (((ob >> 9) & 1) << 5)); }
__host__ __device__ __forceinline__ void stage_rc(int b, int& R, int& C) { const int st = b / 1024, sb = b % 1024, swz = sb ^ (((sb >> 9) & 1) << 5); R = (st >> 1) * 16 + swz / 64; C = (st & 1) * 32 + (swz % 64) / 2; }
__host__ __device__ __forceinline__ int perm32(int rho) { const int n = rho >> 4, i = rho & 15; return 8 * (i >> 2) + 4 * n + (i & 3); }

struct Unit { int pm, pn; };
struct Gemm { const bf16_t* A; const bf16_t* Bt; int M, N, K; };

struct StaticOrder {
    int nM, nN, nwg, G, c;
    __host__ __device__ void init(int M, int N, int G_, int c_) { nM = M / BM; nN = N / BM; nwg = nM * nN; G = G_; c = c_; }
    __host__ __device__ bool next(int i, Unit& u) const {
        const long L = (long)i * G + c; if (L >= nwg) return false;
        int wgid = (int)L; { const int q = nwg / NXCD, r = nwg % NXCD, xcd = wgid % NXCD, off = wgid / NXCD; wgid = (xcd < r ? xcd * (q + 1) : r * (q + 1) + (xcd - r) * q) + off; }
        const int nig = WGM * nN, gid = wgid / nig, fm = gid * WGM, gsz = (nM - fm) < WGM ? (nM - fm) : WGM;
        u.pm = fm + ((wgid % nig) % gsz); u.pn = (wgid % nig) / gsz; return true;
    }
    __device__ __forceinline__ void a_ready(const Unit&) const {}
    __device__ __forceinline__ void done(const Unit&) const {}
};

__device__ __forceinline__ unsigned cvt_pk_bf16(float lo, float hi) { unsigned r; asm volatile("v_cvt_pk_bf16_f32 %0, %1, %2" : "=v"(r) : "v"(lo), "v"(hi)); return r; }
typedef float f32x2 __attribute__((ext_vector_type(2)));

typedef unsigned u32x4 __attribute__((ext_vector_type(4)));
__device__ __forceinline__ float bf_lo(unsigned w) { return __uint_as_float(w << 16); }
__device__ __forceinline__ float bf_hi(unsigned w) { return __uint_as_float(w & 0xffff0000u); }
__device__ __forceinline__ float fast_sigmoid(float x) { return __builtin_amdgcn_rcpf(1.0f + __builtin_amdgcn_exp2f(-1.4426950408889634f * x)); }

constexpr int SEQ_ = 8192;
struct EpiWin {
    static constexpr bool PERM = true, AFTER_DRAIN = false;
    bf16_t *CONV, *Q, *Kt, *Vt, *G; const float* bgate; float qscale; unsigned* nrm;
    __device__ __forceinline__ void operator()(const f32x4 (&acc)[2][2][4][2], const Unit& u, int wr, int wc, int fr_, int fq_) const {
        int fr = fr_, fq = fq_; asm volatile("" : "+v"(fr), "+v"(fq));
        const int pn = u.pn; const int row0 = u.pm * BM + wr * 64 + fr; const int cl0 = wc * 32 + 8 * fq;
        bf16_t* base; int s_ai, s_m, s_bj; float sc = 1.f; bool gate = false;
        if (pn < 6) { base = CONV + (size_t)row0 * 1536 + pn * 256 + cl0; s_ai = HALF * 1536; s_m = 16 * 1536; s_bj = HALF; }
        else if (pn < 8) { base = Q + (size_t)row0 * 512 + (pn - 6) * 256 + cl0; s_ai = HALF * 512; s_m = 16 * 512; s_bj = HALF; sc = qscale; }
        else if (pn < 10) { const int h0 = (pn - 8) * 2, chunk = cl0 >> 3; const int b = row0 >> 13, s = row0 & (SEQ_ - 1), t = s >> 6, key = s & 63;
            base = Kt + ((size_t)((b * 4 + h0) * 128 + t)) * 8192 + chunk * 512 + key * 8; s_ai = 2 * 8192; s_m = 16 * 8; s_bj = 128 * 8192; }
        else if (pn < 12) { const int h0 = (pn - 10) * 2; const int b = row0 >> 13, s = row0 & (SEQ_ - 1), t = s >> 6, key = s & 63, kg = key >> 3;
            base = Vt + ((size_t)((b * 4 + h0) * 128 + t)) * 8192 + (kg * 4 + wc) * 256 + (key & 7) * 32 + 8 * fq; s_ai = 2 * 8192; s_m = 2 * 4 * 256; s_bj = 128 * 8192; }
        else { base = G + (size_t)row0 * 2048 + (pn - 12) * 256 + cl0; s_ai = HALF * 2048; s_m = 16 * 2048; s_bj = HALF; gate = true; }
        const bool trk = (pn >= 6 && pn < 10); float mx0 = 0.f, mx1 = 0.f;
        f32x4 bv[2][2];
#pragma unroll
        for (int bj = 0; bj < 2; ++bj)
#pragma unroll
            for (int n = 0; n < 2; ++n) bv[bj][n] = gate ? *(const f32x4*)(bgate + (pn - 12) * 256 + cl0 + bj * HALF + 4 * n) : (f32x4){0.f, 0.f, 0.f, 0.f};
#pragma unroll
        for (int ai = 0; ai < 2; ++ai)
#pragma unroll
            for (int m = 0; m < 4; ++m) {
#pragma unroll
                for (int bj = 0; bj < 2; ++bj) {
                    f32x4 v0 = acc[ai][bj][m][0] * sc, v1 = acc[ai][bj][m][1] * sc;
                    if (gate) { v0 = v0 + bv[bj][0]; v1 = v1 + bv[bj][1];
#pragma unroll
                        for (int e = 0; e < 4; ++e) { v0[e] = fast_sigmoid(v0[e]); v1[e] = fast_sigmoid(v1[e]); } }
                    if (trk) { float s = (v0[0] * v0[0] + v0[1] * v0[1]) + (v0[2] * v0[2] + v0[3] * v0[3]) + (v1[0] * v1[0] + v1[1] * v1[1]) + (v1[2] * v1[2] + v1[3] * v1[3]);
                        s += __shfl_xor(s, 16); s += __shfl_xor(s, 32); if (bj == 0) mx0 = fmaxf(mx0, s); else mx1 = fmaxf(mx1, s); }
                    u32x4 w; w.x = cvt_pk_bf16(v0[0], v0[1]); w.y = cvt_pk_bf16(v0[2], v0[3]); w.z = cvt_pk_bf16(v1[0], v1[1]); w.w = cvt_pk_bf16(v1[2], v1[3]);
                    *(u32x4*)(base + (size_t)ai * s_ai + (size_t)m * s_m + (size_t)bj * s_bj) = w;
                }
                asm volatile("" ::: "memory");
            }
        if (trk) {
#pragma unroll
            for (int sft = 1; sft < 16; sft <<= 1) { mx0 = fmaxf(mx0, __shfl_xor(mx0, sft)); mx1 = fmaxf(mx1, __shfl_xor(mx1, sft)); }
            if (fr == 0 && fq == 0) { const int isk = pn >= 8 ? 1 : 0, h0 = ((pn - 6) & 1) * 2, bb = row0 >> 13;
                unsigned* wp = nrm + isk * 32 + (bb * 4 + h0) * 4 + wc;
                atomicMax(wp, __float_as_uint(mx0)); atomicMax(wp + 4, __float_as_uint(mx1)); }
        }
    }
};
struct EpiGate1 {
    static constexpr bool PERM = true, AFTER_DRAIN = false;
    float* T; const bf16_t* G;
    __device__ __forceinline__ void operator()(const f32x4 (&acc)[2][2][4][2], const Unit& u, int wr, int wc, int fr_, int fq_) const {
        int fr = fr_, fq = fq_; asm volatile("" : "+v"(fr), "+v"(fq));
        const int row0 = u.pm * BM + wr * 64 + fr;
#pragma unroll
        for (int ai = 0; ai < 2; ++ai)
#pragma unroll
            for (int m = 0; m < 4; ++m) {
                const int row = row0 + ai * HALF + m * 16;
#pragma unroll
                for (int bj = 0; bj < 2; ++bj) {
                    const int col = u.pn * BM + bj * HALF + wc * 32 + 8 * fq;
                    const u32x4 g = *(const u32x4*)(G + (size_t)row * 2048 + col);
                    f32x4 v0 = acc[ai][bj][m][0], v1 = acc[ai][bj][m][1];
                    v0[0] *= bf_lo(g.x); v0[1] *= bf_hi(g.x); v0[2] *= bf_lo(g.y); v0[3] *= bf_hi(g.y);
                    v1[0] *= bf_lo(g.z); v1[1] *= bf_hi(g.z); v1[2] *= bf_lo(g.w); v1[3] *= bf_hi(g.w);
                    float* d = T + (size_t)row * 1024 + col; *(f32x4*)d = v0; *(f32x4*)(d + 4) = v1;
                }
                asm volatile("" ::: "memory");
            }
    }
};
struct EpiGate2 {
    static constexpr bool PERM = true, AFTER_DRAIN = false;
    const float* T; const bf16_t* G; bf16_t* O;
    __device__ __forceinline__ void operator()(const f32x4 (&acc)[2][2][4][2], const Unit& u, int wr, int wc, int fr_, int fq_) const {
        int fr = fr_, fq = fq_; asm volatile("" : "+v"(fr), "+v"(fq));
        const int row0 = u.pm * BM + wr * 64 + fr;
#pragma unroll
        for (int ai = 0; ai < 2; ++ai)
#pragma unroll
            for (int m = 0; m < 4; ++m) {
                const int row = row0 + ai * HALF + m * 16;
#pragma unroll
                for (int bj = 0; bj < 2; ++bj) {
                    const int col = u.pn * BM + bj * HALF + wc * 32 + 8 * fq;
                    const u32x4 g = *(const u32x4*)(G + (size_t)row * 2048 + 1024 + col);
                    const float* d = T + (size_t)row * 1024 + col; const f32x4 t0 = *(const f32x4*)d, t1 = *(const f32x4*)(d + 4);
                    f32x4 v0 = acc[ai][bj][m][0], v1 = acc[ai][bj][m][1];
                    v0[0] = t0[0] + v0[0] * bf_lo(g.x); v0[1] = t0[1] + v0[1] * bf_hi(g.x); v0[2] = t0[2] + v0[2] * bf_lo(g.y); v0[3] = t0[3] + v0[3] * bf_hi(g.y);
                    v1[0] = t1[0] + v1[0] * bf_lo(g.z); v1[1] = t1[1] + v1[1] * bf_hi(g.z); v1[2] = t1[2] + v1[2] * bf_lo(g.w); v1[3] = t1[3] + v1[3] * bf_hi(g.w);
                    u32x4 w; w.x = cvt_pk_bf16(v0[0], v0[1]); w.y = cvt_pk_bf16(v0[2], v0[3]); w.z = cvt_pk_bf16(v1[0], v1[1]); w.w = cvt_pk_bf16(v1[2], v1[3]);
                    *(u32x4*)(O + (size_t)row * 1024 + col) = w;
                }
                asm volatile("" ::: "memory");
            }
    }
};
struct EpiF32 {
    static constexpr bool PERM = false, AFTER_DRAIN = false;
    float* O; int ldc;
    __device__ __forceinline__ void operator()(const f32x4 (&acc)[2][2][4][2], const Unit& u, int wr, int wc, int fr_, int fq_) const {
        int fr = fr_, fq = fq_; asm volatile("" : "+v"(fr), "+v"(fq));
        const int row0 = u.pm * BM + wr * 64 + fr, col0 = u.pn * BM + wc * 32 + 4 * fq;
#pragma unroll
        for (int ai = 0; ai < 2; ++ai)
#pragma unroll
            for (int m = 0; m < 4; ++m) {
                float* rowp = O + (size_t)(row0 + ai * HALF + m * 16) * ldc + col0;
#pragma unroll
                for (int bj = 0; bj < 2; ++bj)
#pragma unroll
                    for (int n = 0; n < 2; ++n) *(f32x4*)(rowp + bj * HALF + n * 16) = acc[ai][bj][m][n];
            }
    }
};
struct EpiRelu2 {
    static constexpr bool PERM = true, AFTER_DRAIN = false;
    bf16_t* O; int ldc;
    __device__ __forceinline__ void operator()(const f32x4 (&acc)[2][2][4][2], const Unit& u, int wr, int wc, int fr_, int fq_) const {
        int fr = fr_, fq = fq_; asm volatile("" : "+v"(fr), "+v"(fq));
        const int row0 = u.pm * BM + wr * 64 + fr, col0 = u.pn * BM + wc * 32 + 8 * fq;
#pragma unroll
        for (int ai = 0; ai < 2; ++ai)
#pragma unroll
            for (int m = 0; m < 4; ++m) {
                bf16_t* rowp = O + (size_t)(row0 + ai * HALF + m * 16) * ldc + col0;
#pragma unroll
                for (int bj = 0; bj < 2; ++bj) {
                    f32x4 v0 = acc[ai][bj][m][0], v1 = acc[ai][bj][m][1];
#pragma unroll
                    for (int e = 0; e < 4; ++e) { const float a = fmaxf(v0[e], 0.f), b = fmaxf(v1[e], 0.f); v0[e] = a * a; v1[e] = b * b; }
                    u32x4 w; w.x = cvt_pk_bf16(v0[0], v0[1]); w.y = cvt_pk_bf16(v0[2], v0[3]); w.z = cvt_pk_bf16(v1[0], v1[1]); w.w = cvt_pk_bf16(v1[2], v1[3]);
                    *(u32x4*)(rowp + bj * HALF) = w;
                }
            }
    }
};

template <class Epi, class Sched, bool ALIGN_EPI = false, bool SP2 = false>
__device__ __forceinline__ void gemm_phase(PG8_LAS unsigned char* lds, const Gemm g, const Sched& S, const Epi& E) {
    int tid_ = threadIdx.x; asm volatile("" : "+v"(tid_));
    const int tid = tid_, wid = __builtin_amdgcn_readfirstlane(tid >> 6), lane = tid & 63, wr = wid >> 2, wc = wid & 3, fr = lane & 15, fq = lane >> 4;
    const int K = g.K, nt = K / BK;
    unsigned voffA[2], voffB[2];
#pragma unroll
    for (int i = 0; i < 2; ++i) { int R, C; stage_rc(tid * 16 + i * 8192, R, C); const int Rb = Epi::PERM ? ((R & ~31) + perm32(R & 31)) : R;
        voffA[i] = (unsigned)(R * K + C) * 2u; voffB[i] = (unsigned)(Rb * K + C) * 2u; }
    const size_t kstep = (size_t)(BK * 2);
    const size_t hstep = (size_t)HALF * K * 2;
    const size_t tstep = 2 * hstep;
    const unsigned ldsw = (unsigned)wid * 1024u;
    const int aoff = lds_byte(wr * 64 + fr, fq * 8), boff = lds_byte(wc * 32 + fr, fq * 8);
#define PG8_SA(b, h) (((b) * 2 + (h)) * HTB)
#define PG8_SB(b, h) ((4 + (b) * 2 + (h)) * HTB)
#define PG8_STAGE(bufoff, gbase, voff) do { _Pragma("unroll") for (int _i = 0; _i < 2; ++_i) \
        __builtin_amdgcn_global_load_lds((const unsigned*)((const char*)(gbase) + (voff)[_i]), (PG8_LAS unsigned*)(lds + (bufoff) + ldsw + _i * 8192), 16, 0, 0); } while (0)
#define PG8_LDA(dst, b, h) do { _Pragma("unroll") for (int m = 0; m < 4; ++m) _Pragma("unroll") for (int k = 0; k < 2; ++k) dst[m][k] = *(const PG8_LAS bf16x8*)(lds + PG8_SA(b, h) + aoff + m * 2048 + k * 1024); } while (0)
#define PG8_LDB(dst, b, h) do { _Pragma("unroll") for (int n = 0; n < 2; ++n) _Pragma("unroll") for (int k = 0; k < 2; ++k) dst[n][k] = *(const PG8_LAS bf16x8*)(lds + PG8_SB(b, h) + boff + n * 2048 + k * 1024); } while (0)
#define PG8_MMA(ai, bj, At, Bt) do { __builtin_amdgcn_s_setprio(1); _Pragma("unroll") for (int m = 0; m < 4; ++m) _Pragma("unroll") for (int n = 0; n < 2; ++n) _Pragma("unroll") for (int k = 0; k < 2; ++k) \
        acc[ai][bj][m][n] = __builtin_amdgcn_mfma_f32_16x16x32_bf16(Bt[n][k], At[m][k], acc[ai][bj][m][n], 0, 0, 0); __builtin_amdgcn_s_setprio(0); } while (0)
#define PG8_WAIT_V(n) asm volatile("s_waitcnt vmcnt(" #n ")" ::: "memory")
#define PG8_WAIT_L(n) asm volatile("s_waitcnt lgkmcnt(" #n ")" ::: "memory")
#define PG8_BAR __builtin_amdgcn_s_barrier()
#define PG8_SCHED __builtin_amdgcn_sched_barrier(0)
    Unit cur, nxt; int ui = 0;
    if (!S.next(0, cur)) return;
    f32x4 acc[2][2][4][2];
#pragma unroll
    for (int a = 0; a < 2; ++a)
#pragma unroll
        for (int b = 0; b < 2; ++b)
#pragma unroll
            for (int m = 0; m < 4; ++m)
#pragma unroll
                for (int n = 0; n < 2; ++n) acc[a][b][m][n] = (f32x4){0.f, 0.f, 0.f, 0.f};
    bf16x8 At[4][2], B0[2][2], B1[2][2];
    const char* cA = (const char*)g.A + (size_t)cur.pm * tstep; const char* cB = (const char*)g.Bt + (size_t)cur.pn * tstep;
    S.a_ready(cur);
    if constexpr (SP2) {
        PG8_STAGE(PG8_SB(0, 0), cB, voffB); PG8_STAGE(PG8_SB(0, 1), cB + hstep, voffB); PG8_STAGE(PG8_SA(0, 0), cA, voffA); PG8_STAGE(PG8_SA(0, 1), cA + hstep, voffA);
        if (wr == 1) PG8_BAR;
        PG8_WAIT_V(2); PG8_BAR;
        PG8_STAGE(PG8_SB(1, 0), cB + kstep, voffB); PG8_STAGE(PG8_SA(1, 0), cA + kstep, voffA); PG8_STAGE(PG8_SB(1, 1), cB + hstep + kstep, voffB);
        PG8_WAIT_V(6); PG8_BAR;
    } else {
        PG8_STAGE(PG8_SB(0, 0), cB, voffB); PG8_STAGE(PG8_SA(0, 0), cA, voffA); PG8_STAGE(PG8_SB(0, 1), cB + hstep, voffB); PG8_STAGE(PG8_SA(0, 1), cA + hstep, voffA);
        if (wr == 1) PG8_BAR;
        PG8_WAIT_V(4); PG8_BAR;
        PG8_STAGE(PG8_SB(1, 0), cB + kstep, voffB); PG8_STAGE(PG8_SA(1, 0), cA + kstep, voffA); PG8_STAGE(PG8_SB(1, 1), cB + hstep + kstep, voffB);
        PG8_WAIT_V(6); PG8_BAR;
    }
    for (;;) {
        const bool has_next = S.next(ui + 1, nxt);
        const char* nA = has_next ? (const char*)g.A + (size_t)nxt.pm * tstep : cA; const char* nB = has_next ? (const char*)g.Bt + (size_t)nxt.pn * tstep : cB;
        for (int t = 0; t < nt; t += 2) {
            const bool last = (t == nt - 2);
            const char* a1 = cA + (size_t)(t + 1) * kstep;
            const char* a2 = last ? nA : cA + (size_t)(t + 2) * kstep; const char* b2 = last ? nB : cB + (size_t)(t + 2) * kstep;
            const char* a3 = a2 + kstep; const char* b3 = b2 + kstep;
            if (last && has_next) S.a_ready(nxt);
            if constexpr (SP2) {
            PG8_LDB(B0, 0, 0); PG8_LDB(B1, 0, 1); PG8_SCHED; PG8_LDA(At, 0, 0); PG8_STAGE(PG8_SA(1, 1), a1 + hstep, voffA);
            PG8_WAIT_V(8); PG8_WAIT_L(0); PG8_BAR; PG8_MMA(0, 0, At, B0); PG8_MMA(0, 1, At, B1); PG8_BAR; PG8_SCHED;
            PG8_LDA(At, 0, 1); PG8_STAGE(PG8_SB(0, 0), b2, voffB); PG8_STAGE(PG8_SB(0, 1), b2 + hstep, voffB); PG8_STAGE(PG8_SA(0, 0), a2, voffA);
            PG8_WAIT_V(8); PG8_WAIT_L(0); PG8_BAR; PG8_MMA(1, 0, At, B0); PG8_MMA(1, 1, At, B1); PG8_BAR; PG8_SCHED;
            PG8_LDB(B0, 1, 0); PG8_LDB(B1, 1, 1); PG8_SCHED; PG8_LDA(At, 1, 0); PG8_STAGE(PG8_SA(0, 1), a2 + hstep, voffA);
            PG8_WAIT_V(8); PG8_WAIT_L(0); PG8_BAR; PG8_MMA(0, 0, At, B0); PG8_MMA(0, 1, At, B1); PG8_BAR; PG8_SCHED;
            PG8_LDA(At, 1, 1); PG8_STAGE(PG8_SB(1, 0), b3, voffB); PG8_STAGE(PG8_SB(1, 1), b3 + hstep, voffB); PG8_STAGE(PG8_SA(1, 0), a3, voffA);
            PG8_WAIT_V(8); PG8_WAIT_L(0); PG8_BAR; PG8_MMA(1, 0, At, B0); PG8_MMA(1, 1, At, B1); PG8_BAR; PG8_SCHED;
            } else {
            PG8_LDB(B0, 0, 0); PG8_SCHED; PG8_LDA(At, 0, 0); PG8_STAGE(PG8_SA(1, 1), a1 + hstep, voffA);
            PG8_WAIT_L(8); PG8_BAR; PG8_WAIT_L(0); PG8_MMA(0, 0, At, B0); PG8_BAR; PG8_SCHED;
            PG8_LDB(B1, 0, 1); PG8_STAGE(PG8_SB(0, 0), b2, voffB);
            PG8_BAR; PG8_WAIT_L(0); PG8_MMA(0, 1, At, B1); PG8_BAR;
            PG8_LDA(At, 0, 1); PG8_STAGE(PG8_SA(0, 0), a2, voffA);
            PG8_BAR; PG8_WAIT_L(0); PG8_MMA(1, 0, At, B0); PG8_BAR; PG8_SCHED;
            PG8_STAGE(PG8_SB(0, 1), b2 + hstep, voffB);
            PG8_WAIT_V(6); PG8_BAR; PG8_MMA(1, 1, At, B1); PG8_BAR;
            PG8_LDB(B0, 1, 0); PG8_SCHED; PG8_LDA(At, 1, 0); PG8_STAGE(PG8_SA(0, 1), a2 + hstep, voffA);
            PG8_WAIT_L(8); PG8_BAR; PG8_WAIT_L(0); PG8_MMA(0, 0, At, B0); PG8_BAR; PG8_SCHED;
            PG8_LDB(B1, 1, 1); PG8_STAGE(PG8_SB(1, 0), b3, voffB);
            PG8_BAR; PG8_WAIT_L(0); PG8_MMA(0, 1, At, B1); PG8_BAR;
            PG8_LDA(At, 1, 1); PG8_STAGE(PG8_SA(1, 0), a3, voffA);
            PG8_BAR; PG8_WAIT_L(0); PG8_MMA(1, 0, At, B0); PG8_BAR; PG8_SCHED;
            PG8_STAGE(PG8_SB(1, 1), b3 + hstep, voffB);
            PG8_WAIT_V(6); PG8_BAR; PG8_MMA(1, 1, At, B1); PG8_BAR;
            }
        }
        if constexpr (ALIGN_EPI) { if (wr == 0) PG8_BAR; }
        if constexpr (!Epi::AFTER_DRAIN) { E(acc, cur, wr, wc, fr, fq); S.done(cur); }
        if (!has_next) break;
#pragma unroll
        for (int a = 0; a < 2; ++a)
#pragma unroll
            for (int b = 0; b < 2; ++b)
#pragma unroll
                for (int m = 0; m < 4; ++m)
#pragma unroll
                    for (int n = 0; n < 2; ++n) acc[a][b][m][n] = (f32x4){0.f, 0.f, 0.f, 0.f};
        cur = nxt; cA = nA; cB = nB; ++ui;
        if constexpr (ALIGN_EPI) { if (wr == 1) PG8_BAR; }
    }
    PG8_WAIT_V(0);
    if constexpr (!ALIGN_EPI) { if (wr == 0) PG8_BAR; }
    PG8_BAR;
    if constexpr (Epi::AFTER_DRAIN) { E.fused(acc, cur, wr, wc, fr, fq, lds, wid, lane); S.done(cur); }
#undef PG8_SA
#undef PG8_SB
#undef PG8_STAGE
#undef PG8_LDA
#undef PG8_LDB
#undef PG8_MMA
#undef PG8_WAIT_V
#undef PG8_WAIT_L
#undef PG8_BAR
#undef PG8_SCHED
}
}

constexpr int D_MODEL = 1024, BATCH = 2, SEQ = 8192, DEPTH = 4, M = BATCH * SEQ;
constexpr int CONV_W = 512, NHEAD = 4, HEAD_DIM = 64, V_DIM = 128, ATTN_W = 512, D_FF = 4096, IN_W = 5120;
constexpr float EPS = 1e-6f;
constexpr float LOG2E = 1.4426950408889634f;

#define LAS __attribute__((address_space(3)))
typedef unsigned short bf16;
typedef short bf16x8 __attribute__((ext_vector_type(8)));
typedef short s16x4 __attribute__((ext_vector_type(4)));
typedef float f32x4 __attribute__((ext_vector_type(4)));
typedef float f32x16 __attribute__((ext_vector_type(16)));
typedef unsigned u32x4 __attribute__((ext_vector_type(4)));
typedef unsigned u32x2 __attribute__((ext_vector_type(2)));

constexpr size_t MiB = 1u << 20;
constexpr size_t WS_CTL = 0;
constexpr size_t WS_W = 1 * MiB;
constexpr size_t W_IN_OFF = 0, W_CO_OFF = W_IN_OFF + (size_t)IN_W * D_MODEL * 2, W_AO_OFF = W_CO_OFF + (size_t)D_MODEL * CONV_W * 2,
                 W_O_OFF = W_AO_OFF + (size_t)D_MODEL * ATTN_W * 2, W_F1_OFF = W_O_OFF + (size_t)D_MODEL * D_MODEL * 2,
                 W_F2_OFF = W_F1_OFF + (size_t)D_FF * D_MODEL * 2, W_END_OFF = W_F2_OFF + (size_t)D_MODEL * D_FF * 2;
static_assert(WS_W + W_END_OFF <= 32 * MiB, "weights region");
constexpr size_t WS_U = 32 * MiB;
constexpr size_t WS_CONV = 64 * MiB;
constexpr size_t WS_Q = 112 * MiB;
constexpr size_t WS_K = 128 * MiB;
constexpr size_t WS_V = 144 * MiB;
constexpr size_t WS_G = 160 * MiB;
constexpr size_t WS_Z = 224 * MiB;
constexpr size_t WS_ON = 240 * MiB;
constexpr size_t WS_T = 64 * MiB;
constexpr size_t WS_MO = 128 * MiB;
constexpr size_t WS_A = 64 * MiB;
constexpr size_t WS_F = 192 * MiB;
constexpr size_t WS_END = 256 * MiB;

constexpr int LDS_BYTES = 135168;

__device__ __forceinline__ float wave_sum(float v) {
#pragma unroll
    for (int o = 1; o < 64; o <<= 1) v += __shfl_xor(v, o);
    return v;
}
__device__ __forceinline__ unsigned f2bf(float f) { unsigned u = __builtin_bit_cast(unsigned, f); return (u + 0x7fffu + ((u >> 16) & 1u)) >> 16; }
__device__ __forceinline__ unsigned pk2(float lo, float hi) { return f2bf(lo) | (f2bf(hi) << 16); }
__device__ __forceinline__ float bflo(unsigned w) { return __uint_as_float(w << 16); }
__device__ __forceinline__ float bfhi(unsigned w) { return __uint_as_float(w & 0xffff0000u); }

__device__ __forceinline__ void transpose_item(const float* W, int K, int N, bf16* WT, LAS float* scr, int item, int lane) {
    const int nblk = N / 32, kb = item / nblk, nb = item % nblk, k0 = 64 * kb, n0 = 32 * nb;
#pragma unroll 8
    for (int i = 0; i < 32; ++i) { const int kk = 2 * i + (lane >> 5); scr[kk * 33 + (lane & 31)] = W[(size_t)(k0 + kk) * N + n0 + (lane & 31)]; }
    asm volatile("s_waitcnt lgkmcnt(0)" ::: "memory");
    const int c = lane & 7;
#pragma unroll
    for (int j = 0; j < 4; ++j) { const int n = (lane >> 3) + 8 * j; const LAS float* s = scr + (8 * c) * 33 + n;
        u32x4 o; o.x = pk2(s[0 * 33], s[1 * 33]); o.y = pk2(s[2 * 33], s[3 * 33]); o.z = pk2(s[4 * 33], s[5 * 33]); o.w = pk2(s[6 * 33], s[7 * 33]);
        *(u32x4*)(WT + (size_t)(n0 + n) * K + k0 + 8 * c) = o; }
    asm volatile("s_waitcnt lgkmcnt(0)" ::: "memory");
}

struct Args { const float* in[12]; float* out; unsigned char* ws; int ph_lo, ph_hi; };

__device__ __forceinline__ void convert_weights(const Args& a, int l, LAS unsigned char* lds, int gw, int NGW, int wave, int lane) {
    LAS float* scr = (LAS float*)(lds + wave * 16384);
    bf16* wb = (bf16*)(a.ws + WS_W);
    constexpr int I_IN = (D_MODEL / 64) * (IN_W / 32), I_CO = (CONV_W / 64) * (D_MODEL / 32), I_AO = (ATTN_W / 64) * (D_MODEL / 32),
                  I_O = (D_MODEL / 64) * (D_MODEL / 32), I_F1 = (D_MODEL / 64) * (D_FF / 32), I_F2 = (D_FF / 64) * (D_MODEL / 32);
    constexpr int NITEMS = I_IN + I_CO + I_AO + I_O + I_F1 + I_F2;
    const float* w_in = a.in[1] + (size_t)l * D_MODEL * IN_W;
    const float* w_co = a.in[4] + (size_t)l * CONV_W * D_MODEL;
    const float* w_ao = a.in[7] + (size_t)l * ATTN_W * D_MODEL;
    const float* w_o = a.in[8] + (size_t)l * D_MODEL * D_MODEL;
    const float* w_f1 = a.in[10] + (size_t)l * D_MODEL * D_FF;
    const float* w_f2 = a.in[11] + (size_t)l * D_FF * D_MODEL;
    for (int it = gw; it < NITEMS; it += NGW) {
        int r = it;
        if (r < I_IN) { transpose_item(w_in, D_MODEL, IN_W, (bf16*)((unsigned char*)wb + W_IN_OFF), scr, r, lane); continue; } r -= I_IN;
        if (r < I_CO) { transpose_item(w_co, CONV_W, D_MODEL, (bf16*)((unsigned char*)wb + W_CO_OFF), scr, r, lane); continue; } r -= I_CO;
        if (r < I_AO) { transpose_item(w_ao, ATTN_W, D_MODEL, (bf16*)((unsigned char*)wb + W_AO_OFF), scr, r, lane); continue; } r -= I_AO;
        if (r < I_O) { transpose_item(w_o, D_MODEL, D_MODEL, (bf16*)((unsigned char*)wb + W_O_OFF), scr, r, lane); continue; } r -= I_O;
        if (r < I_F1) { transpose_item(w_f1, D_MODEL, D_FF, (bf16*)((unsigned char*)wb + W_F1_OFF), scr, r, lane); continue; } r -= I_F1;
        transpose_item(w_f2, D_FF, D_MODEL, (bf16*)((unsigned char*)wb + W_F2_OFF), scr, r, lane);
    }
}

template <bool ADD, bool NORM>
__device__ __forceinline__ void row_phase(const float* hin, const float* F, const float* gA, float* hout, const float* gB, bf16* U, int gw, int NGW, int lane) {
    f32x4 ga[4], gb[4];
#pragma unroll
    for (int j = 0; j < 4; ++j) { ga[j] = ADD ? ((const f32x4*)gA)[lane + 64 * j] : (f32x4){0.f, 0.f, 0.f, 0.f}; gb[j] = NORM ? ((const f32x4*)gB)[lane + 64 * j] : (f32x4){0.f, 0.f, 0.f, 0.f}; }
    for (int m = gw; m < M; m += NGW) {
        f32x4 v[4];
#pragma unroll
        for (int j = 0; j < 4; ++j) v[j] = ((const f32x4*)(hin + (size_t)m * D_MODEL))[lane + 64 * j];
        if (ADD) {
            f32x4 f[4]; float ss = 0.f;
#pragma unroll
            for (int j = 0; j < 4; ++j) { f[j] = ((const f32x4*)(F + (size_t)m * D_MODEL))[lane + 64 * j]; ss += (f[j].x * f[j].x + f[j].y * f[j].y) + (f[j].z * f[j].z + f[j].w * f[j].w); }
            const float r = 1.0f / sqrtf(wave_sum(ss) * (1.0f / D_MODEL) + EPS);
#pragma unroll
            for (int j = 0; j < 4; ++j) v[j] = v[j] + f[j] * r * ga[j];
        }
#pragma unroll
        for (int j = 0; j < 4; ++j) ((f32x4*)(hout + (size_t)m * D_MODEL))[lane + 64 * j] = v[j];
        if (NORM) {
            float ss = 0.f;
#pragma unroll
            for (int j = 0; j < 4; ++j) ss += (v[j].x * v[j].x + v[j].y * v[j].y) + (v[j].z * v[j].z + v[j].w * v[j].w);
            const float r = 1.0f / sqrtf(wave_sum(ss) * (1.0f / D_MODEL) + EPS);
            u32x2* o8 = (u32x2*)(U + (size_t)m * D_MODEL) + lane;
#pragma unroll
            for (int j = 0; j < 4; ++j) { const f32x4 y = v[j] * r * gb[j]; u32x2 w; w.x = pk2(y.x, y.y); w.y = pk2(y.z, y.w); o8[64 * j] = w; }
        }
    }
}

__device__ __forceinline__ void conv_items(const bf16* CONV, const float* cw, bf16* Z, int gw, int NGW, int lane) {
    const int c = lane * 8;
    float w0[8], w1[8], w2[8];
#pragma unroll
    for (int e = 0; e < 8; ++e) { w0[e] = cw[c + e]; w1[e] = cw[CONV_W + c + e]; w2[e] = cw[2 * CONV_W + c + e]; }
    for (int it = gw; it < M / 8; it += NGW) {
        const int t0 = it * 8, s0 = t0 & (SEQ - 1);
        float prev[8], cur[8], nxt[8];
#define INNER(dst, t) do { const u32x4 hh = *(const u32x4*)(CONV + (size_t)(t) * 1536 + c), cc = *(const u32x4*)(CONV + (size_t)(t) * 1536 + 1024 + c); \
            dst[0] = bflo(hh.x) * bflo(cc.x); dst[1] = bfhi(hh.x) * bfhi(cc.x); dst[2] = bflo(hh.y) * bflo(cc.y); dst[3] = bfhi(hh.y) * bfhi(cc.y); \
            dst[4] = bflo(hh.z) * bflo(cc.z); dst[5] = bfhi(hh.z) * bfhi(cc.z); dst[6] = bflo(hh.w) * bflo(cc.w); dst[7] = bfhi(hh.w) * bfhi(cc.w); } while (0)
        if (s0 > 0) { INNER(prev, t0 - 1); } else {
#pragma unroll
            for (int e = 0; e < 8; ++e) prev[e] = 0.f; }
        INNER(cur, t0);
#pragma unroll
        for (int j = 0; j < 8; ++j) {
            const int t = t0 + j;
            if (s0 + j + 1 < SEQ) { INNER(nxt, t + 1); } else {
#pragma unroll
                for (int e = 0; e < 8; ++e) nxt[e] = 0.f; }
            const u32x4 bb = *(const u32x4*)(CONV + (size_t)t * 1536 + 512 + c);
            float z[8];
#pragma unroll
            for (int e = 0; e < 8; ++e) z[e] = prev[e] * w0[e] + cur[e] * w1[e] + nxt[e] * w2[e];
            z[0] *= bflo(bb.x); z[1] *= bfhi(bb.x); z[2] *= bflo(bb.y); z[3] *= bfhi(bb.y); z[4] *= bflo(bb.z); z[5] *= bfhi(bb.z); z[6] *= bflo(bb.w); z[7] *= bfhi(bb.w);
            u32x4 o; o.x = pk2(z[0], z[1]); o.y = pk2(z[2], z[3]); o.z = pk2(z[4], z[5]); o.w = pk2(z[6], z[7]);
            *(u32x4*)(Z + (size_t)t * CONV_W + c) = o;
#pragma unroll
            for (int e = 0; e < 8; ++e) { prev[e] = cur[e]; cur[e] = nxt[e]; }
        }
#undef INNER
    }
}

__device__ __forceinline__ int crow(int r, int hi) { return (r & 3) + 8 * (r >> 2) + 4 * hi; }
typedef float f32x2_t __attribute__((ext_vector_type(2))); typedef __bf16 bf16x2_t __attribute__((ext_vector_type(2)));
__device__ __forceinline__ unsigned cvtpk(float lo, float hi) { f32x2_t v = {lo, hi}; bf16x2_t b = __builtin_convertvector(v, bf16x2_t); return __builtin_bit_cast(unsigned, b); }
typedef short v4i16_t __attribute__((ext_vector_type(4)));
__device__ __forceinline__ s16x4 vtr(const LAS unsigned char* p) { return __builtin_bit_cast(s16x4, __builtin_amdgcn_ds_read_tr16_b64_v4i16((LAS v4i16_t*)p)); }
constexpr float ATT_T = 32.0f;
#define MFMA32(a, b, c) __builtin_amdgcn_mfma_f32_32x32x16_bf16((a), (b), (c), 0, 0, 0)

__device__ __forceinline__ void attn_unit(int b, int h, int qb, int t_lo, int t_hi, const bf16* Q, const bf16* Kt, const bf16* Vt, bf16* ON, LAS unsigned char* lds,
                                          float lam, float slope2, const float* subg, float post) {
    int tid_ = threadIdx.x; asm volatile("" : "+v"(tid_));
    const int tid = tid_, lane = tid & 63, r = lane & 31, hi = lane >> 5;
    const int wid = __builtin_amdgcn_readfirstlane(tid >> 6), map = wid >> 2, qs = wid & 3;
    const int q0 = qb * 128 + qs * 32;
    const size_t tokbase = (size_t)b * SEQ;
    bf16x8 qf[4];
    { const bf16* qp = Q + (tokbase + q0 + r) * ATTN_W + h * 128 + map * 64 + hi * 8;
#pragma unroll
      for (int ks = 0; ks < 4; ++ks) qf[ks] = *(const bf16x8*)(qp + ks * 16); }
    const unsigned char* ktg = (const unsigned char*)Kt + (size_t)((b * 4 + h) * 128) * 16384 + wid * 1024 + lane * 16;
    const unsigned char* vtg = (const unsigned char*)Vt + (size_t)((b * 4 + h) * 128) * 16384 + wid * 1024 + lane * 16;
#define ISSUE(t, buf) do { const size_t go_ = (size_t)(t) * 16384; LAS unsigned char* lb_ = lds + (buf) * 32768 + wid * 1024; \
        __builtin_amdgcn_global_load_lds((const unsigned*)(ktg + go_), (LAS unsigned*)(lb_), 16, 0, 0); \
        __builtin_amdgcn_global_load_lds((const unsigned*)(ktg + go_ + 8192), (LAS unsigned*)(lb_ + 8192), 16, 0, 0); \
        __builtin_amdgcn_global_load_lds((const unsigned*)(vtg + go_), (LAS unsigned*)(lb_ + 16384), 16, 0, 0); \
        __builtin_amdgcn_global_load_lds((const unsigned*)(vtg + go_ + 8192), (LAS unsigned*)(lb_ + 16384 + 8192), 16, 0, 0); } while (0)
    f32x16 o[4];
#pragma unroll
    for (int cb = 0; cb < 4; ++cb)
#pragma unroll
        for (int i = 0; i < 16; ++i) o[cb][i] = 0.f;
    float mrun = -1e30f, lsum = 0.f;
    LAS float* wsf = (LAS float*)(lds + 65536) + wid * 64;
    const LAS unsigned char* kfb = lds + (map * 8 + hi) * 1024 + r * 16;
    const LAS unsigned char* vfb = lds + 16384 + (4 * hi + ((lane & 15) >> 2)) * 64 + ((lane >> 4) & 1) * 32 + (lane & 3) * 8;
    ISSUE(t_lo, 0);
    asm volatile("s_waitcnt vmcnt(0)" ::: "memory");
    __syncthreads();
    for (int t = t_lo; t < t_hi; ++t) {
        const int cur = (t - t_lo) & 1;
        if (t + 1 < t_hi) ISSUE(t + 1, cur ^ 1);
        f32x16 p0, p1;
#pragma unroll
        for (int i = 0; i < 16; ++i) { p0[i] = 0.f; p1[i] = 0.f; }
        const LAS unsigned char* kc = kfb + cur * 32768;
#pragma unroll
        for (int ks = 0; ks < 4; ++ks) {
            const bf16x8 a0 = *(const LAS bf16x8*)(kc + ks * 2048), a1 = *(const LAS bf16x8*)(kc + ks * 2048 + 512);
            p0 = MFMA32(a0, qf[ks], p0); p1 = MFMA32(a1, qf[ks], p1);
        }
        const float dq = (float)(q0 + r - t * 64 - 4 * hi);
        float tmax = -1e30f;
#pragma unroll
        for (int i = 0; i < 16; ++i) {
            const float c0 = (float)((i & 3) + 8 * (i >> 2));
            p0[i] = __builtin_fmaf(-slope2, __builtin_fabsf(dq - c0), p0[i]);
            p1[i] = __builtin_fmaf(-slope2, __builtin_fabsf(dq - (c0 + 32.f)), p1[i]);
            tmax = fmaxf(tmax, fmaxf(p0[i], p1[i]));
        }
        tmax = fmaxf(tmax, __shfl_xor(tmax, 32));
        if (__any(tmax > mrun)) {
            const float mnew = fmaxf(mrun, tmax), alpha = __builtin_amdgcn_exp2f(mrun - mnew);
            lsum *= alpha; mrun = mnew;
            if (hi == 0) wsf[r] = alpha;
            asm volatile("s_waitcnt lgkmcnt(0)" ::: "memory");
#pragma unroll
            for (int i = 0; i < 16; ++i) { const float ai = wsf[crow(i, hi)];
#pragma unroll
                for (int cb = 0; cb < 4; ++cb) o[cb][i] *= ai; }
            asm volatile("s_waitcnt lgkmcnt(0)" ::: "memory");
        }
        float ls = 0.f;
#pragma unroll
        for (int i = 0; i < 16; ++i) { p0[i] = __builtin_amdgcn_exp2f(p0[i] - mrun); p1[i] = __builtin_amdgcn_exp2f(p1[i] - mrun); ls += p0[i] + p1[i]; }
        lsum += ls;
        bf16x8 pk[4];
        { u32x4 w;
          w.x = cvtpk(p0[0], p0[1]); w.y = cvtpk(p0[2], p0[3]); w.z = cvtpk(p0[4], p0[5]); w.w = cvtpk(p0[6], p0[7]); pk[0] = __builtin_bit_cast(bf16x8, w);
          w.x = cvtpk(p0[8], p0[9]); w.y = cvtpk(p0[10], p0[11]); w.z = cvtpk(p0[12], p0[13]); w.w = cvtpk(p0[14], p0[15]); pk[1] = __builtin_bit_cast(bf16x8, w);
          w.x = cvtpk(p1[0], p1[1]); w.y = cvtpk(p1[2], p1[3]); w.z = cvtpk(p1[4], p1[5]); w.w = cvtpk(p1[6], p1[7]); pk[2] = __builtin_bit_cast(bf16x8, w);
          w.x = cvtpk(p1[8], p1[9]); w.y = cvtpk(p1[10], p1[11]); w.z = cvtpk(p1[12], p1[13]); w.w = cvtpk(p1[14], p1[15]); pk[3] = __builtin_bit_cast(bf16x8, w); }
        const LAS unsigned char* vc = vfb + cur * 32768;
#pragma unroll
        for (int S = 0; S < 4; ++S)
#pragma unroll
            for (int cb = 0; cb < 4; ++cb) {
                const s16x4 lo = vtr(vc + ((2 * S) * 4 + cb) * 512), hh = vtr(vc + ((2 * S + 1) * 4 + cb) * 512);
                const bf16x8 vf = __builtin_shufflevector(lo, hh, 0, 1, 2, 3, 4, 5, 6, 7);
                o[cb] = MFMA32(pk[S], vf, o[cb]);
            }
        asm volatile("s_waitcnt vmcnt(0)" ::: "memory");
        __syncthreads();
    }
#undef ISSUE
    lsum += __shfl_xor(lsum, 32);
    float inv = 1.0f / lsum; if (map == 1) inv *= lam;
    if (hi == 0) wsf[r] = inv;
    asm volatile("s_waitcnt lgkmcnt(0)" ::: "memory");
#pragma unroll
    for (int i = 0; i < 16; ++i) { const float si = wsf[crow(i, hi)];
#pragma unroll
        for (int cb = 0; cb < 4; ++cb) o[cb][i] *= si; }
    LAS float* xch = (LAS float*)lds + qs * 4096;
    if (map == 1) {
#pragma unroll
        for (int cb = 0; cb < 4; ++cb)
#pragma unroll
            for (int i = 0; i < 16; ++i) xch[(cb * 16 + i) * 64 + lane] = o[cb][i];
    }
    __syncthreads();
    if (map == 0) {
        float ss[16];
#pragma unroll
        for (int i = 0; i < 16; ++i) { ss[i] = 0.f;
#pragma unroll
            for (int cb = 0; cb < 4; ++cb) { o[cb][i] -= xch[(cb * 16 + i) * 64 + lane]; ss[i] += o[cb][i] * o[cb][i]; } }
#pragma unroll
        for (int i = 0; i < 16; ++i) {
#pragma unroll
            for (int sft = 1; sft < 32; sft <<= 1) ss[i] += __shfl_xor(ss[i], sft);
            ss[i] = post / sqrtf(ss[i] * (1.0f / V_DIM) + EPS);
        }
#pragma unroll
        for (int cb = 0; cb < 4; ++cb) { const float g = subg[cb * 32 + r];
#pragma unroll
            for (int i = 0; i < 16; ++i) ON[(tokbase + q0 + crow(i, hi)) * ATTN_W + h * 128 + cb * 32 + r] = (bf16)f2bf(o[cb][i] * ss[i] * g); }
    }
    __syncthreads();
}

#ifndef PHM
#define PHM 127
#endif
__global__ void __launch_bounds__(512) mk_fwd(Args a) {
    extern __shared__ __attribute__((aligned(16))) unsigned char lds_raw[];
    LAS unsigned char* lds = (LAS unsigned char*)lds_raw;
    const int G = gridDim.x, bx = blockIdx.x;
    for (int p = a.ph_lo; p < a.ph_hi; ++p) {
        const int l = p >> 3, k = p & 7;
        int tid_ = threadIdx.x; asm volatile("" : "+v"(tid_));
        const int tid = tid_, lane = tid & 63, wave = __builtin_amdgcn_readfirstlane(tid >> 6);
        const int gw = bx * 8 + wave, NGW = G * 8;
    unsigned char* ws = a.ws; asm volatile("" : "+s"(ws));
    bf16* U = (bf16*)(ws + WS_U); bf16* CONV = (bf16*)(ws + WS_CONV); bf16* Qb = (bf16*)(ws + WS_Q); bf16* Kt = (bf16*)(ws + WS_K); bf16* Vt = (bf16*)(ws + WS_V);
    bf16* Gt = (bf16*)(ws + WS_G); bf16* Z = (bf16*)(ws + WS_Z); bf16* ON = (bf16*)(ws + WS_ON); float* T = (float*)(ws + WS_T); float* MO = (float*)(ws + WS_MO);
    bf16* Ah = (bf16*)(ws + WS_A); float* Fo = (float*)(ws + WS_F); bf16* MERGED = U;
    const unsigned char* wb = ws + WS_W;
    float* hbuf = a.out;
    const float* norm_g = a.in[9];
        unsigned* ctl = (unsigned*)(ws + WS_CTL);
        if ((PHM & 1) && k == 0) {
            if (p == 0 && bx == 0) { for (int i = tid; i < 2048; i += 512) ctl[i] = 0u; }
            if (l < DEPTH) convert_weights(a, l, lds, gw, NGW, wave, lane);
            if (l == 0) row_phase<false, true>(a.in[0], nullptr, nullptr, hbuf, norm_g + (size_t)(0 * 4 + 0) * D_MODEL, U, gw, NGW, lane);
            else if (l < DEPTH) row_phase<true, true>(hbuf, Fo, norm_g + (size_t)((l - 1) * 4 + 3) * D_MODEL, hbuf, norm_g + (size_t)(l * 4 + 0) * D_MODEL, U, gw, NGW, lane);
            else row_phase<true, false>(hbuf, Fo, norm_g + (size_t)((l - 1) * 4 + 3) * D_MODEL, hbuf, nullptr, nullptr, gw, NGW, lane);
        } else if ((PHM & 2) && k == 1) {
            pg8::Gemm g{U, (const bf16*)(wb + W_IN_OFF), M, IN_W, D_MODEL}; pg8::StaticOrder S; S.init(M, IN_W, G, bx);
            pg8::EpiWin E{CONV, Qb, Kt, Vt, Gt, a.in[2] + (size_t)l * 2 * D_MODEL, 0.125f * LOG2E, ctl + 1024 + l * 64};
            pg8::gemm_phase<pg8::EpiWin, pg8::StaticOrder, true, true>(lds, g, S, E);
        } else if ((PHM & 4) && k == 2) {
            conv_items(CONV, a.in[3] + (size_t)l * 3 * CONV_W, Z, gw, NGW, lane);
            const float lam_init = 0.8f - 0.6f * expf(-0.3f * (float)l);
            const float* lq = a.in[5] + (size_t)l * 4 * HEAD_DIM;
            const float s1 = wave_sum(lq[lane] * lq[64 + lane]), s2 = wave_sum(lq[128 + lane] * lq[192 + lane]);
            const float lam = expf(s1) - expf(s2) + lam_init;
            const float* subg = a.in[6] + (size_t)l * V_DIM;
            LAS unsigned* sq = (LAS unsigned*)(lds + 65536 + 2048);
            const unsigned* nq = ctl + 1024 + l * 64; const unsigned* nk = nq + 32;
            for (;;) {
                __syncthreads();
                if (tid == 0) sq[0] = atomicAdd(ctl + l * 64, 1u);
                __syncthreads();
                const int u = (int)sq[0];
                if (u >= 512) break;
                const int h = 3 - (u >> 7), idx = u & 127, b = idx & 1, jj = idx >> 1, qb = (jj & 1) ? 31 - (jj >> 1) : 32 + (jj >> 1);
                const float slope2 = exp2f(-2.0f * (float)(h + 1)) * LOG2E;
                const unsigned* wq = nq + (b * 4 + h) * 4; const unsigned* wk = nk + (b * 4 + h) * 4;
                const float B0 = sqrtf((__uint_as_float(wq[0]) + __uint_as_float(wq[1])) * (__uint_as_float(wk[0]) + __uint_as_float(wk[1])));
                const float B1 = sqrtf((__uint_as_float(wq[2]) + __uint_as_float(wq[3])) * (__uint_as_float(wk[2]) + __uint_as_float(wk[3])));
                const float Wf = (2.04f * fmaxf(B0, B1) + ATT_T) / slope2;
                const int W = Wf < 16384.f ? (int)Wf + 1 : 16384;
                const int q0b = qb * 128;
                int t_lo = (q0b - W) >> 6; if (t_lo < 0) t_lo = 0;
                int t_hi = ((q0b + 127 + W) >> 6) + 1; if (t_hi > SEQ / 64) t_hi = SEQ / 64;
                attn_unit(b, h, qb, t_lo, t_hi, Qb, Kt, Vt, ON, lds, lam, slope2, subg, 1.0f - lam_init);
            }
        } else if ((PHM & 8) && k == 3) {
            { pg8::Gemm g{Z, (const bf16*)(wb + W_CO_OFF), M, D_MODEL, CONV_W}; pg8::StaticOrder S; S.init(M, D_MODEL, G, bx);
              pg8::EpiGate1 E{T, Gt};
              pg8::gemm_phase<pg8::EpiGate1, pg8::StaticOrder, false, true>(lds, g, S, E); }
            __syncthreads();
            { pg8::Gemm g{ON, (const bf16*)(wb + W_AO_OFF), M, D_MODEL, ATTN_W}; pg8::StaticOrder S; S.init(M, D_MODEL, G, bx);
              pg8::EpiGate2 E{T, Gt, MERGED};
              pg8::gemm_phase<pg8::EpiGate2, pg8::StaticOrder, false, true>(lds, g, S, E); }
        } else if ((PHM & 16) && (k == 4 || k == 7)) {
            const bool ff = (k == 7);
            pg8::Gemm g{ff ? Ah : MERGED, (const bf16*)(wb + (ff ? W_F2_OFF : W_O_OFF)), M, D_MODEL, ff ? D_FF : D_MODEL}; pg8::StaticOrder S; S.init(M, D_MODEL, G, bx);
            pg8::EpiF32 E{ff ? Fo : MO, D_MODEL};
            pg8::gemm_phase<pg8::EpiF32, pg8::StaticOrder, false, true>(lds, g, S, E);
        } else if ((PHM & 32) && k == 5) {
            row_phase<true, true>(hbuf, MO, norm_g + (size_t)(l * 4 + 1) * D_MODEL, hbuf, norm_g + (size_t)(l * 4 + 2) * D_MODEL, U, gw, NGW, lane);
        } else if ((PHM & 64) && k == 6) {
            pg8::Gemm g{U, (const bf16*)(wb + W_F1_OFF), M, D_FF, D_MODEL}; pg8::StaticOrder S; S.init(M, D_FF, G, bx);
            pg8::EpiRelu2 E{Ah, D_FF};
            pg8::gemm_phase<pg8::EpiRelu2, pg8::StaticOrder, true, true>(lds, g, S, E);
        }
        if (p + 1 < a.ph_hi) cg::this_grid().sync();
    }
}

constexpr int N_PHASES = DEPTH * 8 + 1;
#ifndef MK_MULTI
#define MK_MULTI 0
#endif

extern "C" void kernel_launch(void* const* d_in, const int* in_sizes, int n_in, void* d_out, int out_size, void* d_ws, size_t ws_size, hipStream_t stream) {
    static int grid = 0;
    if (grid == 0) {
        if (n_in != 12 || out_size != M * D_MODEL || ws_size < WS_END) { fprintf(stderr, "kernel_launch: unexpected shapes (n_in %d out %d ws %zu)\n", n_in, out_size, ws_size); grid = -1; return; }
        int dev = 0, cus = 0, per_cu = 0;
        hipGetDevice(&dev); hipDeviceGetAttribute(&cus, hipDeviceAttributeMultiprocessorCount, dev);
        hipFuncSetAttribute((const void*)mk_fwd, hipFuncAttributeMaxDynamicSharedMemorySize, LDS_BYTES);
        hipOccupancyMaxActiveBlocksPerMultiprocessor(&per_cu, (const void*)mk_fwd, 512, LDS_BYTES);
        (void)hipGetLastError();
        if (per_cu < 1) per_cu = 1;
        grid = cus * 1;
        if (grid != 256) fprintf(stderr, "kernel_launch: note: %d CUs\n", grid);
    }
    if (grid < 0) return;
    Args a{};
    for (int i = 0; i < 12; ++i) a.in[i] = (const float*)d_in[i];
    a.out = (float*)d_out; a.ws = (unsigned char*)d_ws;
#if MK_MULTI
    for (int p = 0; p < N_PHASES; ++p) {
        a.ph_lo = p; a.ph_hi = p + 1;
        hipLaunchKernelGGL(mk_fwd, dim3(grid), dim3(512), LDS_BYTES, stream, a);
    }
#else
    a.ph_lo = 0; a.ph_hi = N_PHASES;
    void* args[] = {&a};
    hipError_t e = hipLaunchCooperativeKernel((const void*)mk_fwd, dim3(grid), dim3(512), args, LDS_BYTES, stream);
    if (e != hipSuccess) fprintf(stderr, "cooperative launch failed: %s (grid %d)\n", hipGetErrorString(e), grid);
#endif
}
```

```cpp
#include <hip/hip_runtime.h>
#include <hip/hip_cooperative_groups.h>
#include <cstdio>
#include <cstdint>
namespace cg = cooperative_groups;
namespace pg8 {
#define PG8_LAS __attribute__((address_space(3)))
typedef unsigned short bf16_t;
typedef short bf16x8 __attribute__((ext_vector_type(8)));
typedef float f32x4 __attribute__((ext_vector_type(4)));
typedef unsigned u32x4 __attribute__((ext_vector_type(4)));
constexpr int BM = 256, BK = 64, HALF = 128, HTB = HALF * BK * 2  , STAGE_BYTES = 8 * HTB, NXCD = 8, WGM = 8;

__host__ __device__ __forceinline__ int lds_byte(int r, int c) { const int st = (r >> 4) * 2 + (c >> 5), rr = r & 15, cc = c & 31, ob = rr * 64 + cc * 2; return st * 1024 + (ob ^ (((ob >> 9) & 1) << 5)); }
__host__ __device__ __forceinline__ void stage_rc(int b, int& R, int& C) { const int st = b / 1024, sb = b % 1024, swz = sb ^ (((sb >> 9) & 1) << 5); R = (st >> 1) * 16 + swz / 64; C = (st & 1) * 32 + (swz % 64) / 2; }
__host__ __device__ __forceinline__ int perm32(int rho) { const int n = rho >> 4, i = rho & 15; return 8 * (i >> 2) + 4 * n + (i & 3); }

struct Unit { int pm, pn; };
struct Gemm { const bf16_t* A; const bf16_t* Bt; int M, N, K; };

struct StaticOrder {
    int nM, nN, nwg, G, c;
    __host__ __device__ void init(int M, int N, int G_, int c_) { nM = M / BM; nN = N / BM; nwg = nM * nN; G = G_; c = c_; }
    __host__ __device__ bool next(int i, Unit& u) const {
        const long L = (long)i * G + c; if (L >= nwg) return false;
        int wgid = (int)L; { const int q = nwg / NXCD, r = nwg % NXCD, xcd = wgid % NXCD, off = wgid / NXCD; wgid = (xcd < r ? xcd * (q + 1) : r * (q + 1) + (xcd - r) * q) + off; }
        const int nig = WGM * nN, gid = wgid / nig, fm = gid * WGM, gsz = (nM - fm) < WGM ? (nM - fm) : WGM;
        u.pm = fm + ((wgid % nig) % gsz); u.pn = (wgid % nig) / gsz; return true;
    }
    __device__ __forceinline__ void a_ready(const Unit&) const {}
    __device__ __forceinline__ void done(const Unit&) const {}
};

__device__ __forceinline__ unsigned cvt_pk_bf16(float lo, float hi) { unsigned r; asm volatile("v_cvt_pk_bf16_f32 %0, %1, %2" : "=v"(r) : "v"(lo), "v"(hi)); return r; }
typedef float f32x2 __attribute__((ext_vector_type(2)));

typedef unsigned u32x4 __attribute__((ext_vector_type(4)));
__device__ __forceinline__ float bf_lo(unsigned w) { return __uint_as_float(w << 16); }
__device__ __forceinline__ float bf_hi(unsigned w) { return __uint_as_float(w & 0xffff0000u); }
__device__ __forceinline__ float fast_sigmoid(float x) { return __builtin_amdgcn_rcpf(1.0f + __builtin_amdgcn_exp2f(-1.4426950408889634f * x)); }

constexpr int SEQ_ = 8192;
struct EpiWin {
    static constexpr bool PERM = true, AFTER_DRAIN = false;
    bf16_t *CONV, *Q, *Kt, *Vt, *G; const float* bgate; float qscale; unsigned* nrm;
    __device__ __forceinline__ void operator()(const f32x4 (&acc)[2][2][4][2], const Unit& u, int wr, int wc, int fr_, int fq_) const {
        int fr = fr_, fq = fq_; asm volatile("" : "+v"(fr), "+v"(fq));
        const int pn = u.pn; const int row0 = u.pm * BM + wr * 64 + fr; const int cl0 = wc * 32 + 8 * fq;
        bf16_t* base; int s_ai, s_m, s_bj; float sc = 1.f; bool gate = false;
        if (pn < 6) { base = CONV + (size_t)row0 * 1536 + pn * 256 + cl0; s_ai = HALF * 1536; s_m = 16 * 1536; s_bj = HALF; }
        else if (pn < 8) { base = Q + (size_t)row0 * 512 + (pn - 6) * 256 + cl0; s_ai = HALF * 512; s_m = 16 * 512; s_bj = HALF; sc = qscale; }
        else if (pn < 10) { const int h0 = (pn - 8) * 2, chunk = cl0 >> 3; const int b = row0 >> 13, s = row0 & (SEQ_ - 1), t = s >> 6, key = s & 63;
            base = Kt + ((size_t)((b * 4 + h0) * 128 + t)) * 8192 + chunk * 512 + key * 8; s_ai = 2 * 8192; s_m = 16 * 8; s_bj = 128 * 8192; }
        else if (pn < 12) { const int h0 = (pn - 10) * 2; const int b = row0 >> 13, s = row0 & (SEQ_ - 1), t = s >> 6, key = s & 63, kg = key >> 3;
            base = Vt + ((size_t)((b * 4 + h0) * 128 + t)) * 8192 + (kg * 4 + wc) * 256 + (key & 7) * 32 + 8 * fq; s_ai = 2 * 8192; s_m = 2 * 4 * 256; s_bj = 128 * 8192; }
        else { base = G + (size_t)row0 * 2048 + (pn - 12) * 256 + cl0; s_ai = HALF * 2048; s_m = 16 * 2048; s_bj = HALF; gate = true; }
        const bool trk = (pn >= 6 && pn < 10); float mx0 = 0.f, mx1 = 0.f;
        f32x4 bv[2][2];
#pragma unroll
        for (int bj = 0; bj < 2; ++bj)
#pragma unroll
            for (int n = 0; n < 2; ++n) bv[bj][n] = gate ? *(const f32x4*)(bgate + (pn - 12) * 256 + cl0 + bj * HALF + 4 * n) : (f32x4){0.f, 0.f, 0.f, 0.f};
#pragma unroll
        for (int ai = 0; ai < 2; ++ai)
#pragma unroll
            for (int m = 0; m < 4; ++m) {
#pragma unroll
                for (int bj = 0; bj < 2; ++bj) {
                    f32x4 v0 = acc[ai][bj][m][0] * sc, v1 = acc[ai][bj][m][1] * sc;
                    if (gate) { v0 = v0 + bv[bj][0]; v1 = v1 + bv[bj][1];
#pragma unroll
                        for (int e = 0; e < 4; ++e) { v0[e] = fast_sigmoid(v0[e]); v1[e] = fast_sigmoid(v1[e]); } }
                    if (trk) { float s = (v0[0] * v0[0] + v0[1] * v0[1]) + (v0[2] * v0[2] + v0[3] * v0[3]) + (v1[0] * v1[0] + v1[1] * v1[1]) + (v1[2] * v1[2] + v1[3] * v1[3]);
                        s += __shfl_xor(s, 16); s += __shfl_xor(s, 32); if (bj == 0) mx0 = fmaxf(mx0, s); else mx1 = fmaxf(mx1, s); }
                    u32x4 w; w.x = cvt_pk_bf16(v0[0], v0[1]); w.y = cvt_pk_bf16(v0[2], v0[3]); w.z = cvt_pk_bf16(v1[0], v1[1]); w.w = cvt_pk_bf16(v1[2], v1[3]);
                    *(u32x4*)(base + (size_t)ai * s_ai + (size_t)m * s_m + (size_t)bj * s_bj) = w;
                }
                asm volatile("" ::: "memory");
            }
        if (trk) {
#pragma unroll
            for (int sft = 1; sft < 16; sft <<= 1) { mx0 = fmaxf(mx0, __shfl_xor(mx0, sft)); mx1 = fmaxf(mx1, __shfl_xor(mx1, sft)); }
            if (fr == 0 && fq == 0) { const int isk = pn >= 8 ? 1 : 0, h0 = ((pn - 6) & 1) * 2, bb = row0 >> 13;
                unsigned* wp = nrm + isk * 32 + (bb * 4 + h0) * 4 + wc;
                atomicMax(wp, __float_as_uint(mx0)); atomicMax(wp + 4, __float_as_uint(mx1)); }
        }
    }
};
struct EpiGate1 {
    static constexpr bool PERM = true, AFTER_DRAIN = false;
    float* T; const bf16_t* G;
    __device__ __forceinline__ void operator()(const f32x4 (&acc)[2][2][4][2], const Unit& u, int wr, int wc, int fr_, int fq_) const {
        int fr = fr_, fq = fq_; asm volatile("" : "+v"(fr), "+v"(fq));
        const int row0 = u.pm * BM + wr * 64 + fr;
#pragma unroll
        for (int ai = 0; ai < 2; ++ai)
#pragma unroll
            for (int m = 0; m < 4; ++m) {
                const int row = row0 + ai * HALF + m * 16;
#pragma unroll
                for (int bj = 0; bj < 2; ++bj) {
                    const int col = u.pn * BM + bj * HALF + wc * 32 + 8 * fq;
                    const u32x4 g = *(const u32x4*)(G + (size_t)row * 2048 + col);
                    f32x4 v0 = acc[ai][bj][m][0], v1 = acc[ai][bj][m][1];
                    v0[0] *= bf_lo(g.x); v0[1] *= bf_hi(g.x); v0[2] *= bf_lo(g.y); v0[3] *= bf_hi(g.y);
                    v1[0] *= bf_lo(g.z); v1[1] *= bf_hi(g.z); v1[2] *= bf_lo(g.w); v1[3] *= bf_hi(g.w);
                    float* d = T + (size_t)row * 1024 + col; *(f32x4*)d = v0; *(f32x4*)(d + 4) = v1;
                }
                asm volatile("" ::: "memory");
            }
    }
};
struct EpiGate2 {
    static constexpr bool PERM = true, AFTER_DRAIN = false;
    const float* T; const bf16_t* G; bf16_t* O;
    __device__ __forceinline__ void operator()(const f32x4 (&acc)[2][2][4][2], const Unit& u, int wr, int wc, int fr_, int fq_) const {
        int fr = fr_, fq = fq_; asm volatile("" : "+v"(fr), "+v"(fq));
        const int row0 = u.pm * BM + wr * 64 + fr;
#pragma unroll
        for (int ai = 0; ai < 2; ++ai)
#pragma unroll
            for (int m = 0; m < 4; ++m) {
                const int row = row0 + ai * HALF + m * 16;
#pragma unroll
                for (int bj = 0; bj < 2; ++bj) {
                    const int col = u.pn * BM + bj * HALF + wc * 32 + 8 * fq;
                    const u32x4 g = *(const u32x4*)(G + (size_t)row * 2048 + 1024 + col);
                    const float* d = T + (size_t)row * 1024 + col; const f32x4 t0 = *(const f32x4*)d, t1 = *(const f32x4*)(d + 4);
                    f32x4 v0 = acc[ai][bj][m][0], v1 = acc[ai][bj][m][1];
                    v0[0] = t0[0] + v0[0] * bf_lo(g.x); v0[1] = t0[1] + v0[1] * bf_hi(g.x); v0[2] = t0[2] + v0[2] * bf_lo(g.y); v0[3] = t0[3] + v0[3] * bf_hi(g.y);
                    v1[0] = t1[0] + v1[0] * bf_lo(g.z); v1[1] = t1[1] + v1[1] * bf_hi(g.z); v1[2] = t1[2] + v1[2] * bf_lo(g.w); v1[3] = t1[3] + v1[3] * bf_hi(g.w);
                    u32x4 w; w.x = cvt_pk_bf16(v0[0], v0[1]); w.y = cvt_pk_bf16(v0[2], v0[3]); w.z = cvt_pk_bf16(v1[0], v1[1]); w.w = cvt_pk_bf16(v1[2], v1[3]);
                    *(u32x4*)(O + (size_t)row * 1024 + col) = w;
                }
                asm volatile("" ::: "memory");
            }
    }
};
struct EpiF32 {
    static constexpr bool PERM = false, AFTER_DRAIN = false;
    float* O; int ldc;
    __device__ __forceinline__ void operator()(const f32x4 (&acc)[2][2][4][2], const Unit& u, int wr, int wc, int fr_, int fq_) const {
        int fr = fr_, fq = fq_; asm volatile("" : "+v"(fr), "+v"(fq));
        const int row0 = u.pm * BM + wr * 64 + fr, col0 = u.pn * BM + wc * 32 + 4 * fq;
#pragma unroll
        for (int ai = 0; ai < 2; ++ai)
#pragma unroll
            for (int m = 0; m < 4; ++m) {
                float* rowp = O + (size_t)(row0 + ai * HALF + m * 16) * ldc + col0;
#pragma unroll
                for (int bj = 0; bj < 2; ++bj)
#pragma unroll
                    for (int n = 0; n < 2; ++n) *(f32x4*)(rowp + bj * HALF + n * 16) = acc[ai][bj][m][n];
            }
    }
};
struct EpiRelu2 {
    static constexpr bool PERM = true, AFTER_DRAIN = false;
    bf16_t* O; int ldc;
    __device__ __forceinline__ void operator()(const f32x4 (&acc)[2][2][4][2], const Unit& u, int wr, int wc, int fr_, int fq_) const {
        int fr = fr_, fq = fq_; asm volatile("" : "+v"(fr), "+v"(fq));
        const int row0 = u.pm * BM + wr * 64 + fr, col0 = u.pn * BM + wc * 32 + 8 * fq;
#pragma unroll
        for (int ai = 0; ai < 2; ++ai)
#pragma unroll
            for (int m = 0; m < 4; ++m) {
                bf16_t* rowp = O + (size_t)(row0 + ai * HALF + m * 16) * ldc + col0;
#pragma unroll
                for (int bj = 0; bj < 2; ++bj) {
                    f32x4 v0 = acc[ai][bj][m][0], v1 = acc[ai][bj][m][1];
#pragma unroll
                    for (int e = 0; e < 4; ++e) { const float a = fmaxf(v0[e], 0.f), b = fmaxf(v1[e], 0.f); v0[e] = a * a; v1[e] = b * b; }
                    u32x4 w; w.x = cvt_pk_bf16(v0[0], v0[1]); w.y = cvt_pk_bf16(v0[2], v0[3]); w.z = cvt_pk_bf16(v1[0], v1[1]); w.w = cvt_pk_bf16(v1[2], v1[3]);
                    *(u32x4*)(rowp + bj * HALF) = w;
                }
            }
    }
};

template <class Epi, class Sched, bool ALIGN_EPI = false, bool SP2 = false>
__device__ __forceinline__ void gemm_phase(PG8_LAS unsigned char* lds, const Gemm g, const Sched& S, const Epi& E) {
    int tid_ = threadIdx.x; asm volatile("" : "+v"(tid_));
    const int tid = tid_, wid = __builtin_amdgcn_readfirstlane(tid >> 6), lane = tid & 63, wr = wid >> 2, wc = wid & 3, fr = lane & 15, fq = lane >> 4;
    const int K = g.K, nt = K / BK;
    unsigned voffA[2], voffB[2];
#pragma unroll
    for (int i = 0; i < 2; ++i) { int R, C; stage_rc(tid * 16 + i * 8192, R, C); const int Rb = Epi::PERM ? ((R & ~31) + perm32(R & 31)) : R;
        voffA[i] = (unsigned)(R * K + C) * 2u; voffB[i] = (unsigned)(Rb * K + C) * 2u; }
    const size_t kstep = (size_t)(BK * 2);
    const size_t hstep = (size_t)HALF * K * 2;
    const size_t tstep = 2 * hstep;
    const unsigned ldsw = (unsigned)wid * 1024u;
    const int aoff = lds_byte(wr * 64 + fr, fq * 8), boff = lds_byte(wc * 32 + fr, fq * 8);
#define PG8_SA(b, h) (((b) * 2 + (h)) * HTB)
#define PG8_SB(b, h) ((4 + (b) * 2 + (h)) * HTB)
#define PG8_STAGE(bufoff, gbase, voff) do { _Pragma("unroll") for (int _i = 0; _i < 2; ++_i) \
        __builtin_amdgcn_global_load_lds((const unsigned*)((const char*)(gbase) + (voff)[_i]), (PG8_LAS unsigned*)(lds + (bufoff) + ldsw + _i * 8192), 16, 0, 0); } while (0)
#define PG8_LDA(dst, b, h) do { _Pragma("unroll") for (int m = 0; m < 4; ++m) _Pragma("unroll") for (int k = 0; k < 2; ++k) dst[m][k] = *(const PG8_LAS bf16x8*)(lds + PG8_SA(b, h) + aoff + m * 2048 + k * 1024); } while (0)
#define PG8_LDB(dst, b, h) do { _Pragma("unroll") for (int n = 0; n < 2; ++n) _Pragma("unroll") for (int k = 0; k < 2; ++k) dst[n][k] = *(const PG8_LAS bf16x8*)(lds + PG8_SB(b, h) + boff + n * 2048 + k * 1024); } while (0)
#define PG8_MMA(ai, bj, At, Bt) do { __builtin_amdgcn_s_setprio(1); _Pragma("unroll") for (int m = 0; m < 4; ++m) _Pragma("unroll") for (int n = 0; n < 2; ++n) _Pragma("unroll") for (int k = 0; k < 2; ++k) \
        acc[ai][bj][m][n] = __builtin_amdgcn_mfma_f32_16x16x32_bf16(Bt[n][k], At[m][k], acc[ai][bj][m][n], 0, 0, 0); __builtin_amdgcn_s_setprio(0); } while (0)
#define PG8_WAIT_V(n) asm volatile("s_waitcnt vmcnt(" #n ")" ::: "memory")
#define PG8_WAIT_L(n) asm volatile("s_waitcnt lgkmcnt(" #n ")" ::: "memory")
#define PG8_BAR __builtin_amdgcn_s_barrier()
#define PG8_SCHED __builtin_amdgcn_sched_barrier(0)
    Unit cur, nxt; int ui = 0;
    if (!S.next(0, cur)) return;
    f32x4 acc[2][2][4][2];
#pragma unroll
    for (int a = 0; a < 2; ++a)
#pragma unroll
        for (int b = 0; b < 2; ++b)
#pragma unroll
            for (int m = 0; m < 4; ++m)
#pragma unroll
                for (int n = 0; n < 2; ++n) acc[a][b][m][n] = (f32x4){0.f, 0.f, 0.f, 0.f};
    bf16x8 At[4][2], B0[2][2], B1[2][2];
    const char* cA = (const char*)g.A + (size_t)cur.pm * tstep; const char* cB = (const char*)g.Bt + (size_t)cur.pn * tstep;
    S.a_ready(cur);
    if constexpr (SP2) {
        PG8_STAGE(PG8_SB(0, 0), cB, voffB); PG8_STAGE(PG8_SB(0, 1), cB + hstep, voffB); PG8_STAGE(PG8_SA(0, 0), cA, voffA); PG8_STAGE(PG8_SA(0, 1), cA + hstep, voffA);
        if (wr == 1) PG8_BAR;
        PG8_WAIT_V(2); PG8_BAR;
        PG8_STAGE(PG8_SB(1, 0), cB + kstep, voffB); PG8_STAGE(PG8_SA(1, 0), cA + kstep, voffA); PG8_STAGE(PG8_SB(1, 1), cB + hstep + kstep, voffB);
        PG8_WAIT_V(6); PG8_BAR;
    } else {
        PG8_STAGE(PG8_SB(0, 0), cB, voffB); PG8_STAGE(PG8_SA(0, 0), cA, voffA); PG8_STAGE(PG8_SB(0, 1), cB + hstep, voffB); PG8_STAGE(PG8_SA(0, 1), cA + hstep, voffA);
        if (wr == 1) PG8_BAR;
        PG8_WAIT_V(4); PG8_BAR;
        PG8_STAGE(PG8_SB(1, 0), cB + kstep, voffB); PG8_STAGE(PG8_SA(1, 0), cA + kstep, voffA); PG8_STAGE(PG8_SB(1, 1), cB + hstep + kstep, voffB);
        PG8_WAIT_V(6); PG8_BAR;
    }
    for (;;) {
        const bool has_next = S.next(ui + 1, nxt);
        const char* nA = has_next ? (const char*)g.A + (size_t)nxt.pm * tstep : cA; const char* nB = has_next ? (const char*)g.Bt + (size_t)nxt.pn * tstep : cB;
        for (int t = 0; t < nt; t += 2) {
            const bool last = (t == nt - 2);
            const char* a1 = cA + (size_t)(t + 1) * kstep;
            const char* a2 = last ? nA : cA + (size_t)(t + 2) * kstep; const char* b2 = last ? nB : cB + (size_t)(t + 2) * kstep;
            const char* a3 = a2 + kstep; const char* b3 = b2 + kstep;
            if (last && has_next) S.a_ready(nxt);
            if constexpr (SP2) {
            PG8_LDB(B0, 0, 0); PG8_LDB(B1, 0, 1); PG8_SCHED; PG8_LDA(At, 0, 0); PG8_STAGE(PG8_SA(1, 1), a1 + hstep, voffA);
            PG8_WAIT_V(8); PG8_WAIT_L(0); PG8_BAR; PG8_MMA(0, 0, At, B0); PG8_MMA(0, 1, At, B1); PG8_BAR; PG8_SCHED;
            PG8_LDA(At, 0, 1); PG8_STAGE(PG8_SB(0, 0), b2, voffB); PG8_STAGE(PG8_SB(0, 1), b2 + hstep, voffB); PG8_STAGE(PG8_SA(0, 0), a2, voffA);
            PG8_WAIT_V(8); PG8_WAIT_L(0); PG8_BAR; PG8_MMA(1, 0, At, B0); PG8_MMA(1, 1, At, B1); PG8_BAR; PG8_SCHED;
            PG8_LDB(B0, 1, 0); PG8_LDB(B1, 1, 1); PG8_SCHED; PG8_LDA(At, 1, 0); PG8_STAGE(PG8_SA(0, 1), a2 + hstep, voffA);
            PG8_WAIT_V(8); PG8_WAIT_L(0); PG8_BAR; PG8_MMA(0, 0, At, B0); PG8_MMA(0, 1, At, B1); PG8_BAR; PG8_SCHED;
            PG8_LDA(At, 1, 1); PG8_STAGE(PG8_SB(1, 0), b3, voffB); PG8_STAGE(PG8_SB(1, 1), b3 + hstep, voffB); PG8_STAGE(PG8_SA(1, 0), a3, voffA);
            PG8_WAIT_V(8); PG8_WAIT_L(0); PG8_BAR; PG8_MMA(1, 0, At, B0); PG8_MMA(1, 1, At, B1); PG8_BAR; PG8_SCHED;
            } else {
            PG8_LDB(B0, 0, 0); PG8_SCHED; PG8_LDA(At, 0, 0); PG8_STAGE(PG8_SA(1, 1), a1 + hstep, voffA);
            PG8_WAIT_L(8); PG8_BAR; PG8_WAIT_L(0); PG8_MMA(0, 0, At, B0); PG8_BAR; PG8_SCHED;
            PG8_LDB(B1, 0, 1); PG8_STAGE(PG8_SB(0, 0), b2, voffB);
            PG8_BAR; PG8_WAIT_L(0); PG8_MMA(0, 1, At, B1); PG8_BAR;
            PG8_LDA(At, 0, 1); PG8_STAGE(PG8_SA(0, 0), a2, voffA);
            PG8_BAR; PG8_WAIT_L(0); PG8_MMA(1, 0, At, B0); PG8_BAR; PG8_SCHED;
            PG8_STAGE(PG8_SB(0, 1), b2 + hstep, voffB);
            PG8_WAIT_V(6); PG8_BAR; PG8_MMA(1, 1, At, B1); PG8_BAR;
            PG8_LDB(B0, 1, 0); PG8_SCHED; PG8_LDA(At, 1, 0); PG8_STAGE(PG8_SA(0, 1), a2 + hstep, voffA);
            PG8_WAIT_L(8); PG8_BAR; PG8_WAIT_L(0); PG8_MMA(0, 0, At, B0); PG8_BAR; PG8_SCHED;
            PG8_LDB(B1, 1, 1); PG8_STAGE(PG8_SB(1, 0), b3, voffB);
            PG8_BAR; PG8_WAIT_L(0); PG8_MMA(0, 1, At, B1); PG8_BAR;
            PG8_LDA(At, 1, 1); PG8_STAGE(PG8_SA(1, 0), a3, voffA);
            PG8_BAR; PG8_WAIT_L(0); PG8_MMA(1, 0, At, B0); PG8_BAR; PG8_SCHED;
            PG8_STAGE(PG8_SB(1, 1), b3 + hstep, voffB);
            PG8_WAIT_V(6); PG8_BAR; PG8_MMA(1, 1, At, B1); PG8_BAR;
            }
        }
        if constexpr (ALIGN_EPI) { if (wr == 0) PG8_BAR; }
        if constexpr (!Epi::AFTER_DRAIN) { E(acc, cur, wr, wc, fr, fq); S.done(cur); }
        if (!has_next) break;
#pragma unroll
        for (int a = 0; a < 2; ++a)
#pragma unroll
            for (int b = 0; b < 2; ++b)
#pragma unroll
                for (int m = 0; m < 4; ++m)
#pragma unroll
                    for (int n = 0; n < 2; ++n) acc[a][b][m][n] = (f32x4){0.f, 0.f, 0.f, 0.f};
        cur = nxt; cA = nA; cB = nB; ++ui;
        if constexpr (ALIGN_EPI) { if (wr == 1) PG8_BAR; }
    }
    PG8_WAIT_V(0);
    if constexpr (!ALIGN_EPI) { if (wr == 0) PG8_BAR; }
    PG8_BAR;
    if constexpr (Epi::AFTER_DRAIN) { E.fused(acc, cur, wr, wc, fr, fq, lds, wid, lane); S.done(cur); }
#undef PG8_SA
#undef PG8_SB
#undef PG8_STAGE
#undef PG8_LDA
#undef PG8_LDB
#undef PG8_MMA
#undef PG8_WAIT_V
#undef PG8_WAIT_L
#undef PG8_BAR
#undef PG8_SCHED
}
}

constexpr int D_MODEL = 1024, BATCH = 2, SEQ = 8192, DEPTH = 4, M = BATCH * SEQ;
constexpr int CONV_W = 512, NHEAD = 4, HEAD_DIM = 64, V_DIM = 128, ATTN_W = 512, D_FF = 4096, IN_W = 5120;
constexpr float EPS = 1e-6f;
constexpr float LOG2E = 1.4426950408889634f;

#define LAS __attribute__((address_space(3)))
typedef unsigned short bf16;
typedef short bf16x8 __attribute__((ext_vector_type(8)));
typedef short s16x4 __attribute__((ext_vector_type(4)));
typedef float f32x4 __attribute__((ext_vector_type(4)));
typedef float f32x16 __attribute__((ext_vector_type(16)));
typedef unsigned u32x4 __attribute__((ext_vector_type(4)));
typedef unsigned u32x2 __attribute__((ext_vector_type(2)));

constexpr size_t MiB = 1u << 20;
constexpr size_t WS_CTL = 0;
constexpr size_t WS_W = 1 * MiB;
constexpr size_t W_IN_OFF = 0, W_CO_OFF = W_IN_OFF + (size_t)IN_W * D_MODEL * 2, W_AO_OFF = W_CO_OFF + (size_t)D_MODEL * CONV_W * 2,
                 W_O_OFF = W_AO_OFF + (size_t)D_MODEL * ATTN_W * 2, W_F1_OFF = W_O_OFF + (size_t)D_MODEL * D_MODEL * 2,
                 W_F2_OFF = W_F1_OFF + (size_t)D_FF * D_MODEL * 2, W_END_OFF = W_F2_OFF + (size_t)D_MODEL * D_FF * 2;
static_assert(WS_W + W_END_OFF <= 32 * MiB, "weights region");
constexpr size_t WS_U = 32 * MiB;
constexpr size_t WS_CONV = 64 * MiB;
constexpr size_t WS_Q = 112 * MiB;
constexpr size_t WS_K = 128 * MiB;
constexpr size_t WS_V = 144 * MiB;
constexpr size_t WS_G = 160 * MiB;
constexpr size_t WS_Z = 224 * MiB;
constexpr size_t WS_ON = 240 * MiB;
constexpr size_t WS_T = 64 * MiB;
constexpr size_t WS_MO = 128 * MiB;
constexpr size_t WS_A = 64 * MiB;
constexpr size_t WS_F = 192 * MiB;
constexpr size_t WS_END = 256 * MiB;

constexpr int LDS_BYTES = 135168;

__device__ __forceinline__ float wave_sum(float v) {
#pragma unroll
    for (int o = 1; o < 64; o <<= 1) v += __shfl_xor(v, o);
    return v;
}
__device__ __forceinline__ unsigned f2bf(float f) { unsigned u = __builtin_bit_cast(unsigned, f); return (u + 0x7fffu + ((u >> 16) & 1u)) >> 16; }
__device__ __forceinline__ unsigned pk2(float lo, float hi) { return f2bf(lo) | (f2bf(hi) << 16); }
__device__ __forceinline__ float bflo(unsigned w) { return __uint_as_float(w << 16); }
__device__ __forceinline__ float bfhi(unsigned w) { return __uint_as_float(w & 0xffff0000u); }

__device__ __forceinline__ void transpose_item(const float* W, int K, int N, bf16* WT, LAS float* scr, int item, int lane) {
    const int nblk = N / 32, kb = item / nblk, nb = item % nblk, k0 = 64 * kb, n0 = 32 * nb;
#pragma unroll 8
    for (int i = 0; i < 32; ++i) { const int kk = 2 * i + (lane >> 5); scr[kk * 33 + (lane & 31)] = W[(size_t)(k0 + kk) * N + n0 + (lane & 31)]; }
    asm volatile("s_waitcnt lgkmcnt(0)" ::: "memory");
    const int c = lane & 7;
#pragma unroll
    for (int j = 0; j < 4; ++j) { const int n = (lane >> 3) + 8 * j; const LAS float* s = scr + (8 * c) * 33 + n;
        u32x4 o; o.x = pk2(s[0 * 33], s[1 * 33]); o.y = pk2(s[2 * 33], s[3 * 33]); o.z = pk2(s[4 * 33], s[5 * 33]); o.w = pk2(s[6 * 33], s[7 * 33]);
        *(u32x4*)(WT + (size_t)(n0 + n) * K + k0 + 8 * c) = o; }
    asm volatile("s_waitcnt lgkmcnt(0)" ::: "memory");
}

struct Args { const float* in[12]; float* out; unsigned char* ws; int ph_lo, ph_hi; };

__device__ __forceinline__ void convert_weights(const Args& a, int l, LAS unsigned char* lds, int gw, int NGW, int wave, int lane) {
    LAS float* scr = (LAS float*)(lds + wave * 16384);
    bf16* wb = (bf16*)(a.ws + WS_W);
    constexpr int I_IN = (D_MODEL / 64) * (IN_W / 32), I_CO = (CONV_W / 64) * (D_MODEL / 32), I_AO = (ATTN_W / 64) * (D_MODEL / 32),
                  I_O = (D_MODEL / 64) * (D_MODEL / 32), I_F1 = (D_MODEL / 64) * (D_FF / 32), I_F2 = (D_FF / 64) * (D_MODEL / 32);
    constexpr int NITEMS = I_IN + I_CO + I_AO + I_O + I_F1 + I_F2;
    const float* w_in = a.in[1] + (size_t)l * D_MODEL * IN_W;
    const float* w_co = a.in[4] + (size_t)l * CONV_W * D_MODEL;
    const float* w_ao = a.in[7] + (size_t)l * ATTN_W * D_MODEL;
    const float* w_o = a.in[8] + (size_t)l * D_MODEL * D_MODEL;
    const float* w_f1 = a.in[10] + (size_t)l * D_MODEL * D_FF;
    const float* w_f2 = a.in[11] + (size_t)l * D_FF * D_MODEL;
    for (int it = gw; it < NITEMS; it += NGW) {
        int r = it;
        if (r < I_IN) { transpose_item(w_in, D_MODEL, IN_W, (bf16*)((unsigned char*)wb + W_IN_OFF), scr, r, lane); continue; } r -= I_IN;
        if (r < I_CO) { transpose_item(w_co, CONV_W, D_MODEL, (bf16*)((unsigned char*)wb + W_CO_OFF), scr, r, lane); continue; } r -= I_CO;
        if (r < I_AO) { transpose_item(w_ao, ATTN_W, D_MODEL, (bf16*)((unsigned char*)wb + W_AO_OFF), scr, r, lane); continue; } r -= I_AO;
        if (r < I_O) { transpose_item(w_o, D_MODEL, D_MODEL, (bf16*)((unsigned char*)wb + W_O_OFF), scr, r, lane); continue; } r -= I_O;
        if (r < I_F1) { transpose_item(w_f1, D_MODEL, D_FF, (bf16*)((unsigned char*)wb + W_F1_OFF), scr, r, lane); continue; } r -= I_F1;
        transpose_item(w_f2, D_FF, D_MODEL, (bf16*)((unsigned char*)wb + W_F2_OFF), scr, r, lane);
    }
}

template <bool ADD, bool NORM>
__device__ __forceinline__ void row_phase(const float* hin, const float* F, const float* gA, float* hout, const float* gB, bf16* U, int gw, int NGW, int lane) {
    f32x4 ga[4], gb[4];
#pragma unroll
    for (int j = 0; j < 4; ++j) { ga[j] = ADD ? ((const f32x4*)gA)[lane + 64 * j] : (f32x4){0.f, 0.f, 0.f, 0.f}; gb[j] = NORM ? ((const f32x4*)gB)[lane + 64 * j] : (f32x4){0.f, 0.f, 0.f, 0.f}; }
    for (int m = gw; m < M; m += NGW) {
        f32x4 v[4];
#pragma unroll
        for (int j = 0; j < 4; ++j) v[j] = ((const f32x4*)(hin + (size_t)m * D_MODEL))[lane + 64 * j];
        if (ADD) {
            f32x4 f[4]; float ss = 0.f;
#pragma unroll
            for (int j = 0; j < 4; ++j) { f[j] = ((const f32x4*)(F + (size_t)m * D_MODEL))[lane + 64 * j]; ss += (f[j].x * f[j].x + f[j].y * f[j].y) + (f[j].z * f[j].z + f[j].w * f[j].w); }
            const float r = 1.0f / sqrtf(wave_sum(ss) * (1.0f / D_MODEL) + EPS);
#pragma unroll
            for (int j = 0; j < 4; ++j) v[j] = v[j] + f[j] * r * ga[j];
        }
#pragma unroll
        for (int j = 0; j < 4; ++j) ((f32x4*)(hout + (size_t)m * D_MODEL))[lane + 64 * j] = v[j];
        if (NORM) {
            float ss = 0.f;
#pragma unroll
            for (int j = 0; j < 4; ++j) ss += (v[j].x * v[j].x + v[j].y * v[j].y) + (v[j].z * v[j].z + v[j].w * v[j].w);
            const float r = 1.0f / sqrtf(wave_sum(ss) * (1.0f / D_MODEL) + EPS);
            u32x2* o8 = (u32x2*)(U + (size_t)m * D_MODEL) + lane;
#pragma unroll
            for (int j = 0; j < 4; ++j) { const f32x4 y = v[j] * r * gb[j]; u32x2 w; w.x = pk2(y.x, y.y); w.y = pk2(y.z, y.w); o8[64 * j] = w; }
        }
    }
}

__device__ __forceinline__ void conv_items(const bf16* CONV, const float* cw, bf16* Z, int gw, int NGW, int lane) {
    const int c = lane * 8;
    float w0[8], w1[8], w2[8];
#pragma unroll
    for (int e = 0; e < 8; ++e) { w0[e] = cw[c + e]; w1[e] = cw[CONV_W + c + e]; w2[e] = cw[2 * CONV_W + c + e]; }
    for (int it = gw; it < M / 8; it += NGW) {
        const int t0 = it * 8, s0 = t0 & (SEQ - 1);
        float prev[8], cur[8], nxt[8];
#define INNER(dst, t) do { const u32x4 hh = *(const u32x4*)(CONV + (size_t)(t) * 1536 + c), cc = *(const u32x4*)(CONV + (size_t)(t) * 1536 + 1024 + c); \
            dst[0] = bflo(hh.x) * bflo(cc.x); dst[1] = bfhi(hh.x) * bfhi(cc.x); dst[2] = bflo(hh.y) * bflo(cc.y); dst[3] = bfhi(hh.y) * bfhi(cc.y); \
            dst[4] = bflo(hh.z) * bflo(cc.z); dst[5] = bfhi(hh.z) * bfhi(cc.z); dst[6] = bflo(hh.w) * bflo(cc.w); dst[7] = bfhi(hh.w) * bfhi(cc.w); } while (0)
        if (s0 > 0) { INNER(prev, t0 - 1); } else {
#pragma unroll
            for (int e = 0; e < 8; ++e) prev[e] = 0.f; }
        INNER(cur, t0);
#pragma unroll
        for (int j = 0; j < 8; ++j) {
            const int t = t0 + j;
            if (s0 + j + 1 < SEQ) { INNER(nxt, t + 1); } else {
#pragma unroll
                for (int e = 0; e < 8; ++e) nxt[e] = 0.f; }
            const u32x4 bb = *(const u32x4*)(CONV + (size_t)t * 1536 + 512 + c);
            float z[8];
#pragma unroll
            for (int e = 0; e < 8; ++e) z[e] = prev[e] * w0[e] + cur[e] * w1[e] + nxt[e] * w2[e];
            z[0] *= bflo(bb.x); z[1] *= bfhi(bb.x); z[2] *= bflo(bb.y); z[3] *= bfhi(bb.y); z[4] *= bflo(bb.z); z[5] *= bfhi(bb.z); z[6] *= bflo(bb.w); z[7] *= bfhi(bb.w);
            u32x4 o; o.x = pk2(z[0], z[1]); o.y = pk2(z[2], z[3]); o.z = pk2(z[4], z[5]); o.w = pk2(z[6], z[7]);
            *(u32x4*)(Z + (size_t)t * CONV_W + c) = o;
#pragma unroll
            for (int e = 0; e < 8; ++e) { prev[e] = cur[e]; cur[e] = nxt[e]; }
        }
#undef INNER
    }
}

__device__ __forceinline__ int crow(int r, int hi) { return (r & 3) + 8 * (r >> 2) + 4 * hi; }
typedef float f32x2_t __attribute__((ext_vector_type(2))); typedef __bf16 bf16x2_t __attribute__((ext_vector_type(2)));
__device__ __forceinline__ unsigned cvtpk(float lo, float hi) { f32x2_t v = {lo, hi}; bf16x2_t b = __builtin_convertvector(v, bf16x2_t); return __builtin_bit_cast(unsigned, b); }
typedef short v4i16_t __attribute__((ext_vector_type(4)));
__device__ __forceinline__ s16x4 vtr(const LAS unsigned char* p) { return __builtin_bit_cast(s16x4, __builtin_amdgcn_ds_read_tr16_b64_v4i16((LAS v4i16_t*)p)); }
constexpr float ATT_T = 32.0f;
#define MFMA32(a, b, c) __builtin_amdgcn_mfma_f32_32x32x16_bf16((a), (b), (c), 0, 0, 0)

__device__ __forceinline__ void attn_unit(int b, int h, int qb, int t_lo, int t_hi, const bf16* Q, const bf16* Kt, const bf16* Vt, bf16* ON, LAS unsigned char* lds,
                                          float lam, float slope2, const float* subg, float post) {
    int tid_ = threadIdx.x; asm volatile("" : "+v"(tid_));
    const int tid = tid_, lane = tid & 63, r = lane & 31, hi = lane >> 5;
    const int wid = __builtin_amdgcn_readfirstlane(tid >> 6), map = wid >> 2, qs = wid & 3;
    const int q0 = qb * 128 + qs * 32;
    const size_t tokbase = (size_t)b * SEQ;
    bf16x8 qf[4];
    { const bf16* qp = Q + (tokbase + q0 + r) * ATTN_W + h * 128 + map * 64 + hi * 8;
#pragma unroll
      for (int ks = 0; ks < 4; ++ks) qf[ks] = *(const bf16x8*)(qp + ks * 16); }
    const unsigned char* ktg = (const unsigned char*)Kt + (size_t)((b * 4 + h) * 128) * 16384 + wid * 1024 + lane * 16;
    const unsigned char* vtg = (const unsigned char*)Vt + (size_t)((b * 4 + h) * 128) * 16384 + wid * 1024 + lane * 16;
#define ISSUE(t, buf) do { const size_t go_ = (size_t)(t) * 16384; LAS unsigned char* lb_ = lds + (buf) * 32768 + wid * 1024; \
        __builtin_amdgcn_global_load_lds((const unsigned*)(ktg + go_), (LAS unsigned*)(lb_), 16, 0, 0); \
        __builtin_amdgcn_global_load_lds((const unsigned*)(ktg + go_ + 8192), (LAS unsigned*)(lb_ + 8192), 16, 0, 0); \
        __builtin_amdgcn_global_load_lds((const unsigned*)(vtg + go_), (LAS unsigned*)(lb_ + 16384), 16, 0, 0); \
        __builtin_amdgcn_global_load_lds((const unsigned*)(vtg + go_ + 8192), (LAS unsigned*)(lb_ + 16384 + 8192), 16, 0, 0); } while (0)
    f32x16 o[4];
#pragma unroll
    for (int cb = 0; cb < 4; ++cb)
#pragma unroll
        for (int i = 0; i < 16; ++i) o[cb][i] = 0.f;
    float mrun = -1e30f, lsum = 0.f;
    LAS float* wsf = (LAS float*)(lds + 65536) + wid * 64;
    const LAS unsigned char* kfb = lds + (map * 8 + hi) * 1024 + r * 16;
    const LAS unsigned char* vfb = lds + 16384 + (4 * hi + ((lane & 15) >> 2)) * 64 + ((lane >> 4) & 1) * 32 + (lane & 3) * 8;
    ISSUE(t_lo, 0);
    asm volatile("s_waitcnt vmcnt(0)" ::: "memory");
    __syncthreads();
    for (int t = t_lo; t < t_hi; ++t) {
        const int cur = (t - t_lo) & 1;
        if (t + 1 < t_hi) ISSUE(t + 1, cur ^ 1);
        f32x16 p0, p1;
#pragma unroll
        for (int i = 0; i < 16; ++i) { p0[i] = 0.f; p1[i] = 0.f; }
        const LAS unsigned char* kc = kfb + cur * 32768;
#pragma unroll
        for (int ks = 0; ks < 4; ++ks) {
            const bf16x8 a0 = *(const LAS bf16x8*)(kc + ks * 2048), a1 = *(const LAS bf16x8*)(kc + ks * 2048 + 512);
            p0 = MFMA32(a0, qf[ks], p0); p1 = MFMA32(a1, qf[ks], p1);
        }
        const float dq = (float)(q0 + r - t * 64 - 4 * hi);
        float tmax = -1e30f;
#pragma unroll
        for (int i = 0; i < 16; ++i) {
            const float c0 = (float)((i & 3) + 8 * (i >> 2));
            p0[i] = __builtin_fmaf(-slope2, __builtin_fabsf(dq - c0), p0[i]);
            p1[i] = __builtin_fmaf(-slope2, __builtin_fabsf(dq - (c0 + 32.f)), p1[i]);
            tmax = fmaxf(tmax, fmaxf(p0[i], p1[i]));
        }
        tmax = fmaxf(tmax, __shfl_xor(tmax, 32));
        if (__any(tmax > mrun)) {
            const float mnew = fmaxf(mrun, tmax), alpha = __builtin_amdgcn_exp2f(mrun - mnew);
            lsum *= alpha; mrun = mnew;
            if (hi == 0) wsf[r] = alpha;
            asm volatile("s_waitcnt lgkmcnt(0)" ::: "memory");
#pragma unroll
            for (int i = 0; i < 16; ++i) { const float ai = wsf[crow(i, hi)];
#pragma unroll
                for (int cb = 0; cb < 4; ++cb) o[cb][i] *= ai; }
            asm volatile("s_waitcnt lgkmcnt(0)" ::: "memory");
        }
        float ls = 0.f;
#pragma unroll
        for (int i = 0; i < 16; ++i) { p0[i] = __builtin_amdgcn_exp2f(p0[i] - mrun); p1[i] = __builtin_amdgcn_exp2f(p1[i] - mrun); ls += p0[i] + p1[i]; }
        lsum += ls;
        bf16x8 pk[4];
        { u32x4 w;
          w.x = cvtpk(p0[0], p0[1]); w.y = cvtpk(p0[2], p0[3]); w.z = cvtpk(p0[4], p0[5]); w.w = cvtpk(p0[6], p0[7]); pk[0] = __builtin_bit_cast(bf16x8, w);
          w.x = cvtpk(p0[8], p0[9]); w.y = cvtpk(p0[10], p0[11]); w.z = cvtpk(p0[12], p0[13]); w.w = cvtpk(p0[14], p0[15]); pk[1] = __builtin_bit_cast(bf16x8, w);
          w.x = cvtpk(p1[0], p1[1]); w.y = cvtpk(p1[2], p1[3]); w.z = cvtpk(p1[4], p1[5]); w.w = cvtpk(p1[6], p1[7]); pk[2] = __builtin_bit_cast(bf16x8, w);
          w.x = cvtpk(p1[8], p1[9]); w.y = cvtpk(p1[10], p1[11]); w.z = cvtpk(p1[12], p1[13]); w.w = cvtpk(p1[14], p1[15]); pk[3] = __builtin_bit_cast(bf16x8, w); }
        const LAS unsigned char* vc = vfb + cur * 32768;
#pragma unroll
        for (int S = 0; S < 4; ++S)
#pragma unroll
            for (int cb = 0; cb < 4; ++cb) {
                const s16x4 lo = vtr(vc + ((2 * S) * 4 + cb) * 512), hh = vtr(vc + ((2 * S + 1) * 4 + cb) * 512);
                const bf16x8 vf = __builtin_shufflevector(lo, hh, 0, 1, 2, 3, 4, 5, 6, 7);
                o[cb] = MFMA32(pk[S], vf, o[cb]);
            }
        asm volatile("s_waitcnt vmcnt(0)" ::: "memory");
        __syncthreads();
    }
#undef ISSUE
    lsum += __shfl_xor(lsum, 32);
    float inv = 1.0f / lsum; if (map == 1) inv *= lam;
    if (hi == 0) wsf[r] = inv;
    asm volatile("s_waitcnt lgkmcnt(0)" ::: "memory");
#pragma unroll
    for (int i = 0; i < 16; ++i) { const float si = wsf[crow(i, hi)];
#pragma unroll
        for (int cb = 0; cb < 4; ++cb) o[cb][i] *= si; }
    LAS float* xch = (LAS float*)lds + qs * 4096;
    if (map == 1) {
#pragma unroll
        for (int cb = 0; cb < 4; ++cb)
#pragma unroll
            for (int i = 0; i < 16; ++i) xch[(cb * 16 + i) * 64 + lane] = o[cb][i];
    }
    __syncthreads();
    if (map == 0) {
        float ss[16];
#pragma unroll
        for (int i = 0; i < 16; ++i) { ss[i] = 0.f;
#pragma unroll
            for (int cb = 0; cb < 4; ++cb) { o[cb][i] -= xch[(cb * 16 + i) * 64 + lane]; ss[i] += o[cb][i] * o[cb][i]; } }
#pragma unroll
        for (int i = 0; i < 16; ++i) {
#pragma unroll
            for (int sft = 1; sft < 32; sft <<= 1) ss[i] += __shfl_xor(ss[i], sft);
            ss[i] = post / sqrtf(ss[i] * (1.0f / V_DIM) + EPS);
        }
#pragma unroll
        for (int cb = 0; cb < 4; ++cb) { const float g = subg[cb * 32 + r];
#pragma unroll
            for (int i = 0; i < 16; ++i) ON[(tokbase + q0 + crow(i, hi)) * ATTN_W + h * 128 + cb * 32 + r] = (bf16)f2bf(o[cb][i] * ss[i] * g); }
    }
    __syncthreads();
}

#define XB_TMO      128
#define XB_XCNT(j)  (256  + 64 * (j))
#define XB_XSUB(j)  (1280 + 64 * (j))
#define XB_XGEN(j)  (2304 + 64 * (j))
#define XB_TOP      3328
#define XB_TOPGEN   3392
#define XCD_BAR_WORDS 3456
#define XB_SPIN_CAP (1u << 18)

__device__ __forceinline__ unsigned xb_ld(unsigned* p)              { return __hip_atomic_load(p, __ATOMIC_RELAXED, __HIP_MEMORY_SCOPE_AGENT); }
__device__ __forceinline__ unsigned xb_add(unsigned* p, unsigned v) { return __hip_atomic_fetch_add(p, v, __ATOMIC_RELAXED, __HIP_MEMORY_SCOPE_AGENT); }
__device__ __forceinline__ unsigned xb_xcc_id() { return (unsigned)__builtin_amdgcn_s_getreg((3 << 11) | 20) & 0xFu; }
#define XB_SPIN(cond, bar) do { unsigned _sp = 0; while (cond) { __builtin_amdgcn_s_sleep(1); \
    if ((++_sp & 255u) == 0u) { if (xb_ld(&(bar)[XB_TMO])) break; if (_sp > XB_SPIN_CAP) { atomicAdd(&(bar)[XB_TMO], 1u); break; } } } } while (0)

struct XcdBarrier {
    unsigned* bar; unsigned x;
    volatile LAS unsigned* st;
};

__device__ __forceinline__ XcdBarrier xcd_barrier_post(unsigned* bar, volatile LAS unsigned* st) {
    XcdBarrier b; b.bar = bar; b.x = xb_xcc_id(); b.st = st;
    if (threadIdx.x == 0) (void)xb_add(&bar[XB_XCNT(b.x)], 1u);
    return b;
}
__device__ __forceinline__ void xcd_barrier_complete(unsigned* bar, unsigned x, unsigned& nloc, unsigned& nx) {
    const unsigned G = gridDim.x * gridDim.y * gridDim.z;
    unsigned sum, cnt, mine, sp = 0u;
    for (;;) {
        sum = 0u; cnt = 0u; mine = 0u;
#pragma unroll
        for (unsigned j = 0; j < 16; ++j) { const unsigned c = xb_ld(&bar[XB_XCNT(j)]); sum += c; cnt += (c > 0u) ? 1u : 0u; mine = (j == x) ? c : mine; }
        if (sum == G) break;
        __builtin_amdgcn_s_sleep(1);
        if ((++sp & 255u) == 0u) { if (xb_ld(&bar[XB_TMO])) break; if (sp > XB_SPIN_CAP) { atomicAdd(&bar[XB_TMO], 1u); break; } }
    }
    nloc = mine > 0u ? mine : 1u; nx = cnt > 0u ? cnt : 1u;
}

__device__ __forceinline__ void xcd_barrier(const XcdBarrier& b) {
    asm volatile("s_waitcnt vmcnt(0)" ::: "memory");
    __syncthreads();
    if (threadIdx.x == 0) {
        unsigned* bar = b.bar;
        __builtin_amdgcn_s_waitcnt(0);
        unsigned nloc = b.st[0], nx = b.st[1];
        if (nloc == 0u) { xcd_barrier_complete(bar, b.x, nloc, nx); b.st[0] = nloc; b.st[1] = nx; }
        const unsigned old = xb_add(&bar[XB_XSUB(b.x)], 1u);
        const unsigned gen = old / nloc;
        if (old + 1u == (gen + 1u) * nloc) {
            __builtin_amdgcn_fence(__ATOMIC_RELEASE, "agent");
            asm volatile("s_waitcnt vmcnt(0)" ::: "memory");
            const unsigned og = xb_add(&bar[XB_TOP], 1u);
            const unsigned tg = og / nx;
            if (og + 1u == (tg + 1u) * nx) xb_add(&bar[XB_TOPGEN], 1u);
            else XB_SPIN(xb_ld(&bar[XB_TOPGEN]) == tg, bar);
            __builtin_amdgcn_fence(__ATOMIC_ACQUIRE, "agent");
            xb_add(&bar[XB_XGEN(b.x)], 1u);
            asm volatile("s_waitcnt vmcnt(0)" ::: "memory");
        } else {
            XB_SPIN(xb_ld(&bar[XB_XGEN(b.x)]) == gen, bar);
            __builtin_amdgcn_fence(__ATOMIC_ACQUIRE, "agent");
            asm volatile("s_waitcnt vmcnt(0)" ::: "memory");
        }
    }
    __syncthreads();
}


#ifndef REP_ATT
#define REP_ATT 1
#endif
#ifndef REP_GEMM
#define REP_GEMM 1
#endif
#ifndef PHM
#define PHM 127
#endif
__global__ void __launch_bounds__(512) mk_fwd(Args a) {
    extern __shared__ __attribute__((aligned(16))) unsigned char lds_raw[];
    LAS unsigned char* lds = (LAS unsigned char*)lds_raw;
    const int G = gridDim.x, bx = blockIdx.x;
    volatile LAS unsigned* MISC = (volatile LAS unsigned*)(lds + 131072 + 64);
    if (threadIdx.x < 4) MISC[threadIdx.x] = 0u;
    __syncthreads();
    XcdBarrier xbar; xbar.bar = nullptr; xbar.x = 0; xbar.st = MISC;
    for (int p = a.ph_lo; p < a.ph_hi; ++p) {
        const int l = p >> 3, k = p & 7;
        int tid_ = threadIdx.x; asm volatile("" : "+v"(tid_));
        const int tid = tid_, lane = tid & 63, wave = __builtin_amdgcn_readfirstlane(tid >> 6);
        const int gw = bx * 8 + wave, NGW = G * 8;
    unsigned char* ws = a.ws; asm volatile("" : "+s"(ws));
    bf16* U = (bf16*)(ws + WS_U); bf16* CONV = (bf16*)(ws + WS_CONV); bf16* Qb = (bf16*)(ws + WS_Q); bf16* Kt = (bf16*)(ws + WS_K); bf16* Vt = (bf16*)(ws + WS_V);
    bf16* Gt = (bf16*)(ws + WS_G); bf16* Z = (bf16*)(ws + WS_Z); bf16* ON = (bf16*)(ws + WS_ON); float* T = (float*)(ws + WS_T); float* MO = (float*)(ws + WS_MO);
    bf16* Ah = (bf16*)(ws + WS_A); float* Fo = (float*)(ws + WS_F); bf16* MERGED = U;
    const unsigned char* wb = ws + WS_W;
    float* hbuf = a.out;
    const float* norm_g = a.in[9];
        unsigned* ctl = (unsigned*)(ws + WS_CTL);
        if ((PHM & 1) && k == 0) {
            if (p == 0 && bx == 0) { for (int i = tid; i < 8192; i += 512) ctl[i] = 0u; }
            if (l < DEPTH) convert_weights(a, l, lds, gw, NGW, wave, lane);
            if (l == 0) row_phase<false, true>(a.in[0], nullptr, nullptr, hbuf, norm_g + (size_t)(0 * 4 + 0) * D_MODEL, U, gw, NGW, lane);
            else if (l < DEPTH) row_phase<true, true>(hbuf, Fo, norm_g + (size_t)((l - 1) * 4 + 3) * D_MODEL, hbuf, norm_g + (size_t)(l * 4 + 0) * D_MODEL, U, gw, NGW, lane);
            else row_phase<true, false>(hbuf, Fo, norm_g + (size_t)((l - 1) * 4 + 3) * D_MODEL, hbuf, nullptr, nullptr, gw, NGW, lane);
        } else if ((PHM & 2) && k == 1) {
            pg8::Gemm g{U, (const bf16*)(wb + W_IN_OFF), M, IN_W, D_MODEL}; pg8::StaticOrder S; S.init(M, IN_W, G, bx);
            pg8::EpiWin E{CONV, Qb, Kt, Vt, Gt, a.in[2] + (size_t)l * 2 * D_MODEL, 0.125f * LOG2E, ctl + 1024 + l * 64};
            for (int rep = 0; rep < REP_GEMM; ++rep) pg8::gemm_phase<pg8::EpiWin, pg8::StaticOrder, true, true>(lds, g, S, E);
        } else if ((PHM & 4) && k == 2) {
            conv_items(CONV, a.in[3] + (size_t)l * 3 * CONV_W, Z, gw, NGW, lane);
            const float lam_init = 0.8f - 0.6f * expf(-0.3f * (float)l);
            const float* lq = a.in[5] + (size_t)l * 4 * HEAD_DIM;
            const float s1 = wave_sum(lq[lane] * lq[64 + lane]), s2 = wave_sum(lq[128 + lane] * lq[192 + lane]);
            const float lam = expf(s1) - expf(s2) + lam_init;
            const float* subg = a.in[6] + (size_t)l * V_DIM;
            LAS unsigned* sq = (LAS unsigned*)(lds + 65536 + 2048);
            const unsigned* nq = ctl + 1024 + l * 64; const unsigned* nk = nq + 32;
            for (int rep = 0; rep < REP_ATT; ++rep)
            for (;;) {
                __syncthreads();
                if (tid == 0) sq[0] = atomicAdd(ctl + l * 64 + rep * 16, 1u);
                __syncthreads();
                const int u = (int)sq[0];
                if (u >= 512) break;
                const int h = 3 - (u >> 7), idx = u & 127, b = idx & 1, jj = idx >> 1, qb = (jj & 1) ? 31 - (jj >> 1) : 32 + (jj >> 1);
                const float slope2 = exp2f(-2.0f * (float)(h + 1)) * LOG2E;
                const unsigned* wq = nq + (b * 4 + h) * 4; const unsigned* wk = nk + (b * 4 + h) * 4;
                const float B0 = sqrtf((__uint_as_float(wq[0]) + __uint_as_float(wq[1])) * (__uint_as_float(wk[0]) + __uint_as_float(wk[1])));
                const float B1 = sqrtf((__uint_as_float(wq[2]) + __uint_as_float(wq[3])) * (__uint_as_float(wk[2]) + __uint_as_float(wk[3])));
                const float Wf = (2.04f * fmaxf(B0, B1) + ATT_T) / slope2;
                const int W = Wf < 16384.f ? (int)Wf + 1 : 16384;
                const int q0b = qb * 128;
                int t_lo = (q0b - W) >> 6; if (t_lo < 0) t_lo = 0;
                int t_hi = ((q0b + 127 + W) >> 6) + 1; if (t_hi > SEQ / 64) t_hi = SEQ / 64;
                attn_unit(b, h, qb, t_lo, t_hi, Qb, Kt, Vt, ON, lds, lam, slope2, subg, 1.0f - lam_init);
            }
        } else if ((PHM & 8) && k == 3) {
            { pg8::Gemm g{Z, (const bf16*)(wb + W_CO_OFF), M, D_MODEL, CONV_W}; pg8::StaticOrder S; S.init(M, D_MODEL, G, bx);
              pg8::EpiGate1 E{T, Gt};
              for (int rep = 0; rep < REP_GEMM; ++rep) pg8::gemm_phase<pg8::EpiGate1, pg8::StaticOrder, false, true>(lds, g, S, E); }
            __syncthreads();
            { pg8::Gemm g{ON, (const bf16*)(wb + W_AO_OFF), M, D_MODEL, ATTN_W}; pg8::StaticOrder S; S.init(M, D_MODEL, G, bx);
              pg8::EpiGate2 E{T, Gt, MERGED};
              for (int rep = 0; rep < REP_GEMM; ++rep) pg8::gemm_phase<pg8::EpiGate2, pg8::StaticOrder, false, true>(lds, g, S, E); }
        } else if ((PHM & 16) && (k == 4 || k == 7)) {
            const bool ff = (k == 7);
            pg8::Gemm g{ff ? Ah : MERGED, (const bf16*)(wb + (ff ? W_F2_OFF : W_O_OFF)), M, D_MODEL, ff ? D_FF : D_MODEL}; pg8::StaticOrder S; S.init(M, D_MODEL, G, bx);
            pg8::EpiF32 E{ff ? Fo : MO, D_MODEL};
            for (int rep = 0; rep < REP_GEMM; ++rep) pg8::gemm_phase<pg8::EpiF32, pg8::StaticOrder, false, true>(lds, g, S, E);
        } else if ((PHM & 32) && k == 5) {
            row_phase<true, true>(hbuf, MO, norm_g + (size_t)(l * 4 + 1) * D_MODEL, hbuf, norm_g + (size_t)(l * 4 + 2) * D_MODEL, U, gw, NGW, lane);
        } else if ((PHM & 64) && k == 6) {
            pg8::Gemm g{U, (const bf16*)(wb + W_F1_OFF), M, D_FF, D_MODEL}; pg8::StaticOrder S; S.init(M, D_FF, G, bx);
            pg8::EpiRelu2 E{Ah, D_FF};
            for (int rep = 0; rep < REP_GEMM; ++rep) pg8::gemm_phase<pg8::EpiRelu2, pg8::StaticOrder, true, true>(lds, g, S, E);
        }
        if (p + 1 < a.ph_hi) {
            if (p == a.ph_lo) { cg::this_grid().sync(); xbar = xcd_barrier_post(ctl + 4096, MISC); }
            else xcd_barrier(xbar);
        }
    }
}

constexpr int N_PHASES = DEPTH * 8 + 1;
#ifndef MK_MULTI
#define MK_MULTI 0
#endif

extern "C" void kernel_launch(void* const* d_in, const int* in_sizes, int n_in, void* d_out, int out_size, void* d_ws, size_t ws_size, hipStream_t stream) {
    static int grid = 0;
    if (grid == 0) {
        if (n_in != 12 || out_size != M * D_MODEL || ws_size < WS_END) { fprintf(stderr, "kernel_launch: unexpected shapes (n_in %d out %d ws %zu)\n", n_in, out_size, ws_size); grid = -1; return; }
        int dev = 0, cus = 0, per_cu = 0;
        hipGetDevice(&dev); hipDeviceGetAttribute(&cus, hipDeviceAttributeMultiprocessorCount, dev);
        hipFuncSetAttribute((const void*)mk_fwd, hipFuncAttributeMaxDynamicSharedMemorySize, LDS_BYTES);
        hipOccupancyMaxActiveBlocksPerMultiprocessor(&per_cu, (const void*)mk_fwd, 512, LDS_BYTES);
        (void)hipGetLastError();
        if (per_cu < 1) per_cu = 1;
        grid = cus * 1;
        if (grid != 256) fprintf(stderr, "kernel_launch: note: %d CUs\n", grid);
    }
    if (grid < 0) return;
    Args a{};
    for (int i = 0; i < 12; ++i) a.in[i] = (const float*)d_in[i];
    a.out = (float*)d_out; a.ws = (unsigned char*)d_ws;
#if MK_MULTI
    for (int p = 0; p < N_PHASES; ++p) {
        a.ph_lo = p; a.ph_hi = p + 1;
        hipLaunchKernelGGL(mk_fwd, dim3(grid), dim3(512), LDS_BYTES, stream, a);
    }
#else
    a.ph_lo = 0; a.ph_hi = N_PHASES;
    void* args[] = {&a};
    hipError_t e = hipLaunchCooperativeKernel((const void*)mk_fwd, dim3(grid), dim3(512), args, LDS_BYTES, stream);
    if (e != hipSuccess) fprintf(stderr, "cooperative launch failed: %s (grid %d)\n", hipGetErrorString(e), grid);
#endif
}
```

```cpp
#include <hip/hip_runtime.h>
#include <hip/hip_cooperative_groups.h>
#include <cstdio>
#include <cstdint>
namespace cg = cooperative_groups;
namespace pg8 {
#define PG8_LAS __attribute__((address_space(3)))
#define PG8_GAS __attribute__((address_space(1)))
typedef unsigned short bf16_t;
typedef short bf16x8 __attribute__((ext_vector_type(8)));
typedef float f32x4 __attribute__((ext_vector_type(4)));
typedef unsigned u32x4 __attribute__((ext_vector_type(4)));
constexpr int BM = 256, BK = 64, HALF = 128, HTB = HALF * BK * 2  , STAGE_BYTES = 8 * HTB, NXCD = 8, WGM = 8;

__host__ __device__ __forceinline__ int lds_byte(int r, int c) { const int st = (r >> 4) * 2 + (c >> 5), rr = r & 15, cc = c & 31, ob = rr * 64 + cc * 2; return st * 1024 + (ob ^ (((ob >> 9) & 1) << 5)); }
__host__ __device__ __forceinline__ void stage_rc(int b, int& R, int& C) { const int st = b / 1024, sb = b % 1024, swz = sb ^ (((sb >> 9) & 1) << 5); R = (st >> 1) * 16 + swz / 64; C = (st & 1) * 32 + (swz % 64) / 2; }
__host__ __device__ __forceinline__ int perm32(int rho) { const int n = rho >> 4, i = rho & 15; return 8 * (i >> 2) + 4 * n + (i & 3); }

struct Unit { int pm, pn; };
struct Gemm { const bf16_t* A; const bf16_t* Bt; int M, N, K; };

struct StaticOrder {
    int nM, nN, nwg, G, c;
    __host__ __device__ void init(int M, int N, int G_, int c_) { nM = M / BM; nN = N / BM; nwg = nM * nN; G = G_; c = c_; }
    __host__ __device__ bool next(int i, Unit& u) const {
        const long L = (long)i * G + c; if (L >= nwg) return false;
        int wgid = (int)L; { const int q = nwg / NXCD, r = nwg % NXCD, xcd = wgid % NXCD, off = wgid / NXCD; wgid = (xcd < r ? xcd * (q + 1) : r * (q + 1) + (xcd - r) * q) + off; }
        const int nig = WGM * nN, gid = wgid / nig, fm = gid * WGM, gsz = (nM - fm) < WGM ? (nM - fm) : WGM;
        u.pm = fm + ((wgid % nig) % gsz); u.pn = (wgid % nig) / gsz; return true;
    }
    __device__ __forceinline__ void a_ready(const Unit&) const {}
    __device__ __forceinline__ void done(const Unit&) const {}
};

__device__ __forceinline__ unsigned cvt_pk_bf16(float lo, float hi) { unsigned r; asm volatile("v_cvt_pk_bf16_f32 %0, %1, %2" : "=v"(r) : "v"(lo), "v"(hi)); return r; }
typedef float f32x2 __attribute__((ext_vector_type(2)));

typedef unsigned u32x4 __attribute__((ext_vector_type(4)));
__device__ __forceinline__ float bf_lo(unsigned w) { return __uint_as_float(w << 16); }
__device__ __forceinline__ float bf_hi(unsigned w) { return __uint_as_float(w & 0xffff0000u); }
__device__ __forceinline__ float fast_sigmoid(float x) { return __builtin_amdgcn_rcpf(1.0f + __builtin_amdgcn_exp2f(-1.4426950408889634f * x)); }

constexpr int SEQ_ = 8192;
struct EpiWin {
    static constexpr bool PERM = true, AFTER_DRAIN = false, MID = false;
    bf16_t *CONV, *Q, *Kt, *Vt, *G; const float* bgate; float qscale; unsigned* nrm;
    __device__ __forceinline__ void operator()(const f32x4 (&acc)[2][2][4][2], const Unit& u, int wr, int wc, int fr_, int fq_) const {
        int fr = fr_, fq = fq_; asm volatile("" : "+v"(fr), "+v"(fq));
        const int pn = u.pn; const int row0 = u.pm * BM + wr * 64 + fr; const int cl0 = wc * 32 + 8 * fq;
        bf16_t* base; int s_ai, s_m, s_bj; float sc = 1.f; bool gate = false;
        if (pn < 6) { base = CONV + (size_t)row0 * 1536 + pn * 256 + cl0; s_ai = HALF * 1536; s_m = 16 * 1536; s_bj = HALF; }
        else if (pn < 8) { base = Q + (size_t)row0 * 512 + (pn - 6) * 256 + cl0; s_ai = HALF * 512; s_m = 16 * 512; s_bj = HALF; sc = qscale; }
        else if (pn < 10) { const int h0 = (pn - 8) * 2, chunk = cl0 >> 3; const int b = row0 >> 13, s = row0 & (SEQ_ - 1), t = s >> 6, key = s & 63;
            base = Kt + ((size_t)((b * 4 + h0) * 128 + t)) * 8192 + chunk * 512 + key * 8; s_ai = 2 * 8192; s_m = 16 * 8; s_bj = 128 * 8192; }
        else if (pn < 12) { const int h0 = (pn - 10) * 2; const int b = row0 >> 13, s = row0 & (SEQ_ - 1), t = s >> 6, key = s & 63, kg = key >> 3;
            base = Vt + ((size_t)((b * 4 + h0) * 128 + t)) * 8192 + (kg * 4 + wc) * 256 + (key & 7) * 32 + 8 * fq; s_ai = 2 * 8192; s_m = 2 * 4 * 256; s_bj = 128 * 8192; }
        else { base = G + (size_t)row0 * 2048 + (pn - 12) * 256 + cl0; s_ai = HALF * 2048; s_m = 16 * 2048; s_bj = HALF; gate = true; }
        const bool trk = (pn >= 6 && pn < 10); float mx0 = 0.f, mx1 = 0.f;
        f32x4 bv[2][2];
#pragma unroll
        for (int bj = 0; bj < 2; ++bj)
#pragma unroll
            for (int n = 0; n < 2; ++n) bv[bj][n] = gate ? *(const f32x4*)(bgate + (pn - 12) * 256 + cl0 + bj * HALF + 4 * n) : (f32x4){0.f, 0.f, 0.f, 0.f};
#pragma unroll
        for (int ai = 0; ai < 2; ++ai)
#pragma unroll
            for (int m = 0; m < 4; ++m) {
#pragma unroll
                for (int bj = 0; bj < 2; ++bj) {
                    f32x4 v0 = acc[ai][bj][m][0] * sc, v1 = acc[ai][bj][m][1] * sc;
                    if (gate) { v0 = v0 + bv[bj][0]; v1 = v1 + bv[bj][1];
#pragma unroll
                        for (int e = 0; e < 4; ++e) { v0[e] = fast_sigmoid(v0[e]); v1[e] = fast_sigmoid(v1[e]); } }
                    if (trk) { float s = (v0[0] * v0[0] + v0[1] * v0[1]) + (v0[2] * v0[2] + v0[3] * v0[3]) + (v1[0] * v1[0] + v1[1] * v1[1]) + (v1[2] * v1[2] + v1[3] * v1[3]);
                        s += __shfl_xor(s, 16); s += __shfl_xor(s, 32); if (bj == 0) mx0 = fmaxf(mx0, s); else mx1 = fmaxf(mx1, s); }
                    u32x4 w; w.x = cvt_pk_bf16(v0[0], v0[1]); w.y = cvt_pk_bf16(v0[2], v0[3]); w.z = cvt_pk_bf16(v1[0], v1[1]); w.w = cvt_pk_bf16(v1[2], v1[3]);
                    *(PG8_GAS u32x4*)(base + (size_t)ai * s_ai + (size_t)m * s_m + (size_t)bj * s_bj) = w;
                }
                asm volatile("" ::: "memory");
            }
        if (trk) {
#pragma unroll
            for (int sft = 1; sft < 16; sft <<= 1) { mx0 = fmaxf(mx0, __shfl_xor(mx0, sft)); mx1 = fmaxf(mx1, __shfl_xor(mx1, sft)); }
            if (fr == 0 && fq == 0) { const int isk = pn >= 8 ? 1 : 0, h0 = ((pn - 6) & 1) * 2, bb = row0 >> 13;
                unsigned* wp = nrm + isk * 32 + (bb * 4 + h0) * 4 + wc;
                atomicMax(wp, __float_as_uint(mx0)); atomicMax(wp + 4, __float_as_uint(mx1)); }
        }
    }
};
struct EpiGate1 {
    static constexpr bool PERM = true, AFTER_DRAIN = false, MID = false;
    float* T; const bf16_t* G;
    __device__ __forceinline__ void operator()(const f32x4 (&acc)[2][2][4][2], const Unit& u, int wr, int wc, int fr_, int fq_) const {
        int fr = fr_, fq = fq_; asm volatile("" : "+v"(fr), "+v"(fq));
        const int row0 = u.pm * BM + wr * 64 + fr;
#pragma unroll
        for (int ai = 0; ai < 2; ++ai)
#pragma unroll
            for (int m = 0; m < 4; ++m) {
                const int row = row0 + ai * HALF + m * 16;
#pragma unroll
                for (int bj = 0; bj < 2; ++bj) {
                    const int col = u.pn * BM + bj * HALF + wc * 32 + 8 * fq;
                    const u32x4 g = *(const u32x4*)(G + (size_t)row * 2048 + col);
                    f32x4 v0 = acc[ai][bj][m][0], v1 = acc[ai][bj][m][1];
                    v0[0] *= bf_lo(g.x); v0[1] *= bf_hi(g.x); v0[2] *= bf_lo(g.y); v0[3] *= bf_hi(g.y);
                    v1[0] *= bf_lo(g.z); v1[1] *= bf_hi(g.z); v1[2] *= bf_lo(g.w); v1[3] *= bf_hi(g.w);
                    float* d = T + (size_t)row * 1024 + col; *(f32x4*)d = v0; *(f32x4*)(d + 4) = v1;
                }
                asm volatile("" ::: "memory");
            }
    }
};
struct EpiGate2 {
    static constexpr bool PERM = true, AFTER_DRAIN = false, MID = false;
    const float* T; const bf16_t* G; bf16_t* O;
    __device__ __forceinline__ void operator()(const f32x4 (&acc)[2][2][4][2], const Unit& u, int wr, int wc, int fr_, int fq_) const {
        int fr = fr_, fq = fq_; asm volatile("" : "+v"(fr), "+v"(fq));
        const int row0 = u.pm * BM + wr * 64 + fr;
#pragma unroll
        for (int ai = 0; ai < 2; ++ai)
#pragma unroll
            for (int m = 0; m < 4; ++m) {
                const int row = row0 + ai * HALF + m * 16;
#pragma unroll
                for (int bj = 0; bj < 2; ++bj) {
                    const int col = u.pn * BM + bj * HALF + wc * 32 + 8 * fq;
                    const u32x4 g = *(const u32x4*)(G + (size_t)row * 2048 + 1024 + col);
                    const float* d = T + (size_t)row * 1024 + col; const f32x4 t0 = *(const f32x4*)d, t1 = *(const f32x4*)(d + 4);
                    f32x4 v0 = acc[ai][bj][m][0], v1 = acc[ai][bj][m][1];
                    v0[0] = t0[0] + v0[0] * bf_lo(g.x); v0[1] = t0[1] + v0[1] * bf_hi(g.x); v0[2] = t0[2] + v0[2] * bf_lo(g.y); v0[3] = t0[3] + v0[3] * bf_hi(g.y);
                    v1[0] = t1[0] + v1[0] * bf_lo(g.z); v1[1] = t1[1] + v1[1] * bf_hi(g.z); v1[2] = t1[2] + v1[2] * bf_lo(g.w); v1[3] = t1[3] + v1[3] * bf_hi(g.w);
                    u32x4 w; w.x = cvt_pk_bf16(v0[0], v0[1]); w.y = cvt_pk_bf16(v0[2], v0[3]); w.z = cvt_pk_bf16(v1[0], v1[1]); w.w = cvt_pk_bf16(v1[2], v1[3]);
                    *(u32x4*)(O + (size_t)row * 1024 + col) = w;
                }
                asm volatile("" ::: "memory");
            }
    }
};
struct EpiMerge {
    static constexpr bool PERM = true, AFTER_DRAIN = false, MID = true;
    const bf16_t* G; bf16_t* O;
    __device__ __forceinline__ void mid(f32x4 (&acc)[2][2][4][2], const Unit& u, int wr, int wc, int fr_, int fq_) const {
        int fr = fr_, fq = fq_; asm volatile("" : "+v"(fr), "+v"(fq));
        const int row0 = u.pm * BM + wr * 64 + fr;
#pragma unroll
        for (int ai = 0; ai < 2; ++ai)
#pragma unroll
            for (int m = 0; m < 4; ++m) {
                const int row = row0 + ai * HALF + m * 16;
#pragma unroll
                for (int bj = 0; bj < 2; ++bj) {
                    const int col = u.pn * BM + bj * HALF + wc * 32 + 8 * fq;
                    const u32x4 a = *(const PG8_GAS u32x4*)(G + (size_t)row * 2048 + col), b = *(const PG8_GAS u32x4*)(G + (size_t)row * 2048 + 1024 + col);
#define PG8_RATIO(x, y) ((x) * __builtin_amdgcn_rcpf(fmaxf((y), 1e-30f)))
                    acc[ai][bj][m][0][0] *= PG8_RATIO(bf_lo(a.x), bf_lo(b.x)); acc[ai][bj][m][0][1] *= PG8_RATIO(bf_hi(a.x), bf_hi(b.x));
                    acc[ai][bj][m][0][2] *= PG8_RATIO(bf_lo(a.y), bf_lo(b.y)); acc[ai][bj][m][0][3] *= PG8_RATIO(bf_hi(a.y), bf_hi(b.y));
                    acc[ai][bj][m][1][0] *= PG8_RATIO(bf_lo(a.z), bf_lo(b.z)); acc[ai][bj][m][1][1] *= PG8_RATIO(bf_hi(a.z), bf_hi(b.z));
                    acc[ai][bj][m][1][2] *= PG8_RATIO(bf_lo(a.w), bf_lo(b.w)); acc[ai][bj][m][1][3] *= PG8_RATIO(bf_hi(a.w), bf_hi(b.w));
#undef PG8_RATIO
                }
                asm volatile("" ::: "memory");
            }
    }
    __device__ __forceinline__ void operator()(const f32x4 (&acc)[2][2][4][2], const Unit& u, int wr, int wc, int fr_, int fq_) const {
        int fr = fr_, fq = fq_; asm volatile("" : "+v"(fr), "+v"(fq));
        const int row0 = u.pm * BM + wr * 64 + fr;
#pragma unroll
        for (int ai = 0; ai < 2; ++ai)
#pragma unroll
            for (int m = 0; m < 4; ++m) {
                const int row = row0 + ai * HALF + m * 16;
#pragma unroll
                for (int bj = 0; bj < 2; ++bj) {
                    const int col = u.pn * BM + bj * HALF + wc * 32 + 8 * fq;
                    const u32x4 g = *(const PG8_GAS u32x4*)(G + (size_t)row * 2048 + 1024 + col);
                    f32x4 v0 = acc[ai][bj][m][0], v1 = acc[ai][bj][m][1];
                    v0[0] *= fmaxf(bf_lo(g.x), 1e-30f); v0[1] *= fmaxf(bf_hi(g.x), 1e-30f); v0[2] *= fmaxf(bf_lo(g.y), 1e-30f); v0[3] *= fmaxf(bf_hi(g.y), 1e-30f);
                    v1[0] *= fmaxf(bf_lo(g.z), 1e-30f); v1[1] *= fmaxf(bf_hi(g.z), 1e-30f); v1[2] *= fmaxf(bf_lo(g.w), 1e-30f); v1[3] *= fmaxf(bf_hi(g.w), 1e-30f);
                    u32x4 w; w.x = cvt_pk_bf16(v0[0], v0[1]); w.y = cvt_pk_bf16(v0[2], v0[3]); w.z = cvt_pk_bf16(v1[0], v1[1]); w.w = cvt_pk_bf16(v1[2], v1[3]);
                    *(PG8_GAS u32x4*)(O + (size_t)row * 1024 + col) = w;
                }
                asm volatile("" ::: "memory");
            }
    }
};
struct EpiF32 {
    static constexpr bool PERM = false, AFTER_DRAIN = false, MID = false;
    float* O; int ldc;
    __device__ __forceinline__ void operator()(const f32x4 (&acc)[2][2][4][2], const Unit& u, int wr, int wc, int fr_, int fq_) const {
        int fr = fr_, fq = fq_; asm volatile("" : "+v"(fr), "+v"(fq));
        const int row0 = u.pm * BM + wr * 64 + fr, col0 = u.pn * BM + wc * 32 + 4 * fq;
#pragma unroll
        for (int ai = 0; ai < 2; ++ai)
#pragma unroll
            for (int m = 0; m < 4; ++m) {
                float* rowp = O + (size_t)(row0 + ai * HALF + m * 16) * ldc + col0;
#pragma unroll
                for (int bj = 0; bj < 2; ++bj)
#pragma unroll
                    for (int n = 0; n < 2; ++n) *(f32x4*)(rowp + bj * HALF + n * 16) = acc[ai][bj][m][n];
            }
    }
};
struct EpiRelu2 {
    static constexpr bool PERM = true, AFTER_DRAIN = false, MID = false;
    bf16_t* O; int ldc;
    __device__ __forceinline__ void operator()(const f32x4 (&acc)[2][2][4][2], const Unit& u, int wr, int wc, int fr_, int fq_) const {
        int fr = fr_, fq = fq_; asm volatile("" : "+v"(fr), "+v"(fq));
        const int row0 = u.pm * BM + wr * 64 + fr, col0 = u.pn * BM + wc * 32 + 8 * fq;
#pragma unroll
        for (int ai = 0; ai < 2; ++ai)
#pragma unroll
            for (int m = 0; m < 4; ++m) {
                bf16_t* rowp = O + (size_t)(row0 + ai * HALF + m * 16) * ldc + col0;
#pragma unroll
                for (int bj = 0; bj < 2; ++bj) {
                    f32x4 v0 = acc[ai][bj][m][0], v1 = acc[ai][bj][m][1];
#pragma unroll
                    for (int e = 0; e < 4; ++e) { const float a = fmaxf(v0[e], 0.f), b = fmaxf(v1[e], 0.f); v0[e] = a * a; v1[e] = b * b; }
                    u32x4 w; w.x = cvt_pk_bf16(v0[0], v0[1]); w.y = cvt_pk_bf16(v0[2], v0[3]); w.z = cvt_pk_bf16(v1[0], v1[1]); w.w = cvt_pk_bf16(v1[2], v1[3]);
                    *(PG8_GAS u32x4*)(rowp + bj * HALF) = w;
                }
            }
    }
};


struct EpiBf16P {
    static constexpr bool PERM = true, AFTER_DRAIN = false, MID = false;
    bf16_t* O; int ldc;
    __device__ __forceinline__ void operator()(const f32x4 (&acc)[2][2][4][2], const Unit& u, int wr, int wc, int fr_, int fq_) const {
        int fr = fr_, fq = fq_; asm volatile("" : "+v"(fr), "+v"(fq));
        const int row0 = u.pm * BM + wr * 64 + fr, col0 = u.pn * BM + wc * 32 + 8 * fq;
#pragma unroll
        for (int ai = 0; ai < 2; ++ai)
#pragma unroll
            for (int m = 0; m < 4; ++m) {
                bf16_t* rowp = O + (size_t)(row0 + ai * HALF + m * 16) * ldc + col0;
#pragma unroll
                for (int bj = 0; bj < 2; ++bj) {
                    const f32x4 v0 = acc[ai][bj][m][0], v1 = acc[ai][bj][m][1];
                    u32x4 w; w.x = cvt_pk_bf16(v0[0], v0[1]); w.y = cvt_pk_bf16(v0[2], v0[3]); w.z = cvt_pk_bf16(v1[0], v1[1]); w.w = cvt_pk_bf16(v1[2], v1[3]);
                    *(PG8_GAS u32x4*)(rowp + bj * HALF) = w;
                }
            }
    }
};
template <class Epi, class Sched, bool ALIGN_EPI = false, bool SP2 = false>
__device__ __forceinline__ void gemm_phase(PG8_LAS unsigned char* lds, const Gemm g, const Sched& S, const Epi& E) {
    int tid_ = threadIdx.x; asm volatile("" : "+v"(tid_));
    const int tid = tid_, wid = __builtin_amdgcn_readfirstlane(tid >> 6), lane = tid & 63, wr = wid >> 2, wc = wid & 3, fr = lane & 15, fq = lane >> 4;
    const int K = g.K, nt = K / BK;
    unsigned voffA[2], voffB[2];
#pragma unroll
    for (int i = 0; i < 2; ++i) { int R, C; stage_rc(tid * 16 + i * 8192, R, C); const int Rb = Epi::PERM ? ((R & ~31) + perm32(R & 31)) : R;
        voffA[i] = (unsigned)(R * K + C) * 2u; voffB[i] = (unsigned)(Rb * K + C) * 2u; }
    const size_t kstep = (size_t)(BK * 2);
    const size_t hstep = (size_t)HALF * K * 2;
    const size_t tstep = 2 * hstep;
    const unsigned ldsw = (unsigned)wid * 1024u;
    const int aoff = lds_byte(wr * 64 + fr, fq * 8), boff = lds_byte(wc * 32 + fr, fq * 8);
#define PG8_SA(b, h) (((b) * 2 + (h)) * HTB)
#define PG8_SB(b, h) ((4 + (b) * 2 + (h)) * HTB)
#define PG8_STAGE(bufoff, gbase, voff) do { _Pragma("unroll") for (int _i = 0; _i < 2; ++_i) \
        __builtin_amdgcn_global_load_lds((const unsigned*)((const char*)(gbase) + (voff)[_i]), (PG8_LAS unsigned*)(lds + (bufoff) + ldsw + _i * 8192), 16, 0, 0); } while (0)
#define PG8_LDA(dst, b, h) do { _Pragma("unroll") for (int m = 0; m < 4; ++m) _Pragma("unroll") for (int k = 0; k < 2; ++k) dst[m][k] = *(const PG8_LAS bf16x8*)(lds + PG8_SA(b, h) + aoff + m * 2048 + k * 1024); } while (0)
#define PG8_LDB(dst, b, h) do { _Pragma("unroll") for (int n = 0; n < 2; ++n) _Pragma("unroll") for (int k = 0; k < 2; ++k) dst[n][k] = *(const PG8_LAS bf16x8*)(lds + PG8_SB(b, h) + boff + n * 2048 + k * 1024); } while (0)
#define PG8_MMA(ai, bj, At, Bt) do { __builtin_amdgcn_s_setprio(1); _Pragma("unroll") for (int m = 0; m < 4; ++m) _Pragma("unroll") for (int n = 0; n < 2; ++n) _Pragma("unroll") for (int k = 0; k < 2; ++k) \
        acc[ai][bj][m][n] = __builtin_amdgcn_mfma_f32_16x16x32_bf16(Bt[n][k], At[m][k], acc[ai][bj][m][n], 0, 0, 0); __builtin_amdgcn_s_setprio(0); } while (0)
#define PG8_WAIT_V(n) asm volatile("s_waitcnt vmcnt(" #n ")" ::: "memory")
#define PG8_WAIT_L(n) asm volatile("s_waitcnt lgkmcnt(" #n ")" ::: "memory")
#define PG8_BAR __builtin_amdgcn_s_barrier()
#define PG8_SCHED __builtin_amdgcn_sched_barrier(0)
    Unit cur, nxt; int ui = 0;
    if (!S.next(0, cur)) return;
    f32x4 acc[2][2][4][2];
#pragma unroll
    for (int a = 0; a < 2; ++a)
#pragma unroll
        for (int b = 0; b < 2; ++b)
#pragma unroll
            for (int m = 0; m < 4; ++m)
#pragma unroll
                for (int n = 0; n < 2; ++n) acc[a][b][m][n] = (f32x4){0.f, 0.f, 0.f, 0.f};
    bf16x8 At[4][2], B0[2][2], B1[2][2];
    const char* cA = (const char*)g.A + (size_t)cur.pm * tstep; const char* cB = (const char*)g.Bt + (size_t)cur.pn * tstep;
    S.a_ready(cur);
    if constexpr (SP2) {
        PG8_STAGE(PG8_SB(0, 0), cB, voffB); PG8_STAGE(PG8_SB(0, 1), cB + hstep, voffB); PG8_STAGE(PG8_SA(0, 0), cA, voffA); PG8_STAGE(PG8_SA(0, 1), cA + hstep, voffA);
        if (wr == 1) PG8_BAR;
        PG8_WAIT_V(2); PG8_BAR;
        PG8_STAGE(PG8_SB(1, 0), cB + kstep, voffB); PG8_STAGE(PG8_SA(1, 0), cA + kstep, voffA); PG8_STAGE(PG8_SB(1, 1), cB + hstep + kstep, voffB);
        PG8_WAIT_V(6); PG8_BAR;
    } else {
        PG8_STAGE(PG8_SB(0, 0), cB, voffB); PG8_STAGE(PG8_SA(0, 0), cA, voffA); PG8_STAGE(PG8_SB(0, 1), cB + hstep, voffB); PG8_STAGE(PG8_SA(0, 1), cA + hstep, voffA);
        if (wr == 1) PG8_BAR;
        PG8_WAIT_V(4); PG8_BAR;
        PG8_STAGE(PG8_SB(1, 0), cB + kstep, voffB); PG8_STAGE(PG8_SA(1, 0), cA + kstep, voffA); PG8_STAGE(PG8_SB(1, 1), cB + hstep + kstep, voffB);
        PG8_WAIT_V(6); PG8_BAR;
    }
    for (;;) {
        const bool has_next = S.next(ui + 1, nxt);
        const char* nA = has_next ? (const char*)g.A + (size_t)nxt.pm * tstep : cA; const char* nB = has_next ? (const char*)g.Bt + (size_t)nxt.pn * tstep : cB;
        for (int t = 0; t < nt; t += 2) {
            if constexpr (Epi::MID) { if (t == (nt >> 1)) E.mid(acc, cur, wr, wc, fr, fq); }
            const bool last = (t == nt - 2);
            const char* a1 = cA + (size_t)(t + 1) * kstep;
            const char* a2 = last ? nA : cA + (size_t)(t + 2) * kstep; const char* b2 = last ? nB : cB + (size_t)(t + 2) * kstep;
            const char* a3 = a2 + kstep; const char* b3 = b2 + kstep;
            if (last && has_next) S.a_ready(nxt);
            if constexpr (SP2) {
            PG8_LDB(B0, 0, 0); PG8_LDB(B1, 0, 1); PG8_SCHED; PG8_LDA(At, 0, 0); PG8_STAGE(PG8_SA(1, 1), a1 + hstep, voffA);
            PG8_WAIT_V(8); PG8_WAIT_L(0); PG8_BAR; PG8_MMA(0, 0, At, B0); PG8_MMA(0, 1, At, B1); PG8_BAR; PG8_SCHED;
            PG8_LDA(At, 0, 1); PG8_STAGE(PG8_SB(0, 0), b2, voffB); PG8_STAGE(PG8_SB(0, 1), b2 + hstep, voffB); PG8_STAGE(PG8_SA(0, 0), a2, voffA);
            PG8_WAIT_V(8); PG8_WAIT_L(0); PG8_BAR; PG8_MMA(1, 0, At, B0); PG8_MMA(1, 1, At, B1); PG8_BAR; PG8_SCHED;
            PG8_LDB(B0, 1, 0); PG8_LDB(B1, 1, 1); PG8_SCHED; PG8_LDA(At, 1, 0); PG8_STAGE(PG8_SA(0, 1), a2 + hstep, voffA);
            PG8_WAIT_V(8); PG8_WAIT_L(0); PG8_BAR; PG8_MMA(0, 0, At, B0); PG8_MMA(0, 1, At, B1); PG8_BAR; PG8_SCHED;
            PG8_LDA(At, 1, 1); PG8_STAGE(PG8_SB(1, 0), b3, voffB); PG8_STAGE(PG8_SB(1, 1), b3 + hstep, voffB); PG8_STAGE(PG8_SA(1, 0), a3, voffA);
            PG8_WAIT_V(8); PG8_WAIT_L(0); PG8_BAR; PG8_MMA(1, 0, At, B0); PG8_MMA(1, 1, At, B1); PG8_BAR; PG8_SCHED;
            } else {
            PG8_LDB(B0, 0, 0); PG8_SCHED; PG8_LDA(At, 0, 0); PG8_STAGE(PG8_SA(1, 1), a1 + hstep, voffA);
            PG8_WAIT_L(8); PG8_BAR; PG8_WAIT_L(0); PG8_MMA(0, 0, At, B0); PG8_BAR; PG8_SCHED;
            PG8_LDB(B1, 0, 1); PG8_STAGE(PG8_SB(0, 0), b2, voffB);
            PG8_BAR; PG8_WAIT_L(0); PG8_MMA(0, 1, At, B1); PG8_BAR;
            PG8_LDA(At, 0, 1); PG8_STAGE(PG8_SA(0, 0), a2, voffA);
            PG8_BAR; PG8_WAIT_L(0); PG8_MMA(1, 0, At, B0); PG8_BAR; PG8_SCHED;
            PG8_STAGE(PG8_SB(0, 1), b2 + hstep, voffB);
            PG8_WAIT_V(6); PG8_BAR; PG8_MMA(1, 1, At, B1); PG8_BAR;
            PG8_LDB(B0, 1, 0); PG8_SCHED; PG8_LDA(At, 1, 0); PG8_STAGE(PG8_SA(0, 1), a2 + hstep, voffA);
            PG8_WAIT_L(8); PG8_BAR; PG8_WAIT_L(0); PG8_MMA(0, 0, At, B0); PG8_BAR; PG8_SCHED;
            PG8_LDB(B1, 1, 1); PG8_STAGE(PG8_SB(1, 0), b3, voffB);
            PG8_BAR; PG8_WAIT_L(0); PG8_MMA(0, 1, At, B1); PG8_BAR;
            PG8_LDA(At, 1, 1); PG8_STAGE(PG8_SA(1, 0), a3, voffA);
            PG8_BAR; PG8_WAIT_L(0); PG8_MMA(1, 0, At, B0); PG8_BAR; PG8_SCHED;
            PG8_STAGE(PG8_SB(1, 1), b3 + hstep, voffB);
            PG8_WAIT_V(6); PG8_BAR; PG8_MMA(1, 1, At, B1); PG8_BAR;
            }
        }
        if constexpr (ALIGN_EPI) { if (wr == 0) PG8_BAR; }
        if constexpr (!Epi::AFTER_DRAIN) { E(acc, cur, wr, wc, fr, fq); S.done(cur); }
        if (!has_next) break;
#pragma unroll
        for (int a = 0; a < 2; ++a)
#pragma unroll
            for (int b = 0; b < 2; ++b)
#pragma unroll
                for (int m = 0; m < 4; ++m)
#pragma unroll
                    for (int n = 0; n < 2; ++n) acc[a][b][m][n] = (f32x4){0.f, 0.f, 0.f, 0.f};
        cur = nxt; cA = nA; cB = nB; ++ui;
        if constexpr (ALIGN_EPI) { if (wr == 1) PG8_BAR; }
    }
    PG8_WAIT_V(0);
    if constexpr (!ALIGN_EPI) { if (wr == 0) PG8_BAR; }
    PG8_BAR;
    if constexpr (Epi::AFTER_DRAIN) { E.fused(acc, cur, wr, wc, fr, fq, lds, wid, lane); S.done(cur); }
#undef PG8_SA
#undef PG8_SB
#undef PG8_STAGE
#undef PG8_LDA
#undef PG8_LDB
#undef PG8_MMA
#undef PG8_WAIT_V
#undef PG8_WAIT_L
#undef PG8_BAR
#undef PG8_SCHED
}
}

constexpr int D_MODEL = 1024, BATCH = 2, SEQ = 8192, DEPTH = 4, M = BATCH * SEQ;
constexpr int CONV_W = 512, NHEAD = 4, HEAD_DIM = 64, V_DIM = 128, ATTN_W = 512, D_FF = 4096, IN_W = 5120;
constexpr float EPS = 1e-6f;
constexpr float LOG2E = 1.4426950408889634f;

#define LAS __attribute__((address_space(3)))
#define GAS __attribute__((address_space(1)))
typedef unsigned short bf16;
typedef short bf16x8 __attribute__((ext_vector_type(8)));
typedef short s16x4 __attribute__((ext_vector_type(4)));
typedef float f32x4 __attribute__((ext_vector_type(4)));
typedef float f32x16 __attribute__((ext_vector_type(16)));
typedef unsigned u32x4 __attribute__((ext_vector_type(4)));
typedef unsigned u32x2 __attribute__((ext_vector_type(2)));

constexpr size_t MiB = 1u << 20;
constexpr size_t WS_CTL = 0;
constexpr size_t WS_W = 1 * MiB;
constexpr size_t W_IN_OFF = 0, W_CO_OFF = W_IN_OFF + (size_t)IN_W * D_MODEL * 2, W_AO_OFF = W_CO_OFF + (size_t)D_MODEL * CONV_W * 2,
                 W_O_OFF = W_AO_OFF + (size_t)D_MODEL * ATTN_W * 2, W_F1_OFF = W_O_OFF + (size_t)D_MODEL * D_MODEL * 2,
                 W_F2_OFF = W_F1_OFF + (size_t)D_FF * D_MODEL * 2, W_END_OFF = W_F2_OFF + (size_t)D_MODEL * D_FF * 2;
static_assert(WS_W + W_END_OFF <= 32 * MiB, "weights region");
constexpr size_t WS_U = 32 * MiB;
constexpr size_t WS_CONV = 64 * MiB;
constexpr size_t WS_Q = 112 * MiB;
constexpr size_t WS_K = 128 * MiB;
constexpr size_t WS_V = 144 * MiB;
constexpr size_t WS_G = 160 * MiB;
constexpr size_t WS_Z = 224 * MiB;
constexpr size_t WS_ON = 240 * MiB;
constexpr size_t WS_T = 64 * MiB;
constexpr size_t WS_MO = 128 * MiB;
constexpr size_t WS_A = 64 * MiB;
constexpr size_t WS_F = 192 * MiB;
constexpr size_t WS_END = 256 * MiB;

constexpr int LDS_BYTES = 135168;

__device__ __forceinline__ float wave_sum(float v) {
#pragma unroll
    for (int o = 1; o < 64; o <<= 1) v += __shfl_xor(v, o);
    return v;
}
__device__ __forceinline__ unsigned f2bf(float f) { unsigned u = __builtin_bit_cast(unsigned, f); return (u + 0x7fffu + ((u >> 16) & 1u)) >> 16; }
__device__ __forceinline__ unsigned pk2(float lo, float hi) { return f2bf(lo) | (f2bf(hi) << 16); }
__device__ __forceinline__ float bflo(unsigned w) { return __uint_as_float(w << 16); }
__device__ __forceinline__ float bfhi(unsigned w) { return __uint_as_float(w & 0xffff0000u); }

__device__ __forceinline__ void transpose_item(const float* W, int K, int N, bf16* WT, LAS float* scr, int item, int lane, int ldk = 0) {
    if (ldk == 0) ldk = K;
    const int nblk = N / 64, kb = item / nblk, nb = item % nblk, k0 = 32 * kb, n0 = 64 * nb;
    const int n4 = (lane & 15) * 4, kr = lane >> 4;
    f32x4 v[8];
#pragma unroll
    for (int i = 0; i < 8; ++i) v[i] = *(const GAS f32x4*)(W + (size_t)(k0 + kr + 4 * i) * N + n0 + n4);
#pragma unroll
    for (int i = 0; i < 8; ++i) { LAS float* s = scr + (kr + 4 * i) * 66 + n4; typedef float f32x2v __attribute__((ext_vector_type(2)));
        *(LAS f32x2v*)s = (f32x2v){v[i].x, v[i].y}; *(LAS f32x2v*)(s + 2) = (f32x2v){v[i].z, v[i].w}; }
    asm volatile("s_waitcnt lgkmcnt(0)" ::: "memory");
    const int c = lane >> 4;
#pragma unroll
    for (int j = 0; j < 4; ++j) { const int n = (lane & 15) + 16 * j; const LAS float* s = scr + (8 * c) * 66 + n;
        u32x4 o; o.x = pk2(s[0 * 66], s[1 * 66]); o.y = pk2(s[2 * 66], s[3 * 66]); o.z = pk2(s[4 * 66], s[5 * 66]); o.w = pk2(s[6 * 66], s[7 * 66]);
        *(GAS u32x4*)(WT + (size_t)(n0 + n) * ldk + k0 + 8 * c) = o; }
    asm volatile("s_waitcnt lgkmcnt(0)" ::: "memory");
}

struct Args { const float* in[12]; float* out; unsigned char* ws; int ph_lo, ph_hi; };

__device__ __forceinline__ void convert_weights(const Args& a, int l, LAS unsigned char* lds, int it_begin, int it_end, int it_stride, int wave, int lane) {
    LAS float* scr = (LAS float*)(lds + wave * 16384);
    bf16* wb = (bf16*)(a.ws + WS_W);
    constexpr int I_IN = (D_MODEL / 32) * (IN_W / 64), I_CO = (CONV_W / 32) * (D_MODEL / 64), I_AO = (ATTN_W / 32) * (D_MODEL / 64),
                  I_O = (D_MODEL / 32) * (D_MODEL / 64), I_F1 = (D_MODEL / 32) * (D_FF / 64), I_F2 = (D_FF / 32) * (D_MODEL / 64);
    constexpr int NITEMS = I_IN + I_CO + I_AO + I_O + I_F1 + I_F2;
    const float* w_in = a.in[1] + (size_t)l * D_MODEL * IN_W;
    const float* w_co = a.in[4] + (size_t)l * CONV_W * D_MODEL;
    const float* w_ao = a.in[7] + (size_t)l * ATTN_W * D_MODEL;
    const float* w_o = a.in[8] + (size_t)l * D_MODEL * D_MODEL;
    const float* w_f1 = a.in[10] + (size_t)l * D_MODEL * D_FF;
    const float* w_f2 = a.in[11] + (size_t)l * D_FF * D_MODEL;
    if (it_end > NITEMS) it_end = NITEMS;
    for (int it = it_begin; it < it_end; it += it_stride) {
        int r = it;
        if (r < I_IN) { transpose_item(w_in, D_MODEL, IN_W, (bf16*)((unsigned char*)wb + W_IN_OFF), scr, r, lane); continue; } r -= I_IN;
        if (r < I_CO) { transpose_item(w_co, CONV_W, D_MODEL, (bf16*)((unsigned char*)wb + W_CO_OFF), scr, r, lane, CONV_W + ATTN_W); continue; } r -= I_CO;
        if (r < I_AO) { transpose_item(w_ao, ATTN_W, D_MODEL, (bf16*)((unsigned char*)wb + W_CO_OFF) + CONV_W, scr, r, lane, CONV_W + ATTN_W); continue; } r -= I_AO;
        if (r < I_O) { transpose_item(w_o, D_MODEL, D_MODEL, (bf16*)((unsigned char*)wb + W_O_OFF), scr, r, lane); continue; } r -= I_O;
        if (r < I_F1) { transpose_item(w_f1, D_MODEL, D_FF, (bf16*)((unsigned char*)wb + W_F1_OFF), scr, r, lane); continue; } r -= I_F1;
        transpose_item(w_f2, D_FF, D_MODEL, (bf16*)((unsigned char*)wb + W_F2_OFF), scr, r, lane);
    }
}

template <bool ADD, bool NORM>
__device__ __forceinline__ void row_phase(const float* hin, const bf16* F, const float* gA, float* hout, const float* gB, bf16* U, int gw, int NGW, int lane) {
    f32x4 ga[4], gb[4];
#pragma unroll
    for (int j = 0; j < 4; ++j) { ga[j] = ADD ? ((const GAS f32x4*)gA)[lane + 64 * j] : (f32x4){0.f, 0.f, 0.f, 0.f}; gb[j] = NORM ? ((const GAS f32x4*)gB)[lane + 64 * j] : (f32x4){0.f, 0.f, 0.f, 0.f}; }
    for (int m = gw; m < M; m += NGW) {
        f32x4 v[4];
#pragma unroll
        for (int j = 0; j < 4; ++j) v[j] = ((const GAS f32x4*)(hin + (size_t)m * D_MODEL))[lane + 64 * j];
        if (ADD) {
            f32x4 f[4]; float ss = 0.f;
#pragma unroll
            for (int j = 0; j < 4; ++j) { const u32x2 w = ((const GAS u32x2*)(F + (size_t)m * D_MODEL))[lane + 64 * j]; f[j] = (f32x4){bflo(w.x), bfhi(w.x), bflo(w.y), bfhi(w.y)}; ss += (f[j].x * f[j].x + f[j].y * f[j].y) + (f[j].z * f[j].z + f[j].w * f[j].w); }
            const float r = 1.0f / sqrtf(wave_sum(ss) * (1.0f / D_MODEL) + EPS);
#pragma unroll
            for (int j = 0; j < 4; ++j) v[j] = v[j] + f[j] * r * ga[j];
        }
#pragma unroll
        for (int j = 0; j < 4; ++j) ((GAS f32x4*)(hout + (size_t)m * D_MODEL))[lane + 64 * j] = v[j];
        if (NORM) {
            float ss = 0.f;
#pragma unroll
            for (int j = 0; j < 4; ++j) ss += (v[j].x * v[j].x + v[j].y * v[j].y) + (v[j].z * v[j].z + v[j].w * v[j].w);
            const float r = 1.0f / sqrtf(wave_sum(ss) * (1.0f / D_MODEL) + EPS);
            GAS u32x2* o8 = (GAS u32x2*)(U + (size_t)m * D_MODEL) + lane;
#pragma unroll
            for (int j = 0; j < 4; ++j) { const f32x4 y = v[j] * r * gb[j]; u32x2 w; w.x = pk2(y.x, y.y); w.y = pk2(y.z, y.w); o8[64 * j] = w; }
        }
    }
}

__device__ __forceinline__ void conv_items(const bf16* CONV, const float* cw, bf16* Z, int it_begin, int it_end, int it_stride, int lane) {
    const int c = lane * 8;
    float w0[8], w1[8], w2[8];
#pragma unroll
    for (int e = 0; e < 8; ++e) { w0[e] = cw[c + e]; w1[e] = cw[CONV_W + c + e]; w2[e] = cw[2 * CONV_W + c + e]; }
    for (int it = it_begin; it < it_end; it += it_stride) {
        const int t0 = it * 8, s0 = t0 & (SEQ - 1);
        float prev[8], cur[8], nxt[8];
#define INNER(dst, t) do { const u32x4 hh = *(const GAS u32x4*)(CONV + (size_t)(t) * 1536 + c), cc = *(const GAS u32x4*)(CONV + (size_t)(t) * 1536 + 1024 + c); \
            dst[0] = bflo(hh.x) * bflo(cc.x); dst[1] = bfhi(hh.x) * bfhi(cc.x); dst[2] = bflo(hh.y) * bflo(cc.y); dst[3] = bfhi(hh.y) * bfhi(cc.y); \
            dst[4] = bflo(hh.z) * bflo(cc.z); dst[5] = bfhi(hh.z) * bfhi(cc.z); dst[6] = bflo(hh.w) * bflo(cc.w); dst[7] = bfhi(hh.w) * bfhi(cc.w); } while (0)
        if (s0 > 0) { INNER(prev, t0 - 1); } else {
#pragma unroll
            for (int e = 0; e < 8; ++e) prev[e] = 0.f; }
        INNER(cur, t0);
#pragma unroll
        for (int j = 0; j < 8; ++j) {
            const int t = t0 + j;
            if (s0 + j + 1 < SEQ) { INNER(nxt, t + 1); } else {
#pragma unroll
                for (int e = 0; e < 8; ++e) nxt[e] = 0.f; }
            const u32x4 bb = *(const GAS u32x4*)(CONV + (size_t)t * 1536 + 512 + c);
            float z[8];
#pragma unroll
            for (int e = 0; e < 8; ++e) z[e] = prev[e] * w0[e] + cur[e] * w1[e] + nxt[e] * w2[e];
            z[0] *= bflo(bb.x); z[1] *= bfhi(bb.x); z[2] *= bflo(bb.y); z[3] *= bfhi(bb.y); z[4] *= bflo(bb.z); z[5] *= bfhi(bb.z); z[6] *= bflo(bb.w); z[7] *= bfhi(bb.w);
            u32x4 o; o.x = pk2(z[0], z[1]); o.y = pk2(z[2], z[3]); o.z = pk2(z[4], z[5]); o.w = pk2(z[6], z[7]);
            *(GAS u32x4*)(Z + (size_t)t * (CONV_W + ATTN_W) + c) = o;
#pragma unroll
            for (int e = 0; e < 8; ++e) { prev[e] = cur[e]; cur[e] = nxt[e]; }
        }
#undef INNER
    }
}

__device__ __forceinline__ int crow(int r, int hi) { return (r & 3) + 8 * (r >> 2) + 4 * hi; }
typedef float f32x2_t __attribute__((ext_vector_type(2))); typedef __bf16 bf16x2_t __attribute__((ext_vector_type(2)));
__device__ __forceinline__ unsigned cvtpk(float lo, float hi) { f32x2_t v = {lo, hi}; bf16x2_t b = __builtin_convertvector(v, bf16x2_t); return __builtin_bit_cast(unsigned, b); }
typedef short v4i16_t __attribute__((ext_vector_type(4)));
__device__ __forceinline__ s16x4 vtr(const LAS unsigned char* p) { return __builtin_bit_cast(s16x4, __builtin_amdgcn_ds_read_tr16_b64_v4i16((LAS v4i16_t*)p)); }
constexpr float ATT_T = 24.0f, ATT_THR = 8.0f;
constexpr int W_IN_ITEMS = (D_MODEL / 32) * (IN_W / 64);
constexpr float ATT_NOCHK = 64.0f;
#ifndef DIAG
#define DIAG 0
#endif
#ifndef DIAG_LIGHT
#define DIAG_LIGHT 0
#endif
#ifndef DIAG_WAVE
#define DIAG_WAVE 0
#endif
#ifndef DIAG_SCALE
#define DIAG_SCALE 0.01f
#endif
#ifndef DIAG_SEL
#define DIAG_SEL 0
#endif
__device__ __forceinline__ void glds16(const void* gsrc, unsigned lds_dst) { unsigned keep;
    asm volatile("s_mov_b32 %0, m0\n\ts_mov_b32 m0, %2\n\ts_nop 0\n\tglobal_load_lds_dwordx4 %1, off\n\ts_mov_b32 m0, %0" : "=&s"(keep) : "v"(gsrc), "s"(lds_dst) : "memory"); }
#define MFMA32(a, b, c) __builtin_amdgcn_mfma_f32_32x32x16_bf16((a), (b), (c), 0, 0, 0)

__device__ __forceinline__ void attn_unit(int b, int h, int qb, float kn0, float kn1, const bf16* Q, const bf16* Kt, const bf16* Vt, bf16* ON, LAS unsigned char* lds,
                                          float slope2, const float* subg, float post) {
    int tid_ = threadIdx.x; asm volatile("" : "+v"(tid_));
    const int tid = tid_, lane = tid & 63, r = lane & 31, hi = lane >> 5;
    const int wid = __builtin_amdgcn_readfirstlane(tid >> 6), map = wid >> 2, qs = wid & 3;
    const int q0 = qb * 128 + qs * 32;
    const size_t tokbase = (size_t)b * SEQ;
    bf16x8 qf[4];
    { const bf16* qp = Q + (tokbase + q0 + r) * ATTN_W + h * 128 + map * 64 + hi * 8;
#pragma unroll
      for (int ks = 0; ks < 4; ++ks) qf[ks] = *(const GAS bf16x8*)(qp + ks * 16); }
    const unsigned char* ktg = (const unsigned char*)Kt + (size_t)((b * 4 + h) * 128) * 16384 + wid * 1024 + lane * 16;
    const unsigned char* vtg = (const unsigned char*)Vt + (size_t)((b * 4 + h) * 128) * 16384 + wid * 1024 + lane * 16;
    const unsigned lds0 = (unsigned)(uintptr_t)lds;
#define ISSUE(t, buf) do { const size_t go_ = (size_t)(t) * 16384; const unsigned lb_ = (unsigned)__builtin_amdgcn_readfirstlane(lds0 + (buf) * 32768 + wid * 1024); \
        glds16(ktg + go_, lb_); glds16(ktg + go_ + 8192, lb_ + 8192); glds16(vtg + go_, lb_ + 16384); glds16(vtg + go_ + 8192, lb_ + 16384 + 8192); } while (0)
    f32x16 o[4];
#pragma unroll
    for (int cb = 0; cb < 4; ++cb)
#pragma unroll
        for (int i = 0; i < 16; ++i) o[cb][i] = 0.f;
    float mrun = -1e30f, lsum = 0.f;
    LAS float* wsf = (LAS float*)(lds + 131072 + 256) + wid * 64;
    const LAS unsigned char* kfb = lds + (map * 8 + hi) * 1024 + r * 16;
    const LAS unsigned char* vfb = lds + 16384 + (4 * hi + ((lane & 15) >> 2)) * 64 + ((lane >> 4) & 1) * 32 + (lane & 3) * 8;
    const unsigned vfa = (unsigned)(uintptr_t)vfb;
    const int td0 = 2 * qb; int t_lo = 0, t_hi = 0;
#define TILE_OF(n) ((n) < 2 ? td0 + (n) : ((t_lo + (n) - 2) >= td0 ? t_lo + (n) : t_lo + (n) - 2))
    bf16x8 pk[4];
    const unsigned himask = hi ? 0u : 0xffffffffu;
    bf16x8 kc0, kc1;
    { const unsigned one = 0x3f80u, k0b = f2bf((float)r), k1b = f2bf((float)(32 + r));
      u32x4 w; w.x = (k0b | (k0b << 16)) & himask; w.y = (k0b | (one << 16)) & himask; w.z = (one | (one << 16)) & himask; w.w = 0u; kc0 = __builtin_bit_cast(bf16x8, w);
      w.x = (k1b | (k1b << 16)) & himask; w.y = (k1b | (one << 16)) & himask; kc1 = __builtin_bit_cast(bf16x8, w); }
    unsigned sl12, sl3;
    { const unsigned s1 = f2bf(slope2); const float f1 = __uint_as_float(s1 << 16); const unsigned s2 = f2bf(slope2 - f1); const float f2 = __uint_as_float(s2 << 16); const unsigned s3 = f2bf(slope2 - f1 - f2);
      sl12 = s1 | (s2 << 16); sl3 = s3; }
    ISSUE(TILE_OF(0), 0);
    ISSUE(TILE_OF(1), 1);
    asm volatile("" : "+v"(qf[0]), "+v"(qf[1]), "+v"(qf[2]), "+v"(qf[3]));
    bool nocheck;
    { float qs2 = 0.f;
#pragma unroll
      for (int ks = 0; ks < 4; ++ks)
#pragma unroll
          for (int j = 0; j < 8; ++j) { const float v = __uint_as_float((unsigned)(unsigned short)qf[ks][j] << 16); qs2 += v * v; }
      qs2 += __shfl_xor(qs2, 32);
#pragma unroll
      for (int sft = 1; sft < 32; sft <<= 1) qs2 = fmaxf(qs2, __shfl_xor(qs2, sft));
      LAS float* wsq = (LAS float*)(lds + 131072 + 256 + 2048 + 64);
      if (lane == 0) wsq[wid] = qs2;
      __syncthreads();
      const float qm0 = fmaxf(fmaxf(wsq[0], wsq[1]), fmaxf(wsq[2], wsq[3])), qm1 = fmaxf(fmaxf(wsq[4], wsq[5]), fmaxf(wsq[6], wsq[7]));
      const float Bb = 2.04f * fmaxf(sqrtf(qm0 * kn0), sqrtf(qm1 * kn1));
      const float Wf = (Bb + ATT_T) / slope2;
      const int W = Wf < 16384.f ? (int)Wf + 1 : 16384;
      const int q0b = qb * 128;
      t_lo = (q0b - W) >> 6; if (t_lo < 0) t_lo = 0;
      t_hi = ((q0b + 127 + W) >> 6) + 1; if (t_hi > SEQ / 64) t_hi = SEQ / 64;
      t_lo = __builtin_amdgcn_readfirstlane(t_lo); t_hi = __builtin_amdgcn_readfirstlane(t_hi);
      nocheck = Bb <= ATT_NOCHK; }
    const int NT = t_hi - t_lo;
    asm volatile("s_waitcnt vmcnt(0)\n\ts_barrier" ::: "memory");
    unsigned tacc_ = 0, t0_ = 0;
    if (DIAG && DIAG_SEL == 0) t0_ = (unsigned)clock64();
#define STEP_END(ms_) do { if ((ms_) + 2 < NT) asm volatile("s_waitcnt vmcnt(4) lgkmcnt(0)\n\ts_barrier" ::: "memory");     \
                           else asm volatile("s_waitcnt vmcnt(0) lgkmcnt(0)\n\ts_barrier" ::: "memory"); } while (0)
    if (wid < 8) {
        const int n_plain = nocheck ? 2 : NT;
        for (int ms = 0; ms < n_plain; ++ms) {
            const int msx = ms < 2 ? (ms ^ (qs >> 1)) : ms;
            const int t = TILE_OF(msx), cur = msx & 3;
            if (DIAG && DIAG_SEL == 1) t0_ = (unsigned)clock64();
            {
        const LAS unsigned char* kc = kfb + cur * 32768;
#undef KA
#define KA(ks, kb) (*(const LAS bf16x8*)(kc + (ks) * 2048 + (kb) * 512))
        f32x16 p0, p1; float alpha = 1.0f;
        if (ms < 1) {
#pragma unroll
            for (int i = 0; i < 16; ++i) { p0[i] = 0.f; p1[i] = 0.f; }
#pragma unroll
            for (int kh = 0; kh < 2; ++kh) { const bf16x8 k00 = KA(2 * kh, 0), k01 = KA(2 * kh, 1), k10 = KA(2 * kh + 1, 0), k11 = KA(2 * kh + 1, 1);
                p0 = MFMA32(k00, qf[2 * kh], p0); p1 = MFMA32(k01, qf[2 * kh], p1); p0 = MFMA32(k10, qf[2 * kh + 1], p0); p1 = MFMA32(k11, qf[2 * kh + 1], p1); }
            const float dq = (float)(q0 + r - t * 64 - 4 * hi);
            float tmax = -1e30f;
#pragma unroll
            for (int i = 0; i < 16; ++i) {
                const float c0 = (float)((i & 3) + 8 * (i >> 2));
                p0[i] = __builtin_fmaf(-slope2, __builtin_fabsf(dq - c0), p0[i]);
                p1[i] = __builtin_fmaf(-slope2, __builtin_fabsf(dq - (c0 + 32.f)), p1[i]);
                tmax = fmaxf(tmax, fmaxf(p0[i], p1[i]));
            }
            tmax = fmaxf(tmax, __shfl_xor(tmax, 32));
            const float mnew = fmaxf(mrun, tmax); alpha = __builtin_amdgcn_exp2f(mrun - mnew); mrun = mnew;
#pragma unroll
            for (int i = 0; i < 16; ++i) { p0[i] -= mrun; p1[i] -= mrun; }
        } else {
            const bool right = t > (q0 >> 6);
            const float xq = (float)(q0 + r - 64 * t), ss2 = right ? -slope2 : slope2;
            const float A0 = -ss2 * xq - mrun;
            bf16x8 qx;
            { const unsigned u1 = cvtpk(A0, 0.f) & 0xffffu; const float r1 = A0 - __uint_as_float(u1 << 16);
              const unsigned u2 = cvtpk(r1, 0.f) & 0xffffu; const float r2 = r1 - __uint_as_float(u2 << 16);
              const unsigned u3 = cvtpk(r2, 0.f) & 0xffffu;
              const unsigned sgnm = right ? 0x80008000u : 0u;
              u32x4 w; w.x = (sl12 ^ sgnm) & himask; w.y = (((sl3 ^ sgnm) & 0xffffu) | (u1 << 16)) & himask; w.z = (u2 | (u3 << 16)) & himask; w.w = 0u;
              qx = __builtin_bit_cast(bf16x8, w); }
#pragma unroll
            for (int i = 0; i < 16; ++i) { p0[i] = 0.f; p1[i] = 0.f; }
            p0 = MFMA32(kc0, qx, p0); p1 = MFMA32(kc1, qx, p1);
#pragma unroll
            for (int kh = 0; kh < 2; ++kh) { const bf16x8 k00 = KA(2 * kh, 0), k01 = KA(2 * kh, 1), k10 = KA(2 * kh + 1, 0), k11 = KA(2 * kh + 1, 1);
                p0 = MFMA32(k00, qf[2 * kh], p0); p1 = MFMA32(k01, qf[2 * kh], p1); p0 = MFMA32(k10, qf[2 * kh + 1], p0); p1 = MFMA32(k11, qf[2 * kh + 1], p1); }
            if (!nocheck) {
            float ma = __builtin_fmaxf(__builtin_fmaxf(p0[0], p0[1]), p1[0]), mb = __builtin_fmaxf(__builtin_fmaxf(p0[2], p0[3]), p1[1]);
            ma = __builtin_fmaxf(__builtin_fmaxf(ma, p1[2]), p1[3]);
#pragma unroll
            for (int i = 4; i < 16; i += 4) { ma = __builtin_fmaxf(__builtin_fmaxf(ma, p0[i]), p0[i + 1]); mb = __builtin_fmaxf(__builtin_fmaxf(mb, p0[i + 2]), p0[i + 3]);
                ma = __builtin_fmaxf(__builtin_fmaxf(ma, p1[i]), p1[i + 1]); mb = __builtin_fmaxf(__builtin_fmaxf(mb, p1[i + 2]), p1[i + 3]); }
            float tm = __builtin_fmaxf(ma, mb);
            { auto rr = __builtin_amdgcn_permlane32_swap(__float_as_uint(tm), __float_as_uint(tm), false, false); tm = __builtin_fmaxf(__uint_as_float(rr[0]), __uint_as_float(rr[1])); }
            if (__builtin_expect(__any(tm > ATT_THR), 0)) {
                const float dl = __builtin_fmaxf(tm, 0.f); alpha = __builtin_amdgcn_exp2f(-dl); mrun += dl;
#pragma unroll
                for (int i = 0; i < 16; ++i) { p0[i] -= dl; p1[i] -= dl; }
            }
            }
        }
        if (ms > 0 && __any(alpha != 1.0f)) {
            lsum *= alpha;
            if (hi == 0) wsf[r] = alpha;
            asm volatile("s_waitcnt lgkmcnt(0)" ::: "memory");
#pragma unroll
            for (int i = 0; i < 16; ++i) { const float ai = wsf[crow(i, hi)];
#pragma unroll
                for (int cb = 0; cb < 4; ++cb) asm volatile("v_mul_f32 %0, %0, %1" : "+v"(o[cb][i]) : "v"(ai)); }
            asm volatile("s_waitcnt lgkmcnt(0)" ::: "memory");
        }
        f32x2_t ls2 = {0.f, 0.f};
#pragma unroll
        for (int j = 0; j < 8; ++j) { f32x2_t e0, e1; e0.x = __builtin_amdgcn_exp2f(p0[2 * j]); e0.y = __builtin_amdgcn_exp2f(p0[2 * j + 1]); e1.x = __builtin_amdgcn_exp2f(p1[2 * j]); e1.y = __builtin_amdgcn_exp2f(p1[2 * j + 1]);
            p0[2 * j] = e0.x; p0[2 * j + 1] = e0.y; p1[2 * j] = e1.x; p1[2 * j + 1] = e1.y; ls2 = ls2 + e0; ls2 = ls2 + e1; }
        lsum += ls2.x + ls2.y;
        { u32x4 w;
          w.x = cvtpk(p0[0], p0[1]); w.y = cvtpk(p0[2], p0[3]); w.z = cvtpk(p0[4], p0[5]); w.w = cvtpk(p0[6], p0[7]); pk[0] = __builtin_bit_cast(bf16x8, w);
          w.x = cvtpk(p0[8], p0[9]); w.y = cvtpk(p0[10], p0[11]); w.z = cvtpk(p0[12], p0[13]); w.w = cvtpk(p0[14], p0[15]); pk[1] = __builtin_bit_cast(bf16x8, w);
          w.x = cvtpk(p1[0], p1[1]); w.y = cvtpk(p1[2], p1[3]); w.z = cvtpk(p1[4], p1[5]); w.w = cvtpk(p1[6], p1[7]); pk[2] = __builtin_bit_cast(bf16x8, w);
          w.x = cvtpk(p1[8], p1[9]); w.y = cvtpk(p1[10], p1[11]); w.z = cvtpk(p1[12], p1[13]); w.w = cvtpk(p1[14], p1[15]); pk[3] = __builtin_bit_cast(bf16x8, w); }
            }
            if (DIAG && DIAG_SEL == 1) tacc_ += (unsigned)clock64() - t0_;
            if (DIAG && DIAG_SEL == 2) t0_ = (unsigned)clock64();
            if (ms + 2 < NT) ISSUE(TILE_OF(ms + 2), (ms + 2) & 3);
            {
        const unsigned va = vfa + cur * 32768;
#define TRR(dst, off) asm volatile("ds_read_b64_tr_b16 %0, %1 offset:%2" : "=&v"(dst) : "v"(va), "n"(off) : "memory")
#define READ8(L, H, S) do { TRR(L[0], ((2 * (S)) * 4 + 0) * 512); TRR(H[0], ((2 * (S) + 1) * 4 + 0) * 512); TRR(L[1], ((2 * (S)) * 4 + 1) * 512); TRR(H[1], ((2 * (S) + 1) * 4 + 1) * 512); \
                        TRR(L[2], ((2 * (S)) * 4 + 2) * 512); TRR(H[2], ((2 * (S) + 1) * 4 + 2) * 512); TRR(L[3], ((2 * (S)) * 4 + 3) * 512); TRR(H[3], ((2 * (S) + 1) * 4 + 3) * 512); } while (0)
#define WAITV(N, L, H) asm volatile("s_waitcnt lgkmcnt(" #N ")" : "+v"(L[0]), "+v"(H[0]), "+v"(L[1]), "+v"(H[1]), "+v"(L[2]), "+v"(H[2]), "+v"(L[3]), "+v"(H[3]) :: "memory")
#define PV4(S, L, H) do { _Pragma("unroll") for (int cb = 0; cb < 4; ++cb) { const bf16x8 vf = __builtin_shufflevector(L[cb], H[cb], 0, 1, 2, 3, 4, 5, 6, 7); o[cb] = MFMA32(pk[S], vf, o[cb]); } } while (0)
#if DIAG_LIGHT
        s16x4 la[4], ha[4];
        READ8(la, ha, 0); WAITV(0, la, ha); PV4(0, la, ha); READ8(la, ha, 1); WAITV(0, la, ha); PV4(1, la, ha);
        READ8(la, ha, 2); WAITV(0, la, ha); PV4(2, la, ha); READ8(la, ha, 3); WAITV(0, la, ha); PV4(3, la, ha);
#else
        s16x4 la[4], ha[4], lb[4], hb[4];
        READ8(la, ha, 0); READ8(lb, hb, 1);
        WAITV(8, la, ha); PV4(0, la, ha);
        READ8(la, ha, 2);
        WAITV(8, lb, hb); PV4(1, lb, hb);
        READ8(lb, hb, 3);
        WAITV(8, la, ha); PV4(2, la, ha);
        WAITV(0, lb, hb); PV4(3, lb, hb);
#endif
#undef TRR
#undef READ8
#undef WAITV
#undef PV4
            }
            if (DIAG && DIAG_SEL == 2) tacc_ += (unsigned)clock64() - t0_;
            if (DIAG && DIAG_SEL == 3) t0_ = (unsigned)clock64();
            STEP_END(ms);
            if (DIAG && DIAG_SEL == 3) tacc_ += (unsigned)clock64() - t0_;
        }
        if (n_plain < NT) {
            if (4 < NT) ISSUE(TILE_OF(4), 0);
            if (4 < NT) asm volatile("s_waitcnt vmcnt(4)\n\ts_barrier" ::: "memory"); else asm volatile("s_waitcnt vmcnt(0)\n\ts_barrier" ::: "memory");
            f32x16 pA0, pA1, pB0, pB1;
            {
              const int t_ = TILE_OF(2); const LAS unsigned char* kq_ = kfb + ((2) & 3) * 32768;
              const bool right_ = t_ >= td0; const float xq_ = (float)(q0 + r - 64 * t_), ss2_ = right_ ? -slope2 : slope2; const float A0_ = -ss2_ * xq_ - mrun;
              bf16x8 qx_;
              { const unsigned u1 = cvtpk(A0_, 0.f) & 0xffffu; const float r1 = A0_ - __uint_as_float(u1 << 16);
                const unsigned u2 = cvtpk(r1, 0.f) & 0xffffu; const float r2 = r1 - __uint_as_float(u2 << 16);
                const unsigned u3 = cvtpk(r2, 0.f) & 0xffffu; const unsigned sgnm = right_ ? 0x80008000u : 0u;
                u32x4 w; w.x = (sl12 ^ sgnm) & himask; w.y = (((sl3 ^ sgnm) & 0xffffu) | (u1 << 16)) & himask; w.z = (u2 | (u3 << 16)) & himask; w.w = 0u; qx_ = __builtin_bit_cast(bf16x8, w); }
#pragma unroll
              for (int i = 0; i < 16; ++i) { pA0[i] = 0.f; pA1[i] = 0.f; }
              pA0 = MFMA32(kc0, qx_, pA0); pA1 = MFMA32(kc1, qx_, pA1);
#pragma unroll
              for (int kh = 0; kh < 2; ++kh) { const bf16x8 k00 = *(const LAS bf16x8*)(kq_ + (2 * kh) * 2048), k01 = *(const LAS bf16x8*)(kq_ + (2 * kh) * 2048 + 512), k10 = *(const LAS bf16x8*)(kq_ + (2 * kh + 1) * 2048), k11 = *(const LAS bf16x8*)(kq_ + (2 * kh + 1) * 2048 + 512);
                  pA0 = MFMA32(k00, qf[2 * kh], pA0); pA1 = MFMA32(k01, qf[2 * kh], pA1); pA0 = MFMA32(k10, qf[2 * kh + 1], pA0); pA1 = MFMA32(k11, qf[2 * kh + 1], pA1); }
            }

            for (int msb = 2; msb < NT; msb += 2) {
          { const int ms_ = (msb);
            if (ms_ + 1 < NT) {
            {
              const int t_ = TILE_OF(ms_ + 1); const LAS unsigned char* kq_ = kfb + ((ms_ + 1) & 3) * 32768;
              const bool right_ = t_ >= td0; const float xq_ = (float)(q0 + r - 64 * t_), ss2_ = right_ ? -slope2 : slope2; const float A0_ = -ss2_ * xq_ - mrun;
              bf16x8 qx_;
              { const unsigned u1 = cvtpk(A0_, 0.f) & 0xffffu; const float r1 = A0_ - __uint_as_float(u1 << 16);
                const unsigned u2 = cvtpk(r1, 0.f) & 0xffffu; const float r2 = r1 - __uint_as_float(u2 << 16);
                const unsigned u3 = cvtpk(r2, 0.f) & 0xffffu; const unsigned sgnm = right_ ? 0x80008000u : 0u;
                u32x4 w; w.x = (sl12 ^ sgnm) & himask; w.y = (((sl3 ^ sgnm) & 0xffffu) | (u1 << 16)) & himask; w.z = (u2 | (u3 << 16)) & himask; w.w = 0u; qx_ = __builtin_bit_cast(bf16x8, w); }
#pragma unroll
              for (int i = 0; i < 16; ++i) { pB0[i] = 0.f; pB1[i] = 0.f; }
              pB0 = MFMA32(kc0, qx_, pB0); pB1 = MFMA32(kc1, qx_, pB1);
#pragma unroll
              for (int kh = 0; kh < 2; ++kh) { const bf16x8 k00 = *(const LAS bf16x8*)(kq_ + (2 * kh) * 2048), k01 = *(const LAS bf16x8*)(kq_ + (2 * kh) * 2048 + 512), k10 = *(const LAS bf16x8*)(kq_ + (2 * kh + 1) * 2048), k11 = *(const LAS bf16x8*)(kq_ + (2 * kh + 1) * 2048 + 512);
                  pB0 = MFMA32(k00, qf[2 * kh], pB0); pB1 = MFMA32(k01, qf[2 * kh], pB1); pB0 = MFMA32(k10, qf[2 * kh + 1], pB0); pB1 = MFMA32(k11, qf[2 * kh + 1], pB1); }
            }
            }
            {
        f32x2_t ls2 = {0.f, 0.f};
#pragma unroll
        for (int j = 0; j < 8; ++j) { f32x2_t e0, e1; e0.x = __builtin_amdgcn_exp2f(pA0[2 * j]); e0.y = __builtin_amdgcn_exp2f(pA0[2 * j + 1]); e1.x = __builtin_amdgcn_exp2f(pA1[2 * j]); e1.y = __builtin_amdgcn_exp2f(pA1[2 * j + 1]);
            pA0[2 * j] = e0.x; pA0[2 * j + 1] = e0.y; pA1[2 * j] = e1.x; pA1[2 * j + 1] = e1.y; ls2 = ls2 + e0; ls2 = ls2 + e1; }
        lsum += ls2.x + ls2.y;
        { u32x4 w;
          w.x = cvtpk(pA0[0], pA0[1]); w.y = cvtpk(pA0[2], pA0[3]); w.z = cvtpk(pA0[4], pA0[5]); w.w = cvtpk(pA0[6], pA0[7]); pk[0] = __builtin_bit_cast(bf16x8, w);
          w.x = cvtpk(pA0[8], pA0[9]); w.y = cvtpk(pA0[10], pA0[11]); w.z = cvtpk(pA0[12], pA0[13]); w.w = cvtpk(pA0[14], pA0[15]); pk[1] = __builtin_bit_cast(bf16x8, w);
          w.x = cvtpk(pA1[0], pA1[1]); w.y = cvtpk(pA1[2], pA1[3]); w.z = cvtpk(pA1[4], pA1[5]); w.w = cvtpk(pA1[6], pA1[7]); pk[2] = __builtin_bit_cast(bf16x8, w);
          w.x = cvtpk(pA1[8], pA1[9]); w.y = cvtpk(pA1[10], pA1[11]); w.z = cvtpk(pA1[12], pA1[13]); w.w = cvtpk(pA1[14], pA1[15]); pk[3] = __builtin_bit_cast(bf16x8, w); }
            }
            if (ms_ + 3 < NT) ISSUE(TILE_OF(ms_ + 3), (ms_ + 3) & 3);
            { const int cur = ms_ & 3;
        const unsigned va = vfa + cur * 32768;
#define TRR(dst, off) asm volatile("ds_read_b64_tr_b16 %0, %1 offset:%2" : "=&v"(dst) : "v"(va), "n"(off) : "memory")
#define READ8(L, H, S) do { TRR(L[0], ((2 * (S)) * 4 + 0) * 512); TRR(H[0], ((2 * (S) + 1) * 4 + 0) * 512); TRR(L[1], ((2 * (S)) * 4 + 1) * 512); TRR(H[1], ((2 * (S) + 1) * 4 + 1) * 512); \
                        TRR(L[2], ((2 * (S)) * 4 + 2) * 512); TRR(H[2], ((2 * (S) + 1) * 4 + 2) * 512); TRR(L[3], ((2 * (S)) * 4 + 3) * 512); TRR(H[3], ((2 * (S) + 1) * 4 + 3) * 512); } while (0)
#define WAITV(N, L, H) asm volatile("s_waitcnt lgkmcnt(" #N ")" : "+v"(L[0]), "+v"(H[0]), "+v"(L[1]), "+v"(H[1]), "+v"(L[2]), "+v"(H[2]), "+v"(L[3]), "+v"(H[3]) :: "memory")
#define PV4(S, L, H) do { _Pragma("unroll") for (int cb = 0; cb < 4; ++cb) { const bf16x8 vf = __builtin_shufflevector(L[cb], H[cb], 0, 1, 2, 3, 4, 5, 6, 7); o[cb] = MFMA32(pk[S], vf, o[cb]); } } while (0)
#if DIAG_LIGHT
        s16x4 la[4], ha[4];
        READ8(la, ha, 0); WAITV(0, la, ha); PV4(0, la, ha); READ8(la, ha, 1); WAITV(0, la, ha); PV4(1, la, ha);
        READ8(la, ha, 2); WAITV(0, la, ha); PV4(2, la, ha); READ8(la, ha, 3); WAITV(0, la, ha); PV4(3, la, ha);
#else
        s16x4 la[4], ha[4], lb[4], hb[4];
        READ8(la, ha, 0); READ8(lb, hb, 1);
        WAITV(8, la, ha); PV4(0, la, ha);
        READ8(la, ha, 2);
        WAITV(8, lb, hb); PV4(1, lb, hb);
        READ8(lb, hb, 3);
        WAITV(8, la, ha); PV4(2, la, ha);
        WAITV(0, lb, hb); PV4(3, lb, hb);
#endif
#undef TRR
#undef READ8
#undef WAITV
#undef PV4
            }
            if (ms_ + 3 < NT) asm volatile("s_waitcnt vmcnt(4) lgkmcnt(0)\n\ts_barrier" ::: "memory");
            else asm volatile("s_waitcnt vmcnt(0) lgkmcnt(0)\n\ts_barrier" ::: "memory");
          }

              if (msb + 1 < NT) {
          { const int ms_ = (msb + 1);
            if (ms_ + 1 < NT) {
            {
              const int t_ = TILE_OF(ms_ + 1); const LAS unsigned char* kq_ = kfb + ((ms_ + 1) & 3) * 32768;
              const bool right_ = t_ >= td0; const float xq_ = (float)(q0 + r - 64 * t_), ss2_ = right_ ? -slope2 : slope2; const float A0_ = -ss2_ * xq_ - mrun;
              bf16x8 qx_;
              { const unsigned u1 = cvtpk(A0_, 0.f) & 0xffffu; const float r1 = A0_ - __uint_as_float(u1 << 16);
                const unsigned u2 = cvtpk(r1, 0.f) & 0xffffu; const float r2 = r1 - __uint_as_float(u2 << 16);
                const unsigned u3 = cvtpk(r2, 0.f) & 0xffffu; const unsigned sgnm = right_ ? 0x80008000u : 0u;
                u32x4 w; w.x = (sl12 ^ sgnm) & himask; w.y = (((sl3 ^ sgnm) & 0xffffu) | (u1 << 16)) & himask; w.z = (u2 | (u3 << 16)) & himask; w.w = 0u; qx_ = __builtin_bit_cast(bf16x8, w); }
#pragma unroll
              for (int i = 0; i < 16; ++i) { pA0[i] = 0.f; pA1[i] = 0.f; }
              pA0 = MFMA32(kc0, qx_, pA0); pA1 = MFMA32(kc1, qx_, pA1);
#pragma unroll
              for (int kh = 0; kh < 2; ++kh) { const bf16x8 k00 = *(const LAS bf16x8*)(kq_ + (2 * kh) * 2048), k01 = *(const LAS bf16x8*)(kq_ + (2 * kh) * 2048 + 512), k10 = *(const LAS bf16x8*)(kq_ + (2 * kh + 1) * 2048), k11 = *(const LAS bf16x8*)(kq_ + (2 * kh + 1) * 2048 + 512);
                  pA0 = MFMA32(k00, qf[2 * kh], pA0); pA1 = MFMA32(k01, qf[2 * kh], pA1); pA0 = MFMA32(k10, qf[2 * kh + 1], pA0); pA1 = MFMA32(k11, qf[2 * kh + 1], pA1); }
            }
            }
            {
        f32x2_t ls2 = {0.f, 0.f};
#pragma unroll
        for (int j = 0; j < 8; ++j) { f32x2_t e0, e1; e0.x = __builtin_amdgcn_exp2f(pB0[2 * j]); e0.y = __builtin_amdgcn_exp2f(pB0[2 * j + 1]); e1.x = __builtin_amdgcn_exp2f(pB1[2 * j]); e1.y = __builtin_amdgcn_exp2f(pB1[2 * j + 1]);
            pB0[2 * j] = e0.x; pB0[2 * j + 1] = e0.y; pB1[2 * j] = e1.x; pB1[2 * j + 1] = e1.y; ls2 = ls2 + e0; ls2 = ls2 + e1; }
        lsum += ls2.x + ls2.y;
        { u32x4 w;
          w.x = cvtpk(pB0[0], pB0[1]); w.y = cvtpk(pB0[2], pB0[3]); w.z = cvtpk(pB0[4], pB0[5]); w.w = cvtpk(pB0[6], pB0[7]); pk[0] = __builtin_bit_cast(bf16x8, w);
          w.x = cvtpk(pB0[8], pB0[9]); w.y = cvtpk(pB0[10], pB0[11]); w.z = cvtpk(pB0[12], pB0[13]); w.w = cvtpk(pB0[14], pB0[15]); pk[1] = __builtin_bit_cast(bf16x8, w);
          w.x = cvtpk(pB1[0], pB1[1]); w.y = cvtpk(pB1[2], pB1[3]); w.z = cvtpk(pB1[4], pB1[5]); w.w = cvtpk(pB1[6], pB1[7]); pk[2] = __builtin_bit_cast(bf16x8, w);
          w.x = cvtpk(pB1[8], pB1[9]); w.y = cvtpk(pB1[10], pB1[11]); w.z = cvtpk(pB1[12], pB1[13]); w.w = cvtpk(pB1[14], pB1[15]); pk[3] = __builtin_bit_cast(bf16x8, w); }
            }
            if (ms_ + 3 < NT) ISSUE(TILE_OF(ms_ + 3), (ms_ + 3) & 3);
            { const int cur = ms_ & 3;
        const unsigned va = vfa + cur * 32768;
#define TRR(dst, off) asm volatile("ds_read_b64_tr_b16 %0, %1 offset:%2" : "=&v"(dst) : "v"(va), "n"(off) : "memory")
#define READ8(L, H, S) do { TRR(L[0], ((2 * (S)) * 4 + 0) * 512); TRR(H[0], ((2 * (S) + 1) * 4 + 0) * 512); TRR(L[1], ((2 * (S)) * 4 + 1) * 512); TRR(H[1], ((2 * (S) + 1) * 4 + 1) * 512); \
                        TRR(L[2], ((2 * (S)) * 4 + 2) * 512); TRR(H[2], ((2 * (S) + 1) * 4 + 2) * 512); TRR(L[3], ((2 * (S)) * 4 + 3) * 512); TRR(H[3], ((2 * (S) + 1) * 4 + 3) * 512); } while (0)
#define WAITV(N, L, H) asm volatile("s_waitcnt lgkmcnt(" #N ")" : "+v"(L[0]), "+v"(H[0]), "+v"(L[1]), "+v"(H[1]), "+v"(L[2]), "+v"(H[2]), "+v"(L[3]), "+v"(H[3]) :: "memory")
#define PV4(S, L, H) do { _Pragma("unroll") for (int cb = 0; cb < 4; ++cb) { const bf16x8 vf = __builtin_shufflevector(L[cb], H[cb], 0, 1, 2, 3, 4, 5, 6, 7); o[cb] = MFMA32(pk[S], vf, o[cb]); } } while (0)
#if DIAG_LIGHT
        s16x4 la[4], ha[4];
        READ8(la, ha, 0); WAITV(0, la, ha); PV4(0, la, ha); READ8(la, ha, 1); WAITV(0, la, ha); PV4(1, la, ha);
        READ8(la, ha, 2); WAITV(0, la, ha); PV4(2, la, ha); READ8(la, ha, 3); WAITV(0, la, ha); PV4(3, la, ha);
#else
        s16x4 la[4], ha[4], lb[4], hb[4];
        READ8(la, ha, 0); READ8(lb, hb, 1);
        WAITV(8, la, ha); PV4(0, la, ha);
        READ8(la, ha, 2);
        WAITV(8, lb, hb); PV4(1, lb, hb);
        READ8(lb, hb, 3);
        WAITV(8, la, ha); PV4(2, la, ha);
        WAITV(0, lb, hb); PV4(3, lb, hb);
#endif
#undef TRR
#undef READ8
#undef WAITV
#undef PV4
            }
            if (ms_ + 3 < NT) asm volatile("s_waitcnt vmcnt(4) lgkmcnt(0)\n\ts_barrier" ::: "memory");
            else asm volatile("s_waitcnt vmcnt(0) lgkmcnt(0)\n\ts_barrier" ::: "memory");
          }

              }
            }
        }
        asm volatile("s_waitcnt lgkmcnt(0)\n\ts_barrier" ::: "memory");
    } else {
        __builtin_amdgcn_s_setprio(1);
        for (int ms = 0; ms <= NT; ++ms) {
            if (ms + 2 < NT) ISSUE(TILE_OF(ms + 2), (ms + 2) & 3);
            if (ms > 0) {
                const int cur = (ms - 1) & 3;
        const unsigned va = vfa + cur * 32768;
#define TRR(dst, off) asm volatile("ds_read_b64_tr_b16 %0, %1 offset:%2" : "=&v"(dst) : "v"(va), "n"(off) : "memory")
#define READ8(L, H, S) do { TRR(L[0], ((2 * (S)) * 4 + 0) * 512); TRR(H[0], ((2 * (S) + 1) * 4 + 0) * 512); TRR(L[1], ((2 * (S)) * 4 + 1) * 512); TRR(H[1], ((2 * (S) + 1) * 4 + 1) * 512); \
                        TRR(L[2], ((2 * (S)) * 4 + 2) * 512); TRR(H[2], ((2 * (S) + 1) * 4 + 2) * 512); TRR(L[3], ((2 * (S)) * 4 + 3) * 512); TRR(H[3], ((2 * (S) + 1) * 4 + 3) * 512); } while (0)
#define WAITV(N, L, H) asm volatile("s_waitcnt lgkmcnt(" #N ")" : "+v"(L[0]), "+v"(H[0]), "+v"(L[1]), "+v"(H[1]), "+v"(L[2]), "+v"(H[2]), "+v"(L[3]), "+v"(H[3]) :: "memory")
#define PV4(S, L, H) do { _Pragma("unroll") for (int cb = 0; cb < 4; ++cb) { const bf16x8 vf = __builtin_shufflevector(L[cb], H[cb], 0, 1, 2, 3, 4, 5, 6, 7); o[cb] = MFMA32(pk[S], vf, o[cb]); } } while (0)
#if DIAG_LIGHT
        s16x4 la[4], ha[4];
        READ8(la, ha, 0); WAITV(0, la, ha); PV4(0, la, ha); READ8(la, ha, 1); WAITV(0, la, ha); PV4(1, la, ha);
        READ8(la, ha, 2); WAITV(0, la, ha); PV4(2, la, ha); READ8(la, ha, 3); WAITV(0, la, ha); PV4(3, la, ha);
#else
        s16x4 la[4], ha[4], lb[4], hb[4];
        READ8(la, ha, 0); READ8(lb, hb, 1);
        WAITV(8, la, ha); PV4(0, la, ha);
        READ8(la, ha, 2);
        WAITV(8, lb, hb); PV4(1, lb, hb);
        READ8(lb, hb, 3);
        WAITV(8, la, ha); PV4(2, la, ha);
        WAITV(0, lb, hb); PV4(3, lb, hb);
#endif
#undef TRR
#undef READ8
#undef WAITV
#undef PV4
            }
            if (ms < NT) {
                const int t = TILE_OF(ms), cur = ms & 3;
        const LAS unsigned char* kc = kfb + cur * 32768;
#undef KA
#define KA(ks, kb) (*(const LAS bf16x8*)(kc + (ks) * 2048 + (kb) * 512))
        f32x16 p0, p1; float alpha = 1.0f;
        if (ms < 2) {
#pragma unroll
            for (int i = 0; i < 16; ++i) { p0[i] = 0.f; p1[i] = 0.f; }
#pragma unroll
            for (int kh = 0; kh < 2; ++kh) { const bf16x8 k00 = KA(2 * kh, 0), k01 = KA(2 * kh, 1), k10 = KA(2 * kh + 1, 0), k11 = KA(2 * kh + 1, 1);
                p0 = MFMA32(k00, qf[2 * kh], p0); p1 = MFMA32(k01, qf[2 * kh], p1); p0 = MFMA32(k10, qf[2 * kh + 1], p0); p1 = MFMA32(k11, qf[2 * kh + 1], p1); }
            const float dq = (float)(q0 + r - t * 64 - 4 * hi);
            float tmax = -1e30f;
#pragma unroll
            for (int i = 0; i < 16; ++i) {
                const float c0 = (float)((i & 3) + 8 * (i >> 2));
                p0[i] = __builtin_fmaf(-slope2, __builtin_fabsf(dq - c0), p0[i]);
                p1[i] = __builtin_fmaf(-slope2, __builtin_fabsf(dq - (c0 + 32.f)), p1[i]);
                tmax = fmaxf(tmax, fmaxf(p0[i], p1[i]));
            }
            tmax = fmaxf(tmax, __shfl_xor(tmax, 32));
            const float mnew = fmaxf(mrun, tmax); alpha = __builtin_amdgcn_exp2f(mrun - mnew); mrun = mnew;
#pragma unroll
            for (int i = 0; i < 16; ++i) { p0[i] -= mrun; p1[i] -= mrun; }
        } else {
            const bool right = t >= td0;
            const float xq = (float)(q0 + r - 64 * t), ss2 = right ? -slope2 : slope2;
            const float A0 = -ss2 * xq - mrun;
            bf16x8 qx;
            { const unsigned u1 = cvtpk(A0, 0.f) & 0xffffu; const float r1 = A0 - __uint_as_float(u1 << 16);
              const unsigned u2 = cvtpk(r1, 0.f) & 0xffffu; const float r2 = r1 - __uint_as_float(u2 << 16);
              const unsigned u3 = cvtpk(r2, 0.f) & 0xffffu;
              const unsigned sgnm = right ? 0x80008000u : 0u;
              u32x4 w; w.x = (sl12 ^ sgnm) & himask; w.y = (((sl3 ^ sgnm) & 0xffffu) | (u1 << 16)) & himask; w.z = (u2 | (u3 << 16)) & himask; w.w = 0u;
              qx = __builtin_bit_cast(bf16x8, w); }
#pragma unroll
            for (int i = 0; i < 16; ++i) { p0[i] = 0.f; p1[i] = 0.f; }
            p0 = MFMA32(kc0, qx, p0); p1 = MFMA32(kc1, qx, p1);
#pragma unroll
            for (int kh = 0; kh < 2; ++kh) { const bf16x8 k00 = KA(2 * kh, 0), k01 = KA(2 * kh, 1), k10 = KA(2 * kh + 1, 0), k11 = KA(2 * kh + 1, 1);
                p0 = MFMA32(k00, qf[2 * kh], p0); p1 = MFMA32(k01, qf[2 * kh], p1); p0 = MFMA32(k10, qf[2 * kh + 1], p0); p1 = MFMA32(k11, qf[2 * kh + 1], p1); }
            if (!nocheck) {
            float ma = __builtin_fmaxf(__builtin_fmaxf(p0[0], p0[1]), p1[0]), mb = __builtin_fmaxf(__builtin_fmaxf(p0[2], p0[3]), p1[1]);
            ma = __builtin_fmaxf(__builtin_fmaxf(ma, p1[2]), p1[3]);
#pragma unroll
            for (int i = 4; i < 16; i += 4) { ma = __builtin_fmaxf(__builtin_fmaxf(ma, p0[i]), p0[i + 1]); mb = __builtin_fmaxf(__builtin_fmaxf(mb, p0[i + 2]), p0[i + 3]);
                ma = __builtin_fmaxf(__builtin_fmaxf(ma, p1[i]), p1[i + 1]); mb = __builtin_fmaxf(__builtin_fmaxf(mb, p1[i + 2]), p1[i + 3]); }
            float tm = __builtin_fmaxf(ma, mb);
            { auto rr = __builtin_amdgcn_permlane32_swap(__float_as_uint(tm), __float_as_uint(tm), false, false); tm = __builtin_fmaxf(__uint_as_float(rr[0]), __uint_as_float(rr[1])); }
            if (__builtin_expect(__any(tm > ATT_THR), 0)) {
                const float dl = __builtin_fmaxf(tm, 0.f); alpha = __builtin_amdgcn_exp2f(-dl); mrun += dl;
#pragma unroll
                for (int i = 0; i < 16; ++i) { p0[i] -= dl; p1[i] -= dl; }
            }
            }
        }
        if (__any(alpha != 1.0f)) {
            lsum *= alpha;
            if (hi == 0) wsf[r] = alpha;
            asm volatile("s_waitcnt lgkmcnt(0)" ::: "memory");
#pragma unroll
            for (int i = 0; i < 16; ++i) { const float ai = wsf[crow(i, hi)];
#pragma unroll
                for (int cb = 0; cb < 4; ++cb) asm volatile("v_mul_f32 %0, %0, %1" : "+v"(o[cb][i]) : "v"(ai)); }
            asm volatile("s_waitcnt lgkmcnt(0)" ::: "memory");
        }
        f32x2_t ls2 = {0.f, 0.f};
#pragma unroll
        for (int j = 0; j < 8; ++j) { f32x2_t e0, e1; e0.x = __builtin_amdgcn_exp2f(p0[2 * j]); e0.y = __builtin_amdgcn_exp2f(p0[2 * j + 1]); e1.x = __builtin_amdgcn_exp2f(p1[2 * j]); e1.y = __builtin_amdgcn_exp2f(p1[2 * j + 1]);
            p0[2 * j] = e0.x; p0[2 * j + 1] = e0.y; p1[2 * j] = e1.x; p1[2 * j + 1] = e1.y; ls2 = ls2 + e0; ls2 = ls2 + e1; }
        lsum += ls2.x + ls2.y;
        { u32x4 w;
          w.x = cvtpk(p0[0], p0[1]); w.y = cvtpk(p0[2], p0[3]); w.z = cvtpk(p0[4], p0[5]); w.w = cvtpk(p0[6], p0[7]); pk[0] = __builtin_bit_cast(bf16x8, w);
          w.x = cvtpk(p0[8], p0[9]); w.y = cvtpk(p0[10], p0[11]); w.z = cvtpk(p0[12], p0[13]); w.w = cvtpk(p0[14], p0[15]); pk[1] = __builtin_bit_cast(bf16x8, w);
          w.x = cvtpk(p1[0], p1[1]); w.y = cvtpk(p1[2], p1[3]); w.z = cvtpk(p1[4], p1[5]); w.w = cvtpk(p1[6], p1[7]); pk[2] = __builtin_bit_cast(bf16x8, w);
          w.x = cvtpk(p1[8], p1[9]); w.y = cvtpk(p1[10], p1[11]); w.z = cvtpk(p1[12], p1[13]); w.w = cvtpk(p1[14], p1[15]); pk[3] = __builtin_bit_cast(bf16x8, w); }
                STEP_END(ms);
            } else asm volatile("s_waitcnt lgkmcnt(0)\n\ts_barrier" ::: "memory");
        }
        __builtin_amdgcn_s_setprio(0);
    }
#undef STEP_END
    if (DIAG && wid == DIAG_WAVE && lane == 0 && *(const LAS unsigned*)(lds + 131072 + 256 + 2048 + 12) != 0u) { if (DIAG_SEL == 0) tacc_ = (unsigned)clock64() - t0_;
        unsigned* dg_ = (unsigned*)((unsigned char*)Kt - WS_K) + 3000; dg_[0] = tacc_ / (unsigned)NT; }
#undef TILE_OF
#undef ISSUE
    lsum += __shfl_xor(lsum, 32);
    float inv = 1.0f / lsum; if (map == 1) inv *= *(const LAS float*)(lds + 131072 + 256 + 2048 + 8);
    if (hi == 0) wsf[r] = inv;
    asm volatile("s_waitcnt lgkmcnt(0)" ::: "memory");
#pragma unroll
    for (int i = 0; i < 16; ++i) { const float si = wsf[crow(i, hi)];
#pragma unroll
        for (int cb = 0; cb < 4; ++cb) o[cb][i] *= si; }
    LAS float* xch = (LAS float*)lds + qs * 4096;
    if (map == 1) {
#pragma unroll
        for (int cb = 0; cb < 4; ++cb)
#pragma unroll
            for (int i = 0; i < 16; ++i) xch[(cb * 16 + i) * 64 + lane] = o[cb][i];
    }
    __syncthreads();
    if (map == 0) {
        float ss[16];
#pragma unroll
        for (int i = 0; i < 16; ++i) { ss[i] = 0.f;
#pragma unroll
            for (int cb = 0; cb < 4; ++cb) { o[cb][i] -= xch[(cb * 16 + i) * 64 + lane]; ss[i] += o[cb][i] * o[cb][i]; } }
#pragma unroll
        for (int i = 0; i < 16; ++i) {
#pragma unroll
            for (int sft = 1; sft < 32; sft <<= 1) ss[i] += __shfl_xor(ss[i], sft);
            ss[i] = post / sqrtf(ss[i] * (1.0f / V_DIM) + EPS);
        }
#pragma unroll
        for (int cb = 0; cb < 4; ++cb) { const float g = subg[cb * 32 + r];
#pragma unroll
            for (int i = 0; i < 16; ++i) ((GAS bf16*)ON)[(tokbase + q0 + crow(i, hi)) * (CONV_W + ATTN_W) + h * 128 + cb * 32 + r] = (bf16)f2bf(o[cb][i] * ss[i] * g); }
    }
    __syncthreads();
}

#define XB_TMO      128
#define XB_XCNT(j)  (256  + 64 * (j))
#define XB_XSUB(j)  (1280 + 64 * (j))
#define XB_XGEN(j)  (2304 + 64 * (j))
#define XB_TOP      3328
#define XB_TOPGEN   3392
#define XCD_BAR_WORDS 3456
#define XB_SPIN_CAP (1u << 18)

__device__ __forceinline__ unsigned xb_ld(unsigned* p)              { return __hip_atomic_load(p, __ATOMIC_RELAXED, __HIP_MEMORY_SCOPE_AGENT); }
__device__ __forceinline__ unsigned xb_add(unsigned* p, unsigned v) { return __hip_atomic_fetch_add(p, v, __ATOMIC_RELAXED, __HIP_MEMORY_SCOPE_AGENT); }
__device__ __forceinline__ unsigned xb_xcc_id() { return (unsigned)__builtin_amdgcn_s_getreg((3 << 11) | 20) & 0xFu; }
#define XB_SPIN(cond, bar) do { unsigned _sp = 0; while (cond) { __builtin_amdgcn_s_sleep(1); \
    if ((++_sp & 255u) == 0u) { if (xb_ld(&(bar)[XB_TMO])) break; if (_sp > XB_SPIN_CAP) { atomicAdd(&(bar)[XB_TMO], 1u); break; } } } } while (0)

struct XcdBarrier {
    unsigned* bar; unsigned x;
    volatile LAS unsigned* st;
};

__device__ __forceinline__ XcdBarrier xcd_barrier_post(unsigned* bar, volatile LAS unsigned* st) {
    XcdBarrier b; b.bar = bar; b.x = xb_xcc_id(); b.st = st;
    if (threadIdx.x == 0) (void)xb_add(&bar[XB_XCNT(b.x)], 1u);
    return b;
}
__device__ __forceinline__ void xcd_barrier_complete(unsigned* bar, unsigned x, unsigned& nloc, unsigned& nx) {
    const unsigned G = gridDim.x * gridDim.y * gridDim.z;
    unsigned sum, cnt, mine, sp = 0u;
    for (;;) {
        sum = 0u; cnt = 0u; mine = 0u;
#pragma unroll
        for (unsigned j = 0; j < 16; ++j) { const unsigned c = xb_ld(&bar[XB_XCNT(j)]); sum += c; cnt += (c > 0u) ? 1u : 0u; mine = (j == x) ? c : mine; }
        if (sum == G) break;
        __builtin_amdgcn_s_sleep(1);
        if ((++sp & 255u) == 0u) { if (xb_ld(&bar[XB_TMO])) break; if (sp > XB_SPIN_CAP) { atomicAdd(&bar[XB_TMO], 1u); break; } }
    }
    nloc = mine > 0u ? mine : 1u; nx = cnt > 0u ? cnt : 1u;
}

__device__ __forceinline__ void xcd_barrier(const XcdBarrier& b) {
    asm volatile("s_waitcnt vmcnt(0)" ::: "memory");
    __syncthreads();
    if (threadIdx.x == 0) {
        unsigned* bar = b.bar;
        __builtin_amdgcn_s_waitcnt(0);
        unsigned nloc = b.st[0], nx = b.st[1];
        if (nloc == 0u) { xcd_barrier_complete(bar, b.x, nloc, nx); b.st[0] = nloc; b.st[1] = nx; }
        const unsigned old = xb_add(&bar[XB_XSUB(b.x)], 1u);
        const unsigned gen = old / nloc;
        if (old + 1u == (gen + 1u) * nloc) {
            __builtin_amdgcn_fence(__ATOMIC_RELEASE, "agent");
            asm volatile("s_waitcnt vmcnt(0)" ::: "memory");
            const unsigned og = xb_add(&bar[XB_TOP], 1u);
            const unsigned tg = og / nx;
            if (og + 1u == (tg + 1u) * nx) xb_add(&bar[XB_TOPGEN], 1u);
            else XB_SPIN(xb_ld(&bar[XB_TOPGEN]) == tg, bar);
            __builtin_amdgcn_fence(__ATOMIC_ACQUIRE, "agent");
            xb_add(&bar[XB_XGEN(b.x)], 1u);
            asm volatile("s_waitcnt vmcnt(0)" ::: "memory");
        } else {
            XB_SPIN(xb_ld(&bar[XB_XGEN(b.x)]) == gen, bar);
            __builtin_amdgcn_fence(__ATOMIC_ACQUIRE, "agent");
            asm volatile("s_waitcnt vmcnt(0)" ::: "memory");
        }
    }
    __syncthreads();
}


#ifndef REP_ATT
#define REP_ATT 1
#endif
#ifndef REP_GEMM
#define REP_GEMM 1
#endif
#ifndef PHM
#define PHM 127
#endif
__global__ void __launch_bounds__(512) mk_fwd(Args a) {
    extern __shared__ __attribute__((aligned(16))) unsigned char lds_raw[];
    LAS unsigned char* lds = (LAS unsigned char*)lds_raw;
    const int G = gridDim.x, bx = blockIdx.x;
    volatile LAS unsigned* MISC = (volatile LAS unsigned*)(lds + 131072 + 64);
    if (threadIdx.x < 4) MISC[threadIdx.x] = 0u;
    __syncthreads();
    XcdBarrier xbar = xcd_barrier_post((unsigned*)(a.ws + WS_CTL) + 4096, MISC);
    for (int p = a.ph_lo; p < a.ph_hi; ++p) {
        const int l = p >> 3, k = p & 7;
        int tid_ = threadIdx.x; asm volatile("" : "+v"(tid_));
        const int tid = tid_, wave = __builtin_amdgcn_readfirstlane(tid >> 6);
#define FRESH_LANE() ({ int t_ = threadIdx.x; asm volatile("" : "+v"(t_)); t_ & 63; })
        const int gw = bx * 8 + wave, NGW = G * 8;
    unsigned char* ws = a.ws; asm volatile("" : "+s"(ws));
    bf16* U = (bf16*)(ws + WS_U); bf16* CONV = (bf16*)(ws + WS_CONV); bf16* Qb = (bf16*)(ws + WS_Q); bf16* Kt = (bf16*)(ws + WS_K); bf16* Vt = (bf16*)(ws + WS_V);
    bf16* Gt = (bf16*)(ws + WS_G); bf16* Z = (bf16*)(ws + WS_Z); bf16* ON = Z + CONV_W;   bf16* MO = (bf16*)(ws + WS_MO);
    bf16* Ah = (bf16*)(ws + WS_A); bf16* Fo = (bf16*)(ws + WS_F); bf16* MERGED = U;
    const unsigned char* wb = ws + WS_W;
    float* hbuf = a.out;
    const float* norm_g = a.in[9];
        unsigned* ctl = (unsigned*)(ws + WS_CTL);
        if ((PHM & 1) && k == 0) {
            if (l < DEPTH) convert_weights(a, l, lds, (l == 0 ? 0 : W_IN_ITEMS) + gw, 1 << 30, NGW, wave, FRESH_LANE());
            if (l == 0) row_phase<false, true>(a.in[0], nullptr, nullptr, hbuf, norm_g + (size_t)(0 * 4 + 0) * D_MODEL, U, gw, NGW, FRESH_LANE());
            else if (l < DEPTH) row_phase<true, true>(hbuf, Fo, norm_g + (size_t)((l - 1) * 4 + 3) * D_MODEL, hbuf, norm_g + (size_t)(l * 4 + 0) * D_MODEL, U, gw, NGW, FRESH_LANE());
            else row_phase<true, false>(hbuf, Fo, norm_g + (size_t)((l - 1) * 4 + 3) * D_MODEL, hbuf, nullptr, nullptr, gw, NGW, FRESH_LANE());
            if (DIAG && l == DEPTH) { __syncthreads(); if (bx == 0 && tid == 0) hbuf[0] += (float)ctl[3000] * DIAG_SCALE; }
        } else if ((PHM & 2) && k == 1) {
            pg8::Gemm g{U, (const bf16*)(wb + W_IN_OFF), M, IN_W, D_MODEL}; pg8::StaticOrder S; S.init(M, IN_W, G, bx);
            pg8::EpiWin E{CONV, Qb, Kt, Vt, Gt, a.in[2] + (size_t)l * 2 * D_MODEL, 0.125f * LOG2E, ctl + 1024 + l * 64};
            for (int rep = 0; rep < REP_GEMM; ++rep) pg8::gemm_phase<pg8::EpiWin, pg8::StaticOrder, true, true>(lds, g, S, E);
        } else if ((PHM & 4) && k == 2) {
            const float lam_init = 0.8f - 0.6f * expf(-0.3f * (float)l);
            const float* lq = a.in[5] + (size_t)l * 4 * HEAD_DIM;
            const int ln_ = FRESH_LANE(); const float s1 = wave_sum(lq[ln_] * lq[64 + ln_]), s2 = wave_sum(lq[128 + ln_] * lq[192 + ln_]);
            const float lam = expf(s1) - expf(s2) + lam_init;
            const float* subg = a.in[6] + (size_t)l * V_DIM;
            LAS unsigned* sq = (LAS unsigned*)(lds + 131072 + 256 + 2048);
            if (tid == 0) *(LAS float*)(lds + 131072 + 256 + 2048 + 8) = lam;
            const unsigned* nq = ctl + 1024 + l * 64; const unsigned* nk = nq + 32;
            for (int rep = 0; rep < REP_ATT; ++rep)
            for (;;) {
                __syncthreads();
                if (tid == 0) sq[0] = atomicAdd(ctl + l * 64 + rep * 16, 1u);
                __syncthreads();
                const int u = (int)sq[0];
                if (u >= 512) {
                    const int v = u - 512;
                    if (v < M / 64) { conv_items(CONV, a.in[3] + (size_t)l * 3 * CONV_W, Z, v * 8 + wave, v * 8 + 8, 8, FRESH_LANE()); continue; }
                    if (l + 1 < DEPTH && v < M / 64 + W_IN_ITEMS / 32) { const int c = v - M / 64; convert_weights(a, l + 1, lds, c * 32 + wave, c * 32 + 32, 8, wave, FRESH_LANE()); continue; }
                    break; }
                const int h = 3 - (u >> 7), idx = u & 127, b = idx & 1, jj = idx >> 1, qb = (jj & 1) ? 31 - (jj >> 1) : 32 + (jj >> 1);
                const float slope2 = exp2f(-2.0f * (float)(h + 1)) * LOG2E;
                const unsigned* wq = nq + (b * 4 + h) * 4; const unsigned* wk = nk + (b * 4 + h) * 4;
                const float kn0 = __uint_as_float(wk[0]) + __uint_as_float(wk[1]), kn1 = __uint_as_float(wk[2]) + __uint_as_float(wk[3]);
                if (DIAG && tid == 0) sq[3] = (u == 0) ? 1u : 0u;
                attn_unit(b, h, qb, kn0, kn1, Qb, Kt, Vt, ON, lds, slope2, subg, 1.0f - lam_init);
            }
        } else if ((PHM & 8) && k == 3) {
            pg8::Gemm g{Z, (const bf16*)(wb + W_CO_OFF), M, D_MODEL, CONV_W + ATTN_W}; pg8::StaticOrder S; S.init(M, D_MODEL, G, bx);
            pg8::EpiMerge E{Gt, MERGED};
            for (int rep = 0; rep < REP_GEMM; ++rep) pg8::gemm_phase<pg8::EpiMerge, pg8::StaticOrder, true, true>(lds, g, S, E);
        } else if ((PHM & 16) && (k == 4 || k == 7)) {
            const bool ff = (k == 7);
            pg8::Gemm g{ff ? Ah : MERGED, (const bf16*)(wb + (ff ? W_F2_OFF : W_O_OFF)), M, D_MODEL, ff ? D_FF : D_MODEL}; pg8::StaticOrder S; S.init(M, D_MODEL, G, bx);
            pg8::EpiBf16P E{ff ? Fo : MO, D_MODEL};
            for (int rep = 0; rep < REP_GEMM; ++rep) pg8::gemm_phase<pg8::EpiBf16P, pg8::StaticOrder, true, true>(lds, g, S, E);
        } else if ((PHM & 32) && k == 5) {
            row_phase<true, true>(hbuf, MO, norm_g + (size_t)(l * 4 + 1) * D_MODEL, hbuf, norm_g + (size_t)(l * 4 + 2) * D_MODEL, U, gw, NGW, FRESH_LANE());
        } else if ((PHM & 64) && k == 6) {
            pg8::Gemm g{U, (const bf16*)(wb + W_F1_OFF), M, D_FF, D_MODEL}; pg8::StaticOrder S; S.init(M, D_FF, G, bx);
            pg8::EpiRelu2 E{Ah, D_FF};
            for (int rep = 0; rep < REP_GEMM; ++rep) pg8::gemm_phase<pg8::EpiRelu2, pg8::StaticOrder, true, true>(lds, g, S, E);
        }
        if (p + 1 < a.ph_hi) {
            if (a.ph_lo < 0) cg::this_grid().sync();
            xcd_barrier(xbar);
        }
    }
}

constexpr int N_PHASES = DEPTH * 8 + 1;
#ifndef MK_MULTI
#define MK_MULTI 0
#endif

extern "C" void kernel_launch(void* const* d_in, const int* in_sizes, int n_in, void* d_out, int out_size, void* d_ws, size_t ws_size, hipStream_t stream) {
    static int grid = 0;
    if (grid == 0) {
        if (n_in != 12 || out_size != M * D_MODEL || ws_size < WS_END) { fprintf(stderr, "kernel_launch: unexpected shapes (n_in %d out %d ws %zu)\n", n_in, out_size, ws_size); grid = -1; return; }
        int dev = 0, cus = 0, per_cu = 0;
        hipGetDevice(&dev); hipDeviceGetAttribute(&cus, hipDeviceAttributeMultiprocessorCount, dev);
        hipFuncSetAttribute((const void*)mk_fwd, hipFuncAttributeMaxDynamicSharedMemorySize, LDS_BYTES);
        hipOccupancyMaxActiveBlocksPerMultiprocessor(&per_cu, (const void*)mk_fwd, 512, LDS_BYTES);
        (void)hipGetLastError();
        if (per_cu < 1) per_cu = 1;
        grid = cus * 1;
        if (grid != 256) fprintf(stderr, "kernel_launch: note: %d CUs\n", grid);
    }
    if (grid < 0) return;
    Args a{};
    for (int i = 0; i < 12; ++i) a.in[i] = (const float*)d_in[i];
    a.out = (float*)d_out; a.ws = (unsigned char*)d_ws;
#if MK_MULTI
    for (int p = 0; p < N_PHASES; ++p) {
        a.ph_lo = p; a.ph_hi = p + 1;
        hipLaunchKernelGGL(mk_fwd, dim3(grid), dim3(512), LDS_BYTES, stream, a);
    }
#else
    a.ph_lo = 0; a.ph_hi = N_PHASES;
    if (hipMemsetAsync((char*)d_ws + WS_CTL, 0, 8192 * 4, stream) != hipSuccess) { fprintf(stderr, "kernel_launch: hipMemsetAsync failed\n"); return; }
    void* args[] = {&a};
    hipError_t e = hipLaunchCooperativeKernel((const void*)mk_fwd, dim3(grid), dim3(512), args, LDS_BYTES, stream);
    if (e != hipSuccess) fprintf(stderr, "cooperative launch failed: %s (grid %d)\n", hipGetErrorString(e), grid);
#endif
}
```

```cpp
#include <hip/hip_runtime.h>
#include <hip/hip_cooperative_groups.h>
#include <cstdio>
#include <cstdint>
namespace cg = cooperative_groups;
namespace pg8 {
#define PG8_LAS __attribute__((address_space(3)))
#define PG8_GAS __attribute__((address_space(1)))
typedef unsigned short bf16_t;
typedef short bf16x8 __attribute__((ext_vector_type(8)));
typedef float f32x4 __attribute__((ext_vector_type(4)));
typedef unsigned u32x4 __attribute__((ext_vector_type(4)));
constexpr int BM = 256, BK = 64, HALF = 128, HTB = HALF * BK * 2  , STAGE_BYTES = 8 * HTB, NXCD = 8, WGM = 8;

__host__ __device__ __forceinline__ int lds_byte(int r, int c) { const int st = (r >> 4) * 2 + (c >> 5), rr = r & 15, cc = c & 31, ob = rr * 64 + cc * 2; return st * 1024 + (ob ^ (((ob >> 9) & 1) << 5)); }
__host__ __device__ __forceinline__ void stage_rc(int b, int& R, int& C) { const int st = b / 1024, sb = b % 1024, swz = sb ^ (((sb >> 9) & 1) << 5); R = (st >> 1) * 16 + swz / 64; C = (st & 1) * 32 + (swz % 64) / 2; }
__host__ __device__ __forceinline__ int perm32(int rho) { const int n = rho >> 4, i = rho & 15; return 8 * (i >> 2) + 4 * n + (i & 3); }

struct Unit { int pm, pn; };
struct Gemm { const bf16_t* A; const bf16_t* Bt; int M, N, K; };

struct StaticOrder {
    int nM, nN, nwg, G, c;
    __host__ __device__ void init(int M, int N, int G_, int c_) { nM = M / BM; nN = N / BM; nwg = nM * nN; G = G_; c = c_; }
    __host__ __device__ bool next(int i, Unit& u) const {
        const long L = (long)i * G + c; if (L >= nwg) return false;
        int wgid = (int)L; { const int q = nwg / NXCD, r = nwg % NXCD, xcd = wgid % NXCD, off = wgid / NXCD; wgid = (xcd < r ? xcd * (q + 1) : r * (q + 1) + (xcd - r) * q) + off; }
        const int nig = WGM * nN, gid = wgid / nig, fm = gid * WGM, gsz = (nM - fm) < WGM ? (nM - fm) : WGM;
        u.pm = fm + ((wgid % nig) % gsz); u.pn = (wgid % nig) / gsz; return true;
    }
    __device__ __forceinline__ void a_ready(const Unit&) const {}
    __device__ __forceinline__ void done(const Unit&) const {}
};

__device__ __forceinline__ unsigned cvt_pk_bf16(float lo, float hi) { unsigned r; asm volatile("v_cvt_pk_bf16_f32 %0, %1, %2" : "=v"(r) : "v"(lo), "v"(hi)); return r; }
typedef float f32x2 __attribute__((ext_vector_type(2)));

typedef unsigned u32x4 __attribute__((ext_vector_type(4)));
__device__ __forceinline__ float bf_lo(unsigned w) { return __uint_as_float(w << 16); }
__device__ __forceinline__ float bf_hi(unsigned w) { return __uint_as_float(w & 0xffff0000u); }
__device__ __forceinline__ float fast_sigmoid(float x) { return __builtin_amdgcn_rcpf(1.0f + __builtin_amdgcn_exp2f(-1.4426950408889634f * x)); }

constexpr int SEQ_ = 8192;
struct EpiWin {
    static constexpr bool PERM = true, AFTER_DRAIN = false, MID = false;
    bf16_t *CONV, *Q, *Kt, *Vt, *G; const float* bgate; float qscale; unsigned* nrm;
    __device__ __forceinline__ void operator()(const f32x4 (&acc)[2][2][4][2], const Unit& u, int wr, int wc, int fr_, int fq_) const {
        int fr = fr_, fq = fq_; asm volatile("" : "+v"(fr), "+v"(fq));
        const int pn = u.pn; const int row0 = u.pm * BM + wr * 64 + fr; const int cl0 = wc * 32 + 8 * fq;
        bf16_t* base; int s_ai, s_m, s_bj; float sc = 1.f; bool gate = false;
        if (pn < 6) { base = CONV + (size_t)row0 * 1536 + pn * 256 + cl0; s_ai = HALF * 1536; s_m = 16 * 1536; s_bj = HALF; }
        else if (pn < 8) { base = Q + (size_t)row0 * 512 + (pn - 6) * 256 + cl0; s_ai = HALF * 512; s_m = 16 * 512; s_bj = HALF; sc = qscale; }
        else if (pn < 10) { const int h0 = (pn - 8) * 2, chunk = cl0 >> 3; const int b = row0 >> 13, s = row0 & (SEQ_ - 1), t = s >> 6, key = s & 63;
            base = Kt + ((size_t)((b * 4 + h0) * 128 + t)) * 8192 + chunk * 512 + key * 8; s_ai = 2 * 8192; s_m = 16 * 8; s_bj = 128 * 8192; }
        else if (pn < 12) { const int h0 = (pn - 10) * 2; const int b = row0 >> 13, s = row0 & (SEQ_ - 1), t = s >> 6, key = s & 63, kg = key >> 3;
            base = Vt + ((size_t)((b * 4 + h0) * 128 + t)) * 8192 + (kg * 4 + wc) * 256 + (key & 7) * 32 + 8 * fq; s_ai = 2 * 8192; s_m = 2 * 4 * 256; s_bj = 128 * 8192; }
        else { base = G + (size_t)row0 * 2048 + (pn - 12) * 256 + cl0; s_ai = HALF * 2048; s_m = 16 * 2048; s_bj = HALF; gate = true; }
        const bool trk = (pn >= 6 && pn < 10); float mx0 = 0.f, mx1 = 0.f;
        f32x4 bv[2][2];
#pragma unroll
        for (int bj = 0; bj < 2; ++bj)
#pragma unroll
            for (int n = 0; n < 2; ++n) bv[bj][n] = gate ? *(const f32x4*)(bgate + (pn - 12) * 256 + cl0 + bj * HALF + 4 * n) : (f32x4){0.f, 0.f, 0.f, 0.f};
#pragma unroll
        for (int ai = 0; ai < 2; ++ai)
#pragma unroll
            for (int m = 0; m < 4; ++m) {
#pragma unroll
                for (int bj = 0; bj < 2; ++bj) {
                    f32x4 v0 = acc[ai][bj][m][0] * sc, v1 = acc[ai][bj][m][1] * sc;
                    if (gate) { v0 = v0 + bv[bj][0]; v1 = v1 + bv[bj][1];
#pragma unroll
                        for (int e = 0; e < 4; ++e) { v0[e] = fast_sigmoid(v0[e]); v1[e] = fast_sigmoid(v1[e]); } }
                    if (trk) { float s = (v0[0] * v0[0] + v0[1] * v0[1]) + (v0[2] * v0[2] + v0[3] * v0[3]) + (v1[0] * v1[0] + v1[1] * v1[1]) + (v1[2] * v1[2] + v1[3] * v1[3]);
                        s += __shfl_xor(s, 16); s += __shfl_xor(s, 32); if (bj == 0) mx0 = fmaxf(mx0, s); else mx1 = fmaxf(mx1, s); }
                    u32x4 w; w.x = cvt_pk_bf16(v0[0], v0[1]); w.y = cvt_pk_bf16(v0[2], v0[3]); w.z = cvt_pk_bf16(v1[0], v1[1]); w.w = cvt_pk_bf16(v1[2], v1[3]);
                    *(PG8_GAS u32x4*)(base + (size_t)ai * s_ai + (size_t)m * s_m + (size_t)bj * s_bj) = w;
                }
                asm volatile("" ::: "memory");
            }
        if (trk) {
#pragma unroll
            for (int sft = 1; sft < 16; sft <<= 1) { mx0 = fmaxf(mx0, __shfl_xor(mx0, sft)); mx1 = fmaxf(mx1, __shfl_xor(mx1, sft)); }
            if (fr == 0 && fq == 0) { const int isk = pn >= 8 ? 1 : 0, h0 = ((pn - 6) & 1) * 2, bb = row0 >> 13;
                unsigned* wp = nrm + isk * 32 + (bb * 4 + h0) * 4 + wc;
                atomicMax(wp, __float_as_uint(mx0)); atomicMax(wp + 4, __float_as_uint(mx1)); }
        }
    }
};
struct EpiGate1 {
    static constexpr bool PERM = true, AFTER_DRAIN = false, MID = false;
    float* T; const bf16_t* G;
    __device__ __forceinline__ void operator()(const f32x4 (&acc)[2][2][4][2], const Unit& u, int wr, int wc, int fr_, int fq_) const {
        int fr = fr_, fq = fq_; asm volatile("" : "+v"(fr), "+v"(fq));
        const int row0 = u.pm * BM + wr * 64 + fr;
#pragma unroll
        for (int ai = 0; ai < 2; ++ai)
#pragma unroll
            for (int m = 0; m < 4; ++m) {
                const int row = row0 + ai * HALF + m * 16;
#pragma unroll
                for (int bj = 0; bj < 2; ++bj) {
                    const int col = u.pn * BM + bj * HALF + wc * 32 + 8 * fq;
                    const u32x4 g = *(const u32x4*)(G + (size_t)row * 2048 + col);
                    f32x4 v0 = acc[ai][bj][m][0], v1 = acc[ai][bj][m][1];
                    v0[0] *= bf_lo(g.x); v0[1] *= bf_hi(g.x); v0[2] *= bf_lo(g.y); v0[3] *= bf_hi(g.y);
                    v1[0] *= bf_lo(g.z); v1[1] *= bf_hi(g.z); v1[2] *= bf_lo(g.w); v1[3] *= bf_hi(g.w);
                    float* d = T + (size_t)row * 1024 + col; *(f32x4*)d = v0; *(f32x4*)(d + 4) = v1;
                }
                asm volatile("" ::: "memory");
            }
    }
};
struct EpiGate2 {
    static constexpr bool PERM = true, AFTER_DRAIN = false, MID = false;
    const float* T; const bf16_t* G; bf16_t* O;
    __device__ __forceinline__ void operator()(const f32x4 (&acc)[2][2][4][2], const Unit& u, int wr, int wc, int fr_, int fq_) const {
        int fr = fr_, fq = fq_; asm volatile("" : "+v"(fr), "+v"(fq));
        const int row0 = u.pm * BM + wr * 64 + fr;
#pragma unroll
        for (int ai = 0; ai < 2; ++ai)
#pragma unroll
            for (int m = 0; m < 4; ++m) {
                const int row = row0 + ai * HALF + m * 16;
#pragma unroll
                for (int bj = 0; bj < 2; ++bj) {
                    const int col = u.pn * BM + bj * HALF + wc * 32 + 8 * fq;
                    const u32x4 g = *(const u32x4*)(G + (size_t)row * 2048 + 1024 + col);
                    const float* d = T + (size_t)row * 1024 + col; const f32x4 t0 = *(const f32x4*)d, t1 = *(const f32x4*)(d + 4);
                    f32x4 v0 = acc[ai][bj][m][0], v1 = acc[ai][bj][m][1];
                    v0[0] = t0[0] + v0[0] * bf_lo(g.x); v0[1] = t0[1] + v0[1] * bf_hi(g.x); v0[2] = t0[2] + v0[2] * bf_lo(g.y); v0[3] = t0[3] + v0[3] * bf_hi(g.y);
                    v1[0] = t1[0] + v1[0] * bf_lo(g.z); v1[1] = t1[1] + v1[1] * bf_hi(g.z); v1[2] = t1[2] + v1[2] * bf_lo(g.w); v1[3] = t1[3] + v1[3] * bf_hi(g.w);
                    u32x4 w; w.x = cvt_pk_bf16(v0[0], v0[1]); w.y = cvt_pk_bf16(v0[2], v0[3]); w.z = cvt_pk_bf16(v1[0], v1[1]); w.w = cvt_pk_bf16(v1[2], v1[3]);
                    *(u32x4*)(O + (size_t)row * 1024 + col) = w;
                }
                asm volatile("" ::: "memory");
            }
    }
};
struct EpiMerge {
    static constexpr bool PERM = true, AFTER_DRAIN = false, MID = true;
    const bf16_t* G; bf16_t* O;
    __device__ __forceinline__ void mid(f32x4 (&acc)[2][2][4][2], const Unit& u, int wr, int wc, int fr_, int fq_) const {
        int fr = fr_, fq = fq_; asm volatile("" : "+v"(fr), "+v"(fq));
        const int row0 = u.pm * BM + wr * 64 + fr;
#pragma unroll
        for (int ai = 0; ai < 2; ++ai)
#pragma unroll
            for (int m = 0; m < 4; ++m) {
                const int row = row0 + ai * HALF + m * 16;
#pragma unroll
                for (int bj = 0; bj < 2; ++bj) {
                    const int col = u.pn * BM + bj * HALF + wc * 32 + 8 * fq;
                    const u32x4 a = *(const PG8_GAS u32x4*)(G + (size_t)row * 2048 + col), b = *(const PG8_GAS u32x4*)(G + (size_t)row * 2048 + 1024 + col);
#define PG8_RATIO(x, y) ((x) * __builtin_amdgcn_rcpf(fmaxf((y), 1e-30f)))
                    acc[ai][bj][m][0][0] *= PG8_RATIO(bf_lo(a.x), bf_lo(b.x)); acc[ai][bj][m][0][1] *= PG8_RATIO(bf_hi(a.x), bf_hi(b.x));
                    acc[ai][bj][m][0][2] *= PG8_RATIO(bf_lo(a.y), bf_lo(b.y)); acc[ai][bj][m][0][3] *= PG8_RATIO(bf_hi(a.y), bf_hi(b.y));
                    acc[ai][bj][m][1][0] *= PG8_RATIO(bf_lo(a.z), bf_lo(b.z)); acc[ai][bj][m][1][1] *= PG8_RATIO(bf_hi(a.z), bf_hi(b.z));
                    acc[ai][bj][m][1][2] *= PG8_RATIO(bf_lo(a.w), bf_lo(b.w)); acc[ai][bj][m][1][3] *= PG8_RATIO(bf_hi(a.w), bf_hi(b.w));
#undef PG8_RATIO
                }
                asm volatile("" ::: "memory");
            }
    }
    __device__ __forceinline__ void operator()(const f32x4 (&acc)[2][2][4][2], const Unit& u, int wr, int wc, int fr_, int fq_) const {
        int fr = fr_, fq = fq_; asm volatile("" : "+v"(fr), "+v"(fq));
        const int row0 = u.pm * BM + wr * 64 + fr;
#pragma unroll
        for (int ai = 0; ai < 2; ++ai)
#pragma unroll
            for (int m = 0; m < 4; ++m) {
                const int row = row0 + ai * HALF + m * 16;
#pragma unroll
                for (int bj = 0; bj < 2; ++bj) {
                    const int col = u.pn * BM + bj * HALF + wc * 32 + 8 * fq;
                    const u32x4 g = *(const PG8_GAS u32x4*)(G + (size_t)row * 2048 + 1024 + col);
                    f32x4 v0 = acc[ai][bj][m][0], v1 = acc[ai][bj][m][1];
                    v0[0] *= fmaxf(bf_lo(g.x), 1e-30f); v0[1] *= fmaxf(bf_hi(g.x), 1e-30f); v0[2] *= fmaxf(bf_lo(g.y), 1e-30f); v0[3] *= fmaxf(bf_hi(g.y), 1e-30f);
                    v1[0] *= fmaxf(bf_lo(g.z), 1e-30f); v1[1] *= fmaxf(bf_hi(g.z), 1e-30f); v1[2] *= fmaxf(bf_lo(g.w), 1e-30f); v1[3] *= fmaxf(bf_hi(g.w), 1e-30f);
                    u32x4 w; w.x = cvt_pk_bf16(v0[0], v0[1]); w.y = cvt_pk_bf16(v0[2], v0[3]); w.z = cvt_pk_bf16(v1[0], v1[1]); w.w = cvt_pk_bf16(v1[2], v1[3]);
                    *(PG8_GAS u32x4*)(O + (size_t)row * 1024 + col) = w;
                }
                asm volatile("" ::: "memory");
            }
    }
};
struct EpiF32 {
    static constexpr bool PERM = false, AFTER_DRAIN = false, MID = false;
    float* O; int ldc;
    __device__ __forceinline__ void operator()(const f32x4 (&acc)[2][2][4][2], const Unit& u, int wr, int wc, int fr_, int fq_) const {
        int fr = fr_, fq = fq_; asm volatile("" : "+v"(fr), "+v"(fq));
        const int row0 = u.pm * BM + wr * 64 + fr, col0 = u.pn * BM + wc * 32 + 4 * fq;
#pragma unroll
        for (int ai = 0; ai < 2; ++ai)
#pragma unroll
            for (int m = 0; m < 4; ++m) {
                float* rowp = O + (size_t)(row0 + ai * HALF + m * 16) * ldc + col0;
#pragma unroll
                for (int bj = 0; bj < 2; ++bj)
#pragma unroll
                    for (int n = 0; n < 2; ++n) *(f32x4*)(rowp + bj * HALF + n * 16) = acc[ai][bj][m][n];
            }
    }
};
struct EpiRelu2 {
    static constexpr bool PERM = true, AFTER_DRAIN = false, MID = false;
    bf16_t* O; int ldc;
    __device__ __forceinline__ void operator()(const f32x4 (&acc)[2][2][4][2], const Unit& u, int wr, int wc, int fr_, int fq_) const {
        int fr = fr_, fq = fq_; asm volatile("" : "+v"(fr), "+v"(fq));
        const int row0 = u.pm * BM + wr * 64 + fr, col0 = u.pn * BM + wc * 32 + 8 * fq;
#pragma unroll
        for (int ai = 0; ai < 2; ++ai)
#pragma unroll
            for (int m = 0; m < 4; ++m) {
                bf16_t* rowp = O + (size_t)(row0 + ai * HALF + m * 16) * ldc + col0;
#pragma unroll
                for (int bj = 0; bj < 2; ++bj) {
                    f32x4 v0 = acc[ai][bj][m][0], v1 = acc[ai][bj][m][1];
#pragma unroll
                    for (int e = 0; e < 4; ++e) { const float a = fmaxf(v0[e], 0.f), b = fmaxf(v1[e], 0.f); v0[e] = a * a; v1[e] = b * b; }
                    u32x4 w; w.x = cvt_pk_bf16(v0[0], v0[1]); w.y = cvt_pk_bf16(v0[2], v0[3]); w.z = cvt_pk_bf16(v1[0], v1[1]); w.w = cvt_pk_bf16(v1[2], v1[3]);
                    *(PG8_GAS u32x4*)(rowp + bj * HALF) = w;
                }
            }
    }
};


struct EpiBf16P {
    static constexpr bool PERM = true, AFTER_DRAIN = false, MID = false;
    bf16_t* O; int ldc;
    __device__ __forceinline__ void operator()(const f32x4 (&acc)[2][2][4][2], const Unit& u, int wr, int wc, int fr_, int fq_) const {
        int fr = fr_, fq = fq_; asm volatile("" : "+v"(fr), "+v"(fq));
        const int row0 = u.pm * BM + wr * 64 + fr, col0 = u.pn * BM + wc * 32 + 8 * fq;
#pragma unroll
        for (int ai = 0; ai < 2; ++ai)
#pragma unroll
            for (int m = 0; m < 4; ++m) {
                bf16_t* rowp = O + (size_t)(row0 + ai * HALF + m * 16) * ldc + col0;
#pragma unroll
                for (int bj = 0; bj < 2; ++bj) {
                    const f32x4 v0 = acc[ai][bj][m][0], v1 = acc[ai][bj][m][1];
                    u32x4 w; w.x = cvt_pk_bf16(v0[0], v0[1]); w.y = cvt_pk_bf16(v0[2], v0[3]); w.z = cvt_pk_bf16(v1[0], v1[1]); w.w = cvt_pk_bf16(v1[2], v1[3]);
                    *(PG8_GAS u32x4*)(rowp + bj * HALF) = w;
                }
            }
    }
};
template <class Epi, class Sched, bool ALIGN_EPI = false, bool SP2 = false>
__device__ __forceinline__ void gemm_phase(PG8_LAS unsigned char* lds, const Gemm g, const Sched& S, const Epi& E) {
    int tid_ = threadIdx.x; asm volatile("" : "+v"(tid_));
    const int tid = tid_, wid = __builtin_amdgcn_readfirstlane(tid >> 6), lane = tid & 63, wr = wid >> 2, wc = wid & 3, fr = lane & 15, fq = lane >> 4;
    const int K = g.K, nt = K / BK;
    unsigned voffA[2], voffB[2];
#pragma unroll
    for (int i = 0; i < 2; ++i) { int R, C; stage_rc(tid * 16 + i * 8192, R, C); const int Rb = Epi::PERM ? ((R & ~31) + perm32(R & 31)) : R;
        voffA[i] = (unsigned)(R * K + C) * 2u; voffB[i] = (unsigned)(Rb * K + C) * 2u; }
    const size_t kstep = (size_t)(BK * 2);
    const size_t hstep = (size_t)HALF * K * 2;
    const size_t tstep = 2 * hstep;
    const unsigned ldsw = (unsigned)wid * 1024u;
    const int aoff = lds_byte(wr * 64 + fr, fq * 8), boff = lds_byte(wc * 32 + fr, fq * 8);
#define PG8_SA(b, h) (((b) * 2 + (h)) * HTB)
#define PG8_SB(b, h) ((4 + (b) * 2 + (h)) * HTB)
#define PG8_STAGE(bufoff, gbase, voff) do { _Pragma("unroll") for (int _i = 0; _i < 2; ++_i) \
        __builtin_amdgcn_global_load_lds((const unsigned*)((const char*)(gbase) + (voff)[_i]), (PG8_LAS unsigned*)(lds + (bufoff) + ldsw + _i * 8192), 16, 0, 0); } while (0)
#define PG8_LDA(dst, b, h) do { _Pragma("unroll") for (int m = 0; m < 4; ++m) _Pragma("unroll") for (int k = 0; k < 2; ++k) dst[m][k] = *(const PG8_LAS bf16x8*)(lds + PG8_SA(b, h) + aoff + m * 2048 + k * 1024); } while (0)
#define PG8_LDB(dst, b, h) do { _Pragma("unroll") for (int n = 0; n < 2; ++n) _Pragma("unroll") for (int k = 0; k < 2; ++k) dst[n][k] = *(const PG8_LAS bf16x8*)(lds + PG8_SB(b, h) + boff + n * 2048 + k * 1024); } while (0)
#define PG8_MMA(ai, bj, At, Bt) do { __builtin_amdgcn_s_setprio(1); _Pragma("unroll") for (int m = 0; m < 4; ++m) _Pragma("unroll") for (int n = 0; n < 2; ++n) _Pragma("unroll") for (int k = 0; k < 2; ++k) \
        acc[ai][bj][m][n] = __builtin_amdgcn_mfma_f32_16x16x32_bf16(Bt[n][k], At[m][k], acc[ai][bj][m][n], 0, 0, 0); __builtin_amdgcn_s_setprio(0); } while (0)
#define PG8_WAIT_V(n) asm volatile("s_waitcnt vmcnt(" #n ")" ::: "memory")
#define PG8_WAIT_L(n) asm volatile("s_waitcnt lgkmcnt(" #n ")" ::: "memory")
#define PG8_BAR __builtin_amdgcn_s_barrier()
#define PG8_SCHED __builtin_amdgcn_sched_barrier(0)
    Unit cur, nxt; int ui = 0;
    if (!S.next(0, cur)) return;
    f32x4 acc[2][2][4][2];
#pragma unroll
    for (int a = 0; a < 2; ++a)
#pragma unroll
        for (int b = 0; b < 2; ++b)
#pragma unroll
            for (int m = 0; m < 4; ++m)
#pragma unroll
                for (int n = 0; n < 2; ++n) acc[a][b][m][n] = (f32x4){0.f, 0.f, 0.f, 0.f};
    bf16x8 At[4][2], B0[2][2], B1[2][2];
    const char* cA = (const char*)g.A + (size_t)cur.pm * tstep; const char* cB = (const char*)g.Bt + (size_t)cur.pn * tstep;
    S.a_ready(cur);
    if constexpr (SP2) {
        PG8_STAGE(PG8_SB(0, 0), cB, voffB); PG8_STAGE(PG8_SB(0, 1), cB + hstep, voffB); PG8_STAGE(PG8_SA(0, 0), cA, voffA); PG8_STAGE(PG8_SA(0, 1), cA + hstep, voffA);
        if (wr == 1) PG8_BAR;
        PG8_WAIT_V(2); PG8_BAR;
        PG8_STAGE(PG8_SB(1, 0), cB + kstep, voffB); PG8_STAGE(PG8_SA(1, 0), cA + kstep, voffA); PG8_STAGE(PG8_SB(1, 1), cB + hstep + kstep, voffB);
        PG8_WAIT_V(6); PG8_BAR;
    } else {
        PG8_STAGE(PG8_SB(0, 0), cB, voffB); PG8_STAGE(PG8_SA(0, 0), cA, voffA); PG8_STAGE(PG8_SB(0, 1), cB + hstep, voffB); PG8_STAGE(PG8_SA(0, 1), cA + hstep, voffA);
        if (wr == 1) PG8_BAR;
        PG8_WAIT_V(4); PG8_BAR;
        PG8_STAGE(PG8_SB(1, 0), cB + kstep, voffB); PG8_STAGE(PG8_SA(1, 0), cA + kstep, voffA); PG8_STAGE(PG8_SB(1, 1), cB + hstep + kstep, voffB);
        PG8_WAIT_V(6); PG8_BAR;
    }
    for (;;) {
        const bool has_next = S.next(ui + 1, nxt);
        const char* nA = has_next ? (const char*)g.A + (size_t)nxt.pm * tstep : cA; const char* nB = has_next ? (const char*)g.Bt + (size_t)nxt.pn * tstep : cB;
        for (int t = 0; t < nt; t += 2) {
            if constexpr (Epi::MID) { if (t == (nt >> 1)) E.mid(acc, cur, wr, wc, fr, fq); }
            const bool last = (t == nt - 2);
            const char* a1 = cA + (size_t)(t + 1) * kstep;
            const char* a2 = last ? nA : cA + (size_t)(t + 2) * kstep; const char* b2 = last ? nB : cB + (size_t)(t + 2) * kstep;
            const char* a3 = a2 + kstep; const char* b3 = b2 + kstep;
            if (last && has_next) S.a_ready(nxt);
            if constexpr (SP2) {
            PG8_LDB(B0, 0, 0); PG8_LDB(B1, 0, 1); PG8_SCHED; PG8_LDA(At, 0, 0); PG8_STAGE(PG8_SA(1, 1), a1 + hstep, voffA);
            PG8_WAIT_V(8); PG8_WAIT_L(0); PG8_BAR; PG8_MMA(0, 0, At, B0); PG8_MMA(0, 1, At, B1); PG8_BAR; PG8_SCHED;
            PG8_LDA(At, 0, 1); PG8_STAGE(PG8_SB(0, 0), b2, voffB); PG8_STAGE(PG8_SB(0, 1), b2 + hstep, voffB); PG8_STAGE(PG8_SA(0, 0), a2, voffA);
            PG8_WAIT_V(8); PG8_WAIT_L(0); PG8_BAR; PG8_MMA(1, 0, At, B0); PG8_MMA(1, 1, At, B1); PG8_BAR; PG8_SCHED;
            PG8_LDB(B0, 1, 0); PG8_LDB(B1, 1, 1); PG8_SCHED; PG8_LDA(At, 1, 0); PG8_STAGE(PG8_SA(0, 1), a2 + hstep, voffA);
            PG8_WAIT_V(8); PG8_WAIT_L(0); PG8_BAR; PG8_MMA(0, 0, At, B0); PG8_MMA(0, 1, At, B1); PG8_BAR; PG8_SCHED;
            PG8_LDA(At, 1, 1); PG8_STAGE(PG8_SB(1, 0), b3, voffB); PG8_STAGE(PG8_SB(1, 1), b3 + hstep, voffB); PG8_STAGE(PG8_SA(1, 0), a3, voffA);
            PG8_WAIT_V(8); PG8_WAIT_L(0); PG8_BAR; PG8_MMA(1, 0, At, B0); PG8_MMA(1, 1, At, B1); PG8_BAR; PG8_SCHED;
            } else {
            PG8_LDB(B0, 0, 0); PG8_SCHED; PG8_LDA(At, 0, 0); PG8_STAGE(PG8_SA(1, 1), a1 + hstep, voffA);
            PG8_WAIT_L(8); PG8_BAR; PG8_WAIT_L(0); PG8_MMA(0, 0, At, B0); PG8_BAR; PG8_SCHED;
            PG8_LDB(B1, 0, 1); PG8_STAGE(PG8_SB(0, 0), b2, voffB);
            PG8_BAR; PG8_WAIT_L(0); PG8_MMA(0, 1, At, B1); PG8_BAR;
            PG8_LDA(At, 0, 1); PG8_STAGE(PG8_SA(0, 0), a2, voffA);
            PG8_BAR; PG8_WAIT_L(0); PG8_MMA(1, 0, At, B0); PG8_BAR; PG8_SCHED;
            PG8_STAGE(PG8_SB(0, 1), b2 + hstep, voffB);
            PG8_WAIT_V(6); PG8_BAR; PG8_MMA(1, 1, At, B1); PG8_BAR;
            PG8_LDB(B0, 1, 0); PG8_SCHED; PG8_LDA(At, 1, 0); PG8_STAGE(PG8_SA(0, 1), a2 + hstep, voffA);
            PG8_WAIT_L(8); PG8_BAR; PG8_WAIT_L(0); PG8_MMA(0, 0, At, B0); PG8_BAR; PG8_SCHED;
            PG8_LDB(B1, 1, 1); PG8_STAGE(PG8_SB(1, 0), b3, voffB);
            PG8_BAR; PG8_WAIT_L(0); PG8_MMA(0, 1, At, B1); PG8_BAR;
            PG8_LDA(At, 1, 1); PG8_STAGE(PG8_SA(1, 0), a3, voffA);
            PG8_BAR; PG8_WAIT_L(0); PG8_MMA(1, 0, At, B0); PG8_BAR; PG8_SCHED;
            PG8_STAGE(PG8_SB(1, 1), b3 + hstep, voffB);
            PG8_WAIT_V(6); PG8_BAR; PG8_MMA(1, 1, At, B1); PG8_BAR;
            }
        }
        if constexpr (ALIGN_EPI) { if (wr == 0) PG8_BAR; }
        if constexpr (!Epi::AFTER_DRAIN) { E(acc, cur, wr, wc, fr, fq); S.done(cur); }
        if (!has_next) break;
#pragma unroll
        for (int a = 0; a < 2; ++a)
#pragma unroll
            for (int b = 0; b < 2; ++b)
#pragma unroll
                for (int m = 0; m < 4; ++m)
#pragma unroll
                    for (int n = 0; n < 2; ++n) acc[a][b][m][n] = (f32x4){0.f, 0.f, 0.f, 0.f};
        cur = nxt; cA = nA; cB = nB; ++ui;
        if constexpr (ALIGN_EPI) { if (wr == 1) PG8_BAR; }
    }
    PG8_WAIT_V(0);
    if constexpr (!ALIGN_EPI) { if (wr == 0) PG8_BAR; }
    PG8_BAR;
    if constexpr (Epi::AFTER_DRAIN) { E.fused(acc, cur, wr, wc, fr, fq, lds, wid, lane); S.done(cur); }
#undef PG8_SA
#undef PG8_SB
#undef PG8_STAGE
#undef PG8_LDA
#undef PG8_LDB
#undef PG8_MMA
#undef PG8_WAIT_V
#undef PG8_WAIT_L
#undef PG8_BAR
#undef PG8_SCHED
}
}

constexpr int D_MODEL = 1024, BATCH = 2, SEQ = 8192, DEPTH = 4, M = BATCH * SEQ;
constexpr int CONV_W = 512, NHEAD = 4, HEAD_DIM = 64, V_DIM = 128, ATTN_W = 512, D_FF = 4096, IN_W = 5120;
constexpr float EPS = 1e-6f;
constexpr float LOG2E = 1.4426950408889634f;

#define LAS __attribute__((address_space(3)))
#define GAS __attribute__((address_space(1)))
typedef unsigned short bf16;
typedef short bf16x8 __attribute__((ext_vector_type(8)));
typedef short s16x4 __attribute__((ext_vector_type(4)));
typedef float f32x4 __attribute__((ext_vector_type(4)));
typedef float f32x16 __attribute__((ext_vector_type(16)));
typedef unsigned u32x4 __attribute__((ext_vector_type(4)));
typedef unsigned u32x2 __attribute__((ext_vector_type(2)));

constexpr size_t MiB = 1u << 20;
constexpr size_t WS_CTL = 0;
constexpr size_t WS_W = 1 * MiB;
constexpr size_t W_IN_OFF = 0, W_CO_OFF = W_IN_OFF + (size_t)IN_W * D_MODEL * 2, W_AO_OFF = W_CO_OFF + (size_t)D_MODEL * CONV_W * 2,
                 W_O_OFF = W_AO_OFF + (size_t)D_MODEL * ATTN_W * 2, W_F1_OFF = W_O_OFF + (size_t)D_MODEL * D_MODEL * 2,
                 W_F2_OFF = W_F1_OFF + (size_t)D_FF * D_MODEL * 2, W_END_OFF = W_F2_OFF + (size_t)D_MODEL * D_FF * 2;
static_assert(WS_W + W_END_OFF <= 32 * MiB, "weights region");
constexpr size_t WS_U = 32 * MiB;
constexpr size_t WS_CONV = 64 * MiB;
constexpr size_t WS_Q = 112 * MiB;
constexpr size_t WS_K = 128 * MiB;
constexpr size_t WS_V = 144 * MiB;
constexpr size_t WS_G = 160 * MiB;
constexpr size_t WS_Z = 224 * MiB;
constexpr size_t WS_ON = 240 * MiB;
constexpr size_t WS_T = 64 * MiB;
constexpr size_t WS_MO = 128 * MiB;
constexpr size_t WS_A = 64 * MiB;
constexpr size_t WS_F = 192 * MiB;
constexpr size_t WS_END = 256 * MiB;

constexpr int LDS_BYTES = 135168;

__device__ __forceinline__ float wave_sum(float v) {
#pragma unroll
    for (int o = 1; o < 64; o <<= 1) v += __shfl_xor(v, o);
    return v;
}
__device__ __forceinline__ unsigned f2bf(float f) { unsigned u = __builtin_bit_cast(unsigned, f); return (u + 0x7fffu + ((u >> 16) & 1u)) >> 16; }
__device__ __forceinline__ unsigned pk2(float lo, float hi) { return f2bf(lo) | (f2bf(hi) << 16); }
__device__ __forceinline__ float bflo(unsigned w) { return __uint_as_float(w << 16); }
__device__ __forceinline__ float bfhi(unsigned w) { return __uint_as_float(w & 0xffff0000u); }

__device__ __forceinline__ void transpose_item(const float* W, int K, int N, bf16* WT, LAS float* scr, int item, int lane, int ldk = 0) {
    if (ldk == 0) ldk = K;
    const int nblk = N / 64, kb = item / nblk, nb = item % nblk, k0 = 32 * kb, n0 = 64 * nb;
    const int n4 = (lane & 15) * 4, kr = lane >> 4;
    f32x4 v[8];
#pragma unroll
    for (int i = 0; i < 8; ++i) v[i] = *(const GAS f32x4*)(W + (size_t)(k0 + kr + 4 * i) * N + n0 + n4);
#pragma unroll
    for (int i = 0; i < 8; ++i) { LAS float* s = scr + (kr + 4 * i) * 66 + n4; typedef float f32x2v __attribute__((ext_vector_type(2)));
        *(LAS f32x2v*)s = (f32x2v){v[i].x, v[i].y}; *(LAS f32x2v*)(s + 2) = (f32x2v){v[i].z, v[i].w}; }
    asm volatile("s_waitcnt lgkmcnt(0)" ::: "memory");
    const int c = lane >> 4;
#pragma unroll
    for (int j = 0; j < 4; ++j) { const int n = (lane & 15) + 16 * j; const LAS float* s = scr + (8 * c) * 66 + n;
        u32x4 o; o.x = pk2(s[0 * 66], s[1 * 66]); o.y = pk2(s[2 * 66], s[3 * 66]); o.z = pk2(s[4 * 66], s[5 * 66]); o.w = pk2(s[6 * 66], s[7 * 66]);
        *(GAS u32x4*)(WT + (size_t)(n0 + n) * ldk + k0 + 8 * c) = o; }
    asm volatile("s_waitcnt lgkmcnt(0)" ::: "memory");
}

struct Args { const float* in[12]; float* out; unsigned char* ws; int ph_lo, ph_hi; };

__device__ __forceinline__ void convert_weights(const Args& a, int l, LAS unsigned char* lds, int gw, int NGW, int wave, int lane) {
    LAS float* scr = (LAS float*)(lds + wave * 16384);
    bf16* wb = (bf16*)(a.ws + WS_W);
    constexpr int I_IN = (D_MODEL / 32) * (IN_W / 64), I_CO = (CONV_W / 32) * (D_MODEL / 64), I_AO = (ATTN_W / 32) * (D_MODEL / 64),
                  I_O = (D_MODEL / 32) * (D_MODEL / 64), I_F1 = (D_MODEL / 32) * (D_FF / 64), I_F2 = (D_FF / 32) * (D_MODEL / 64);
    constexpr int NITEMS = I_IN + I_CO + I_AO + I_O + I_F1 + I_F2;
    const float* w_in = a.in[1] + (size_t)l * D_MODEL * IN_W;
    const float* w_co = a.in[4] + (size_t)l * CONV_W * D_MODEL;
    const float* w_ao = a.in[7] + (size_t)l * ATTN_W * D_MODEL;
    const float* w_o = a.in[8] + (size_t)l * D_MODEL * D_MODEL;
    const float* w_f1 = a.in[10] + (size_t)l * D_MODEL * D_FF;
    const float* w_f2 = a.in[11] + (size_t)l * D_FF * D_MODEL;
    for (int it = gw; it < NITEMS; it += NGW) {
        int r = it;
        if (r < I_IN) { transpose_item(w_in, D_MODEL, IN_W, (bf16*)((unsigned char*)wb + W_IN_OFF), scr, r, lane); continue; } r -= I_IN;
        if (r < I_CO) { transpose_item(w_co, CONV_W, D_MODEL, (bf16*)((unsigned char*)wb + W_CO_OFF), scr, r, lane, CONV_W + ATTN_W); continue; } r -= I_CO;
        if (r < I_AO) { transpose_item(w_ao, ATTN_W, D_MODEL, (bf16*)((unsigned char*)wb + W_CO_OFF) + CONV_W, scr, r, lane, CONV_W + ATTN_W); continue; } r -= I_AO;
        if (r < I_O) { transpose_item(w_o, D_MODEL, D_MODEL, (bf16*)((unsigned char*)wb + W_O_OFF), scr, r, lane); continue; } r -= I_O;
        if (r < I_F1) { transpose_item(w_f1, D_MODEL, D_FF, (bf16*)((unsigned char*)wb + W_F1_OFF), scr, r, lane); continue; } r -= I_F1;
        transpose_item(w_f2, D_FF, D_MODEL, (bf16*)((unsigned char*)wb + W_F2_OFF), scr, r, lane);
    }
}

template <bool ADD, bool NORM>
__device__ __forceinline__ void row_phase(const float* hin, const bf16* F, const float* gA, float* hout, const float* gB, bf16* U, int gw, int NGW, int lane) {
    f32x4 ga[4], gb[4];
#pragma unroll
    for (int j = 0; j < 4; ++j) { ga[j] = ADD ? ((const GAS f32x4*)gA)[lane + 64 * j] : (f32x4){0.f, 0.f, 0.f, 0.f}; gb[j] = NORM ? ((const GAS f32x4*)gB)[lane + 64 * j] : (f32x4){0.f, 0.f, 0.f, 0.f}; }
    for (int m = gw; m < M; m += NGW) {
        f32x4 v[4];
#pragma unroll
        for (int j = 0; j < 4; ++j) v[j] = ((const GAS f32x4*)(hin + (size_t)m * D_MODEL))[lane + 64 * j];
        if (ADD) {
            f32x4 f[4]; float ss = 0.f;
#pragma unroll
            for (int j = 0; j < 4; ++j) { const u32x2 w = ((const GAS u32x2*)(F + (size_t)m * D_MODEL))[lane + 64 * j]; f[j] = (f32x4){bflo(w.x), bfhi(w.x), bflo(w.y), bfhi(w.y)}; ss += (f[j].x * f[j].x + f[j].y * f[j].y) + (f[j].z * f[j].z + f[j].w * f[j].w); }
            const float r = 1.0f / sqrtf(wave_sum(ss) * (1.0f / D_MODEL) + EPS);
#pragma unroll
            for (int j = 0; j < 4; ++j) v[j] = v[j] + f[j] * r * ga[j];
        }
#pragma unroll
        for (int j = 0; j < 4; ++j) ((GAS f32x4*)(hout + (size_t)m * D_MODEL))[lane + 64 * j] = v[j];
        if (NORM) {
            float ss = 0.f;
#pragma unroll
            for (int j = 0; j < 4; ++j) ss += (v[j].x * v[j].x + v[j].y * v[j].y) + (v[j].z * v[j].z + v[j].w * v[j].w);
            const float r = 1.0f / sqrtf(wave_sum(ss) * (1.0f / D_MODEL) + EPS);
            GAS u32x2* o8 = (GAS u32x2*)(U + (size_t)m * D_MODEL) + lane;
#pragma unroll
            for (int j = 0; j < 4; ++j) { const f32x4 y = v[j] * r * gb[j]; u32x2 w; w.x = pk2(y.x, y.y); w.y = pk2(y.z, y.w); o8[64 * j] = w; }
        }
    }
}

__device__ __forceinline__ void conv_items(const bf16* CONV, const float* cw, bf16* Z, int it_begin, int it_end, int it_stride, int lane) {
    const int c = lane * 8;
    float w0[8], w1[8], w2[8];
#pragma unroll
    for (int e = 0; e < 8; ++e) { w0[e] = cw[c + e]; w1[e] = cw[CONV_W + c + e]; w2[e] = cw[2 * CONV_W + c + e]; }
    for (int it = it_begin; it < it_end; it += it_stride) {
        const int t0 = it * 8, s0 = t0 & (SEQ - 1);
        float prev[8], cur[8], nxt[8];
#define INNER(dst, t) do { const u32x4 hh = *(const GAS u32x4*)(CONV + (size_t)(t) * 1536 + c), cc = *(const GAS u32x4*)(CONV + (size_t)(t) * 1536 + 1024 + c); \
            dst[0] = bflo(hh.x) * bflo(cc.x); dst[1] = bfhi(hh.x) * bfhi(cc.x); dst[2] = bflo(hh.y) * bflo(cc.y); dst[3] = bfhi(hh.y) * bfhi(cc.y); \
            dst[4] = bflo(hh.z) * bflo(cc.z); dst[5] = bfhi(hh.z) * bfhi(cc.z); dst[6] = bflo(hh.w) * bflo(cc.w); dst[7] = bfhi(hh.w) * bfhi(cc.w); } while (0)
        if (s0 > 0) { INNER(prev, t0 - 1); } else {
#pragma unroll
            for (int e = 0; e < 8; ++e) prev[e] = 0.f; }
        INNER(cur, t0);
#pragma unroll
        for (int j = 0; j < 8; ++j) {
            const int t = t0 + j;
            if (s0 + j + 1 < SEQ) { INNER(nxt, t + 1); } else {
#pragma unroll
                for (int e = 0; e < 8; ++e) nxt[e] = 0.f; }
            const u32x4 bb = *(const GAS u32x4*)(CONV + (size_t)t * 1536 + 512 + c);
            float z[8];
#pragma unroll
            for (int e = 0; e < 8; ++e) z[e] = prev[e] * w0[e] + cur[e] * w1[e] + nxt[e] * w2[e];
            z[0] *= bflo(bb.x); z[1] *= bfhi(bb.x); z[2] *= bflo(bb.y); z[3] *= bfhi(bb.y); z[4] *= bflo(bb.z); z[5] *= bfhi(bb.z); z[6] *= bflo(bb.w); z[7] *= bfhi(bb.w);
            u32x4 o; o.x = pk2(z[0], z[1]); o.y = pk2(z[2], z[3]); o.z = pk2(z[4], z[5]); o.w = pk2(z[6], z[7]);
            *(GAS u32x4*)(Z + (size_t)t * (CONV_W + ATTN_W) + c) = o;
#pragma unroll
            for (int e = 0; e < 8; ++e) { prev[e] = cur[e]; cur[e] = nxt[e]; }
        }
#undef INNER
    }
}

__device__ __forceinline__ int crow(int r, int hi) { return (r & 3) + 8 * (r >> 2) + 4 * hi; }
typedef float f32x2_t __attribute__((ext_vector_type(2))); typedef __bf16 bf16x2_t __attribute__((ext_vector_type(2)));
__device__ __forceinline__ unsigned cvtpk(float lo, float hi) { f32x2_t v = {lo, hi}; bf16x2_t b = __builtin_convertvector(v, bf16x2_t); return __builtin_bit_cast(unsigned, b); }
typedef short v4i16_t __attribute__((ext_vector_type(4)));
__device__ __forceinline__ s16x4 vtr(const LAS unsigned char* p) { return __builtin_bit_cast(s16x4, __builtin_amdgcn_ds_read_tr16_b64_v4i16((LAS v4i16_t*)p)); }
constexpr float ATT_T = 24.0f, ATT_THR = 8.0f;
constexpr float ATT_NOCHK = 64.0f;
#ifndef DIAG
#define DIAG 0
#endif
#ifndef DIAG_LIGHT
#define DIAG_LIGHT 0
#endif
#ifndef DIAG_WAVE
#define DIAG_WAVE 0
#endif
#ifndef DIAG_SCALE
#define DIAG_SCALE 0.01f
#endif
#ifndef DIAG_SEL
#define DIAG_SEL 0
#endif
__device__ __forceinline__ void glds16(const void* gsrc, unsigned lds_dst) { unsigned keep;
    asm volatile("s_mov_b32 %0, m0\n\ts_mov_b32 m0, %2\n\ts_nop 0\n\tglobal_load_lds_dwordx4 %1, off\n\ts_mov_b32 m0, %0" : "=&s"(keep) : "v"(gsrc), "s"(lds_dst) : "memory"); }
#define MFMA32(a, b, c) __builtin_amdgcn_mfma_f32_32x32x16_bf16((a), (b), (c), 0, 0, 0)

__device__ __forceinline__ void attn_unit(int b, int h, int qb, float kn0, float kn1, const bf16* Q, const bf16* Kt, const bf16* Vt, bf16* ON, LAS unsigned char* lds,
                                          float slope2, const float* subg, float post) {
    int tid_ = threadIdx.x; asm volatile("" : "+v"(tid_));
    const int tid = tid_, lane = tid & 63, r = lane & 31, hi = lane >> 5;
    const int wid = __builtin_amdgcn_readfirstlane(tid >> 6), map = wid >> 2, qs = wid & 3;
    const int q0 = qb * 128 + qs * 32;
    const size_t tokbase = (size_t)b * SEQ;
    bf16x8 qf[4];
    { const bf16* qp = Q + (tokbase + q0 + r) * ATTN_W + h * 128 + map * 64 + hi * 8;
#pragma unroll
      for (int ks = 0; ks < 4; ++ks) qf[ks] = *(const GAS bf16x8*)(qp + ks * 16); }
    const unsigned char* ktg = (const unsigned char*)Kt + (size_t)((b * 4 + h) * 128) * 16384 + wid * 1024 + lane * 16;
    const unsigned char* vtg = (const unsigned char*)Vt + (size_t)((b * 4 + h) * 128) * 16384 + wid * 1024 + lane * 16;
    const unsigned lds0 = (unsigned)(uintptr_t)lds;
#define ISSUE(t, buf) do { const size_t go_ = (size_t)(t) * 16384; const unsigned lb_ = (unsigned)__builtin_amdgcn_readfirstlane(lds0 + (buf) * 32768 + wid * 1024); \
        glds16(ktg + go_, lb_); glds16(ktg + go_ + 8192, lb_ + 8192); glds16(vtg + go_, lb_ + 16384); glds16(vtg + go_ + 8192, lb_ + 16384 + 8192); } while (0)
    f32x16 o[4];
#pragma unroll
    for (int cb = 0; cb < 4; ++cb)
#pragma unroll
        for (int i = 0; i < 16; ++i) o[cb][i] = 0.f;
    float mrun = -1e30f, lsum = 0.f;
    LAS float* wsf = (LAS float*)(lds + 131072 + 256) + wid * 64;
    const LAS unsigned char* kfb = lds + (map * 8 + hi) * 1024 + r * 16;
    const LAS unsigned char* vfb = lds + 16384 + (4 * hi + ((lane & 15) >> 2)) * 64 + ((lane >> 4) & 1) * 32 + (lane & 3) * 8;
    const unsigned vfa = (unsigned)(uintptr_t)vfb;
    const int td0 = 2 * qb; int t_lo = 0, t_hi = 0;
#define TILE_OF(n) ((n) < 2 ? td0 + (n) : ((t_lo + (n) - 2) >= td0 ? t_lo + (n) : t_lo + (n) - 2))
    bf16x8 pk[4];
    const unsigned himask = hi ? 0u : 0xffffffffu;
    bf16x8 kc0, kc1;
    { const unsigned one = 0x3f80u, k0b = f2bf((float)r), k1b = f2bf((float)(32 + r));
      u32x4 w; w.x = (k0b | (k0b << 16)) & himask; w.y = (k0b | (one << 16)) & himask; w.z = (one | (one << 16)) & himask; w.w = 0u; kc0 = __builtin_bit_cast(bf16x8, w);
      w.x = (k1b | (k1b << 16)) & himask; w.y = (k1b | (one << 16)) & himask; kc1 = __builtin_bit_cast(bf16x8, w); }
    unsigned sl12, sl3;
    { const unsigned s1 = f2bf(slope2); const float f1 = __uint_as_float(s1 << 16); const unsigned s2 = f2bf(slope2 - f1); const float f2 = __uint_as_float(s2 << 16); const unsigned s3 = f2bf(slope2 - f1 - f2);
      sl12 = s1 | (s2 << 16); sl3 = s3; }
    ISSUE(TILE_OF(0), 0);
    ISSUE(TILE_OF(1), 1);
    asm volatile("" : "+v"(qf[0]), "+v"(qf[1]), "+v"(qf[2]), "+v"(qf[3]));
    bool nocheck;
    { float qs2 = 0.f;
#pragma unroll
      for (int ks = 0; ks < 4; ++ks)
#pragma unroll
          for (int j = 0; j < 8; ++j) { const float v = __uint_as_float((unsigned)(unsigned short)qf[ks][j] << 16); qs2 += v * v; }
      qs2 += __shfl_xor(qs2, 32);
#pragma unroll
      for (int sft = 1; sft < 32; sft <<= 1) qs2 = fmaxf(qs2, __shfl_xor(qs2, sft));
      LAS float* wsq = (LAS float*)(lds + 131072 + 256 + 2048 + 64);
      if (lane == 0) wsq[wid] = qs2;
      __syncthreads();
      const float qm0 = fmaxf(fmaxf(wsq[0], wsq[1]), fmaxf(wsq[2], wsq[3])), qm1 = fmaxf(fmaxf(wsq[4], wsq[5]), fmaxf(wsq[6], wsq[7]));
      const float Bb = 2.04f * fmaxf(sqrtf(qm0 * kn0), sqrtf(qm1 * kn1));
      const float Wf = (Bb + ATT_T) / slope2;
      const int W = Wf < 16384.f ? (int)Wf + 1 : 16384;
      const int q0b = qb * 128;
      t_lo = (q0b - W) >> 6; if (t_lo < 0) t_lo = 0;
      t_hi = ((q0b + 127 + W) >> 6) + 1; if (t_hi > SEQ / 64) t_hi = SEQ / 64;
      t_lo = __builtin_amdgcn_readfirstlane(t_lo); t_hi = __builtin_amdgcn_readfirstlane(t_hi);
      nocheck = Bb <= ATT_NOCHK; }
    const int NT = t_hi - t_lo;
    asm volatile("s_waitcnt vmcnt(0)\n\ts_barrier" ::: "memory");
    unsigned tacc_ = 0, t0_ = 0;
    if (DIAG && DIAG_SEL == 0) t0_ = (unsigned)clock64();
#define STEP_END(ms_) do { if ((ms_) + 2 < NT) asm volatile("s_waitcnt vmcnt(4) lgkmcnt(0)\n\ts_barrier" ::: "memory");     \
                           else asm volatile("s_waitcnt vmcnt(0) lgkmcnt(0)\n\ts_barrier" ::: "memory"); } while (0)
    if (wid < 8) {
        const int n_plain = nocheck ? 2 : NT;
        for (int ms = 0; ms < n_plain; ++ms) {
            const int msx = ms < 2 ? (ms ^ (qs >> 1)) : ms;
            const int t = TILE_OF(msx), cur = msx & 3;
            if (DIAG && DIAG_SEL == 1) t0_ = (unsigned)clock64();
            {
        const LAS unsigned char* kc = kfb + cur * 32768;
#undef KA
#define KA(ks, kb) (*(const LAS bf16x8*)(kc + (ks) * 2048 + (kb) * 512))
        f32x16 p0, p1; float alpha = 1.0f;
        if (ms < 1) {
#pragma unroll
            for (int i = 0; i < 16; ++i) { p0[i] = 0.f; p1[i] = 0.f; }
#pragma unroll
            for (int kh = 0; kh < 2; ++kh) { const bf16x8 k00 = KA(2 * kh, 0), k01 = KA(2 * kh, 1), k10 = KA(2 * kh + 1, 0), k11 = KA(2 * kh + 1, 1);
                p0 = MFMA32(k00, qf[2 * kh], p0); p1 = MFMA32(k01, qf[2 * kh], p1); p0 = MFMA32(k10, qf[2 * kh + 1], p0); p1 = MFMA32(k11, qf[2 * kh + 1], p1); }
            const float dq = (float)(q0 + r - t * 64 - 4 * hi);
            float tmax = -1e30f;
#pragma unroll
            for (int i = 0; i < 16; ++i) {
                const float c0 = (float)((i & 3) + 8 * (i >> 2));
                p0[i] = __builtin_fmaf(-slope2, __builtin_fabsf(dq - c0), p0[i]);
                p1[i] = __builtin_fmaf(-slope2, __builtin_fabsf(dq - (c0 + 32.f)), p1[i]);
                tmax = fmaxf(tmax, fmaxf(p0[i], p1[i]));
            }
            tmax = fmaxf(tmax, __shfl_xor(tmax, 32));
            const float mnew = fmaxf(mrun, tmax); alpha = __builtin_amdgcn_exp2f(mrun - mnew); mrun = mnew;
#pragma unroll
            for (int i = 0; i < 16; ++i) { p0[i] -= mrun; p1[i] -= mrun; }
        } else {
            const bool right = t > (q0 >> 6);
            const float xq = (float)(q0 + r - 64 * t), ss2 = right ? -slope2 : slope2;
            const float A0 = -ss2 * xq - mrun;
            bf16x8 qx;
            { const unsigned u1 = cvtpk(A0, 0.f) & 0xffffu; const float r1 = A0 - __uint_as_float(u1 << 16);
              const unsigned u2 = cvtpk(r1, 0.f) & 0xffffu; const float r2 = r1 - __uint_as_float(u2 << 16);
              const unsigned u3 = cvtpk(r2, 0.f) & 0xffffu;
              const unsigned sgnm = right ? 0x80008000u : 0u;
              u32x4 w; w.x = (sl12 ^ sgnm) & himask; w.y = (((sl3 ^ sgnm) & 0xffffu) | (u1 << 16)) & himask; w.z = (u2 | (u3 << 16)) & himask; w.w = 0u;
              qx = __builtin_bit_cast(bf16x8, w); }
#pragma unroll
            for (int i = 0; i < 16; ++i) { p0[i] = 0.f; p1[i] = 0.f; }
            p0 = MFMA32(kc0, qx, p0); p1 = MFMA32(kc1, qx, p1);
#pragma unroll
            for (int kh = 0; kh < 2; ++kh) { const bf16x8 k00 = KA(2 * kh, 0), k01 = KA(2 * kh, 1), k10 = KA(2 * kh + 1, 0), k11 = KA(2 * kh + 1, 1);
                p0 = MFMA32(k00, qf[2 * kh], p0); p1 = MFMA32(k01, qf[2 * kh], p1); p0 = MFMA32(k10, qf[2 * kh + 1], p0); p1 = MFMA32(k11, qf[2 * kh + 1], p1); }
            if (!nocheck) {
            float ma = __builtin_fmaxf(__builtin_fmaxf(p0[0], p0[1]), p1[0]), mb = __builtin_fmaxf(__builtin_fmaxf(p0[2], p0[3]), p1[1]);
            ma = __builtin_fmaxf(__builtin_fmaxf(ma, p1[2]), p1[3]);
#pragma unroll
            for (int i = 4; i < 16; i += 4) { ma = __builtin_fmaxf(__builtin_fmaxf(ma, p0[i]), p0[i + 1]); mb = __builtin_fmaxf(__builtin_fmaxf(mb, p0[i + 2]), p0[i + 3]);
                ma = __builtin_fmaxf(__builtin_fmaxf(ma, p1[i]), p1[i + 1]); mb = __builtin_fmaxf(__builtin_fmaxf(mb, p1[i + 2]), p1[i + 3]); }
            float tm = __builtin_fmaxf(ma, mb);
            { auto rr = __builtin_amdgcn_permlane32_swap(__float_as_uint(tm), __float_as_uint(tm), false, false); tm = __builtin_fmaxf(__uint_as_float(rr[0]), __uint_as_float(rr[1])); }
            if (__builtin_expect(__any(tm > ATT_THR), 0)) {
                const float dl = __builtin_fmaxf(tm, 0.f); alpha = __builtin_amdgcn_exp2f(-dl); mrun += dl;
#pragma unroll
                for (int i = 0; i < 16; ++i) { p0[i] -= dl; p1[i] -= dl; }
            }
            }
        }
        if (ms > 0 && __any(alpha != 1.0f)) {
            lsum *= alpha;
            if (hi == 0) wsf[r] = alpha;
            asm volatile("s_waitcnt lgkmcnt(0)" ::: "memory");
#pragma unroll
            for (int i = 0; i < 16; ++i) { const float ai = wsf[crow(i, hi)];
#pragma unroll
                for (int cb = 0; cb < 4; ++cb) asm volatile("v_mul_f32 %0, %0, %1" : "+v"(o[cb][i]) : "v"(ai)); }
            asm volatile("s_waitcnt lgkmcnt(0)" ::: "memory");
        }
        f32x2_t ls2 = {0.f, 0.f};
#pragma unroll
        for (int j = 0; j < 8; ++j) { f32x2_t e0, e1; e0.x = __builtin_amdgcn_exp2f(p0[2 * j]); e0.y = __builtin_amdgcn_exp2f(p0[2 * j + 1]); e1.x = __builtin_amdgcn_exp2f(p1[2 * j]); e1.y = __builtin_amdgcn_exp2f(p1[2 * j + 1]);
            p0[2 * j] = e0.x; p0[2 * j + 1] = e0.y; p1[2 * j] = e1.x; p1[2 * j + 1] = e1.y; ls2 = ls2 + e0; ls2 = ls2 + e1; }
        lsum += ls2.x + ls2.y;
        { u32x4 w;
          w.x = cvtpk(p0[0], p0[1]); w.y = cvtpk(p0[2], p0[3]); w.z = cvtpk(p0[4], p0[5]); w.w = cvtpk(p0[6], p0[7]); pk[0] = __builtin_bit_cast(bf16x8, w);
          w.x = cvtpk(p0[8], p0[9]); w.y = cvtpk(p0[10], p0[11]); w.z = cvtpk(p0[12], p0[13]); w.w = cvtpk(p0[14], p0[15]); pk[1] = __builtin_bit_cast(bf16x8, w);
          w.x = cvtpk(p1[0], p1[1]); w.y = cvtpk(p1[2], p1[3]); w.z = cvtpk(p1[4], p1[5]); w.w = cvtpk(p1[6], p1[7]); pk[2] = __builtin_bit_cast(bf16x8, w);
          w.x = cvtpk(p1[8], p1[9]); w.y = cvtpk(p1[10], p1[11]); w.z = cvtpk(p1[12], p1[13]); w.w = cvtpk(p1[14], p1[15]); pk[3] = __builtin_bit_cast(bf16x8, w); }
            }
            if (DIAG && DIAG_SEL == 1) tacc_ += (unsigned)clock64() - t0_;
            if (DIAG && DIAG_SEL == 2) t0_ = (unsigned)clock64();
            if (ms + 2 < NT) ISSUE(TILE_OF(ms + 2), (ms + 2) & 3);
            {
        const unsigned va = vfa + cur * 32768;
#define TRR(dst, off) asm volatile("ds_read_b64_tr_b16 %0, %1 offset:%2" : "=&v"(dst) : "v"(va), "n"(off) : "memory")
#define READ8(L, H, S) do { TRR(L[0], ((2 * (S)) * 4 + 0) * 512); TRR(H[0], ((2 * (S) + 1) * 4 + 0) * 512); TRR(L[1], ((2 * (S)) * 4 + 1) * 512); TRR(H[1], ((2 * (S) + 1) * 4 + 1) * 512); \
                        TRR(L[2], ((2 * (S)) * 4 + 2) * 512); TRR(H[2], ((2 * (S) + 1) * 4 + 2) * 512); TRR(L[3], ((2 * (S)) * 4 + 3) * 512); TRR(H[3], ((2 * (S) + 1) * 4 + 3) * 512); } while (0)
#define WAITV(N, L, H) asm volatile("s_waitcnt lgkmcnt(" #N ")" : "+v"(L[0]), "+v"(H[0]), "+v"(L[1]), "+v"(H[1]), "+v"(L[2]), "+v"(H[2]), "+v"(L[3]), "+v"(H[3]) :: "memory")
#define PV4(S, L, H) do { _Pragma("unroll") for (int cb = 0; cb < 4; ++cb) { const bf16x8 vf = __builtin_shufflevector(L[cb], H[cb], 0, 1, 2, 3, 4, 5, 6, 7); o[cb] = MFMA32(pk[S], vf, o[cb]); } } while (0)
#if DIAG_LIGHT
        s16x4 la[4], ha[4];
        READ8(la, ha, 0); WAITV(0, la, ha); PV4(0, la, ha); READ8(la, ha, 1); WAITV(0, la, ha); PV4(1, la, ha);
        READ8(la, ha, 2); WAITV(0, la, ha); PV4(2, la, ha); READ8(la, ha, 3); WAITV(0, la, ha); PV4(3, la, ha);
#else
        s16x4 la[4], ha[4], lb[4], hb[4];
        READ8(la, ha, 0); READ8(lb, hb, 1);
        WAITV(8, la, ha); PV4(0, la, ha);
        READ8(la, ha, 2);
        WAITV(8, lb, hb); PV4(1, lb, hb);
        READ8(lb, hb, 3);
        WAITV(8, la, ha); PV4(2, la, ha);
        WAITV(0, lb, hb); PV4(3, lb, hb);
#endif
#undef TRR
#undef READ8
#undef WAITV
#undef PV4
            }
            if (DIAG && DIAG_SEL == 2) tacc_ += (unsigned)clock64() - t0_;
            if (DIAG && DIAG_SEL == 3) t0_ = (unsigned)clock64();
            STEP_END(ms);
            if (DIAG && DIAG_SEL == 3) tacc_ += (unsigned)clock64() - t0_;
        }
        if (n_plain < NT) {
            if (4 < NT) ISSUE(TILE_OF(4), 0);
            if (4 < NT) asm volatile("s_waitcnt vmcnt(4)\n\ts_barrier" ::: "memory"); else asm volatile("s_waitcnt vmcnt(0)\n\ts_barrier" ::: "memory");
            f32x16 pA0, pA1, pB0, pB1;
            {
              const int t_ = TILE_OF(2); const LAS unsigned char* kq_ = kfb + ((2) & 3) * 32768;
              const bool right_ = t_ >= td0; const float xq_ = (float)(q0 + r - 64 * t_), ss2_ = right_ ? -slope2 : slope2; const float A0_ = -ss2_ * xq_ - mrun;
              bf16x8 qx_;
              { const unsigned u1 = cvtpk(A0_, 0.f) & 0xffffu; const float r1 = A0_ - __uint_as_float(u1 << 16);
                const unsigned u2 = cvtpk(r1, 0.f) & 0xffffu; const float r2 = r1 - __uint_as_float(u2 << 16);
                const unsigned u3 = cvtpk(r2, 0.f) & 0xffffu; const unsigned sgnm = right_ ? 0x80008000u : 0u;
                u32x4 w; w.x = (sl12 ^ sgnm) & himask; w.y = (((sl3 ^ sgnm) & 0xffffu) | (u1 << 16)) & himask; w.z = (u2 | (u3 << 16)) & himask; w.w = 0u; qx_ = __builtin_bit_cast(bf16x8, w); }
#pragma unroll
              for (int i = 0; i < 16; ++i) { pA0[i] = 0.f; pA1[i] = 0.f; }
              pA0 = MFMA32(kc0, qx_, pA0); pA1 = MFMA32(kc1, qx_, pA1);
#pragma unroll
              for (int kh = 0; kh < 2; ++kh) { const bf16x8 k00 = *(const LAS bf16x8*)(kq_ + (2 * kh) * 2048), k01 = *(const LAS bf16x8*)(kq_ + (2 * kh) * 2048 + 512), k10 = *(const LAS bf16x8*)(kq_ + (2 * kh + 1) * 2048), k11 = *(const LAS bf16x8*)(kq_ + (2 * kh + 1) * 2048 + 512);
                  pA0 = MFMA32(k00, qf[2 * kh], pA0); pA1 = MFMA32(k01, qf[2 * kh], pA1); pA0 = MFMA32(k10, qf[2 * kh + 1], pA0); pA1 = MFMA32(k11, qf[2 * kh + 1], pA1); }
            }

            for (int msb = 2; msb < NT; msb += 2) {
          { const int ms_ = (msb);
            if (ms_ + 1 < NT) {
            {
              const int t_ = TILE_OF(ms_ + 1); const LAS unsigned char* kq_ = kfb + ((ms_ + 1) & 3) * 32768;
              const bool right_ = t_ >= td0; const float xq_ = (float)(q0 + r - 64 * t_), ss2_ = right_ ? -slope2 : slope2; const float A0_ = -ss2_ * xq_ - mrun;
              bf16x8 qx_;
              { const unsigned u1 = cvtpk(A0_, 0.f) & 0xffffu; const float r1 = A0_ - __uint_as_float(u1 << 16);
                const unsigned u2 = cvtpk(r1, 0.f) & 0xffffu; const float r2 = r1 - __uint_as_float(u2 << 16);
                const unsigned u3 = cvtpk(r2, 0.f) & 0xffffu; const unsigned sgnm = right_ ? 0x80008000u : 0u;
                u32x4 w; w.x = (sl12 ^ sgnm) & himask; w.y = (((sl3 ^ sgnm) & 0xffffu) | (u1 << 16)) & himask; w.z = (u2 | (u3 << 16)) & himask; w.w = 0u; qx_ = __builtin_bit_cast(bf16x8, w); }
#pragma unroll
              for (int i = 0; i < 16; ++i) { pB0[i] = 0.f; pB1[i] = 0.f; }
              pB0 = MFMA32(kc0, qx_, pB0); pB1 = MFMA32(kc1, qx_, pB1);
#pragma unroll
              for (int kh = 0; kh < 2; ++kh) { const bf16x8 k00 = *(const LAS bf16x8*)(kq_ + (2 * kh) * 2048), k01 = *(const LAS bf16x8*)(kq_ + (2 * kh) * 2048 + 512), k10 = *(const LAS bf16x8*)(kq_ + (2 * kh + 1) * 2048), k11 = *(const LAS bf16x8*)(kq_ + (2 * kh + 1) * 2048 + 512);
                  pB0 = MFMA32(k00, qf[2 * kh], pB0); pB1 = MFMA32(k01, qf[2 * kh], pB1); pB0 = MFMA32(k10, qf[2 * kh + 1], pB0); pB1 = MFMA32(k11, qf[2 * kh + 1], pB1); }
            }
            }
            {
        f32x2_t ls2 = {0.f, 0.f};
#pragma unroll
        for (int j = 0; j < 8; ++j) { f32x2_t e0, e1; e0.x = __builtin_amdgcn_exp2f(pA0[2 * j]); e0.y = __builtin_amdgcn_exp2f(pA0[2 * j + 1]); e1.x = __builtin_amdgcn_exp2f(pA1[2 * j]); e1.y = __builtin_amdgcn_exp2f(pA1[2 * j + 1]);
            pA0[2 * j] = e0.x; pA0[2 * j + 1] = e0.y; pA1[2 * j] = e1.x; pA1[2 * j + 1] = e1.y; ls2 = ls2 + e0; ls2 = ls2 + e1; }
        lsum += ls2.x + ls2.y;
        { u32x4 w;
          w.x = cvtpk(pA0[0], pA0[1]); w.y = cvtpk(pA0[2], pA0[3]); w.z = cvtpk(pA0[4], pA0[5]); w.w = cvtpk(pA0[6], pA0[7]); pk[0] = __builtin_bit_cast(bf16x8, w);
          w.x = cvtpk(pA0[8], pA0[9]); w.y = cvtpk(pA0[10], pA0[11]); w.z = cvtpk(pA0[12], pA0[13]); w.w = cvtpk(pA0[14], pA0[15]); pk[1] = __builtin_bit_cast(bf16x8, w);
          w.x = cvtpk(pA1[0], pA1[1]); w.y = cvtpk(pA1[2], pA1[3]); w.z = cvtpk(pA1[4], pA1[5]); w.w = cvtpk(pA1[6], pA1[7]); pk[2] = __builtin_bit_cast(bf16x8, w);
          w.x = cvtpk(pA1[8], pA1[9]); w.y = cvtpk(pA1[10], pA1[11]); w.z = cvtpk(pA1[12], pA1[13]); w.w = cvtpk(pA1[14], pA1[15]); pk[3] = __builtin_bit_cast(bf16x8, w); }
            }
            if (ms_ + 3 < NT) ISSUE(TILE_OF(ms_ + 3), (ms_ + 3) & 3);
            { const int cur = ms_ & 3;
        const unsigned va = vfa + cur * 32768;
#define TRR(dst, off) asm volatile("ds_read_b64_tr_b16 %0, %1 offset:%2" : "=&v"(dst) : "v"(va), "n"(off) : "memory")
#define READ8(L, H, S) do { TRR(L[0], ((2 * (S)) * 4 + 0) * 512); TRR(H[0], ((2 * (S) + 1) * 4 + 0) * 512); TRR(L[1], ((2 * (S)) * 4 + 1) * 512); TRR(H[1], ((2 * (S) + 1) * 4 + 1) * 512); \
                        TRR(L[2], ((2 * (S)) * 4 + 2) * 512); TRR(H[2], ((2 * (S) + 1) * 4 + 2) * 512); TRR(L[3], ((2 * (S)) * 4 + 3) * 512); TRR(H[3], ((2 * (S) + 1) * 4 + 3) * 512); } while (0)
#define WAITV(N, L, H) asm volatile("s_waitcnt lgkmcnt(" #N ")" : "+v"(L[0]), "+v"(H[0]), "+v"(L[1]), "+v"(H[1]), "+v"(L[2]), "+v"(H[2]), "+v"(L[3]), "+v"(H[3]) :: "memory")
#define PV4(S, L, H) do { _Pragma("unroll") for (int cb = 0; cb < 4; ++cb) { const bf16x8 vf = __builtin_shufflevector(L[cb], H[cb], 0, 1, 2, 3, 4, 5, 6, 7); o[cb] = MFMA32(pk[S], vf, o[cb]); } } while (0)
#if DIAG_LIGHT
        s16x4 la[4], ha[4];
        READ8(la, ha, 0); WAITV(0, la, ha); PV4(0, la, ha); READ8(la, ha, 1); WAITV(0, la, ha); PV4(1, la, ha);
        READ8(la, ha, 2); WAITV(0, la, ha); PV4(2, la, ha); READ8(la, ha, 3); WAITV(0, la, ha); PV4(3, la, ha);
#else
        s16x4 la[4], ha[4], lb[4], hb[4];
        READ8(la, ha, 0); READ8(lb, hb, 1);
        WAITV(8, la, ha); PV4(0, la, ha);
        READ8(la, ha, 2);
        WAITV(8, lb, hb); PV4(1, lb, hb);
        READ8(lb, hb, 3);
        WAITV(8, la, ha); PV4(2, la, ha);
        WAITV(0, lb, hb); PV4(3, lb, hb);
#endif
#undef TRR
#undef READ8
#undef WAITV
#undef PV4
            }
            if (ms_ + 3 < NT) asm volatile("s_waitcnt vmcnt(4) lgkmcnt(0)\n\ts_barrier" ::: "memory");
            else asm volatile("s_waitcnt vmcnt(0) lgkmcnt(0)\n\ts_barrier" ::: "memory");
          }

              if (msb + 1 < NT) {
          { const int ms_ = (msb + 1);
            if (ms_ + 1 < NT) {
            {
              const int t_ = TILE_OF(ms_ + 1); const LAS unsigned char* kq_ = kfb + ((ms_ + 1) & 3) * 32768;
              const bool right_ = t_ >= td0; const float xq_ = (float)(q0 + r - 64 * t_), ss2_ = right_ ? -slope2 : slope2; const float A0_ = -ss2_ * xq_ - mrun;
              bf16x8 qx_;
              { const unsigned u1 = cvtpk(A0_, 0.f) & 0xffffu; const float r1 = A0_ - __uint_as_float(u1 << 16);
                const unsigned u2 = cvtpk(r1, 0.f) & 0xffffu; const float r2 = r1 - __uint_as_float(u2 << 16);
                const unsigned u3 = cvtpk(r2, 0.f) & 0xffffu; const unsigned sgnm = right_ ? 0x80008000u : 0u;
                u32x4 w; w.x = (sl12 ^ sgnm) & himask; w.y = (((sl3 ^ sgnm) & 0xffffu) | (u1 << 16)) & himask; w.z = (u2 | (u3 << 16)) & himask; w.w = 0u; qx_ = __builtin_bit_cast(bf16x8, w); }
#pragma unroll
              for (int i = 0; i < 16; ++i) { pA0[i] = 0.f; pA1[i] = 0.f; }
              pA0 = MFMA32(kc0, qx_, pA0); pA1 = MFMA32(kc1, qx_, pA1);
#pragma unroll
              for (int kh = 0; kh < 2; ++kh) { const bf16x8 k00 = *(const LAS bf16x8*)(kq_ + (2 * kh) * 2048), k01 = *(const LAS bf16x8*)(kq_ + (2 * kh) * 2048 + 512), k10 = *(const LAS bf16x8*)(kq_ + (2 * kh + 1) * 2048), k11 = *(const LAS bf16x8*)(kq_ + (2 * kh + 1) * 2048 + 512);
                  pA0 = MFMA32(k00, qf[2 * kh], pA0); pA1 = MFMA32(k01, qf[2 * kh], pA1); pA0 = MFMA32(k10, qf[2 * kh + 1], pA0); pA1 = MFMA32(k11, qf[2 * kh + 1], pA1); }
            }
            }
            {
        f32x2_t ls2 = {0.f, 0.f};
#pragma unroll
        for (int j = 0; j < 8; ++j) { f32x2_t e0, e1; e0.x = __builtin_amdgcn_exp2f(pB0[2 * j]); e0.y = __builtin_amdgcn_exp2f(pB0[2 * j + 1]); e1.x = __builtin_amdgcn_exp2f(pB1[2 * j]); e1.y = __builtin_amdgcn_exp2f(pB1[2 * j + 1]);
            pB0[2 * j] = e0.x; pB0[2 * j + 1] = e0.y; pB1[2 * j] = e1.x; pB1[2 * j + 1] = e1.y; ls2 = ls2 + e0; ls2 = ls2 + e1; }
        lsum += ls2.x + ls2.y;
        { u32x4 w;
          w.x = cvtpk(pB0[0], pB0[1]); w.y = cvtpk(pB0[2], pB0[3]); w.z = cvtpk(pB0[4], pB0[5]); w.w = cvtpk(pB0[6], pB0[7]); pk[0] = __builtin_bit_cast(bf16x8, w);
          w.x = cvtpk(pB0[8], pB0[9]); w.y = cvtpk(pB0[10], pB0[11]); w.z = cvtpk(pB0[12], pB0[13]); w.w = cvtpk(pB0[14], pB0[15]); pk[1] = __builtin_bit_cast(bf16x8, w);
          w.x = cvtpk(pB1[0], pB1[1]); w.y = cvtpk(pB1[2], pB1[3]); w.z = cvtpk(pB1[4], pB1[5]); w.w = cvtpk(pB1[6], pB1[7]); pk[2] = __builtin_bit_cast(bf16x8, w);
          w.x = cvtpk(pB1[8], pB1[9]); w.y = cvtpk(pB1[10], pB1[11]); w.z = cvtpk(pB1[12], pB1[13]); w.w = cvtpk(pB1[14], pB1[15]); pk[3] = __builtin_bit_cast(bf16x8, w); }
            }
            if (ms_ + 3 < NT) ISSUE(TILE_OF(ms_ + 3), (ms_ + 3) & 3);
            { const int cur = ms_ & 3;
        const unsigned va = vfa + cur * 32768;
#define TRR(dst, off) asm volatile("ds_read_b64_tr_b16 %0, %1 offset:%2" : "=&v"(dst) : "v"(va), "n"(off) : "memory")
#define READ8(L, H, S) do { TRR(L[0], ((2 * (S)) * 4 + 0) * 512); TRR(H[0], ((2 * (S) + 1) * 4 + 0) * 512); TRR(L[1], ((2 * (S)) * 4 + 1) * 512); TRR(H[1], ((2 * (S) + 1) * 4 + 1) * 512); \
                        TRR(L[2], ((2 * (S)) * 4 + 2) * 512); TRR(H[2], ((2 * (S) + 1) * 4 + 2) * 512); TRR(L[3], ((2 * (S)) * 4 + 3) * 512); TRR(H[3], ((2 * (S) + 1) * 4 + 3) * 512); } while (0)
#define WAITV(N, L, H) asm volatile("s_waitcnt lgkmcnt(" #N ")" : "+v"(L[0]), "+v"(H[0]), "+v"(L[1]), "+v"(H[1]), "+v"(L[2]), "+v"(H[2]), "+v"(L[3]), "+v"(H[3]) :: "memory")
#define PV4(S, L, H) do { _Pragma("unroll") for (int cb = 0; cb < 4; ++cb) { const bf16x8 vf = __builtin_shufflevector(L[cb], H[cb], 0, 1, 2, 3, 4, 5, 6, 7); o[cb] = MFMA32(pk[S], vf, o[cb]); } } while (0)
#if DIAG_LIGHT
        s16x4 la[4], ha[4];
        READ8(la, ha, 0); WAITV(0, la, ha); PV4(0, la, ha); READ8(la, ha, 1); WAITV(0, la, ha); PV4(1, la, ha);
        READ8(la, ha, 2); WAITV(0, la, ha); PV4(2, la, ha); READ8(la, ha, 3); WAITV(0, la, ha); PV4(3, la, ha);
#else
        s16x4 la[4], ha[4], lb[4], hb[4];
        READ8(la, ha, 0); READ8(lb, hb, 1);
        WAITV(8, la, ha); PV4(0, la, ha);
        READ8(la, ha, 2);
        WAITV(8, lb, hb); PV4(1, lb, hb);
        READ8(lb, hb, 3);
        WAITV(8, la, ha); PV4(2, la, ha);
        WAITV(0, lb, hb); PV4(3, lb, hb);
#endif
#undef TRR
#undef READ8
#undef WAITV
#undef PV4
            }
            if (ms_ + 3 < NT) asm volatile("s_waitcnt vmcnt(4) lgkmcnt(0)\n\ts_barrier" ::: "memory");
            else asm volatile("s_waitcnt vmcnt(0) lgkmcnt(0)\n\ts_barrier" ::: "memory");
          }

              }
            }
        }
        asm volatile("s_waitcnt lgkmcnt(0)\n\ts_barrier" ::: "memory");
    } else {
        __builtin_amdgcn_s_setprio(1);
        for (int ms = 0; ms <= NT; ++ms) {
            if (ms + 2 < NT) ISSUE(TILE_OF(ms + 2), (ms + 2) & 3);
            if (ms > 0) {
                const int cur = (ms - 1) & 3;
        const unsigned va = vfa + cur * 32768;
#define TRR(dst, off) asm volatile("ds_read_b64_tr_b16 %0, %1 offset:%2" : "=&v"(dst) : "v"(va), "n"(off) : "memory")
#define READ8(L, H, S) do { TRR(L[0], ((2 * (S)) * 4 + 0) * 512); TRR(H[0], ((2 * (S) + 1) * 4 + 0) * 512); TRR(L[1], ((2 * (S)) * 4 + 1) * 512); TRR(H[1], ((2 * (S) + 1) * 4 + 1) * 512); \
                        TRR(L[2], ((2 * (S)) * 4 + 2) * 512); TRR(H[2], ((2 * (S) + 1) * 4 + 2) * 512); TRR(L[3], ((2 * (S)) * 4 + 3) * 512); TRR(H[3], ((2 * (S) + 1) * 4 + 3) * 512); } while (0)
#define WAITV(N, L, H) asm volatile("s_waitcnt lgkmcnt(" #N ")" : "+v"(L[0]), "+v"(H[0]), "+v"(L[1]), "+v"(H[1]), "+v"(L[2]), "+v"(H[2]), "+v"(L[3]), "+v"(H[3]) :: "memory")
#define PV4(S, L, H) do { _Pragma("unroll") for (int cb = 0; cb < 4; ++cb) { const bf16x8 vf = __builtin_shufflevector(L[cb], H[cb], 0, 1, 2, 3, 4, 5, 6, 7); o[cb] = MFMA32(pk[S], vf, o[cb]); } } while (0)
#if DIAG_LIGHT
        s16x4 la[4], ha[4];
        READ8(la, ha, 0); WAITV(0, la, ha); PV4(0, la, ha); READ8(la, ha, 1); WAITV(0, la, ha); PV4(1, la, ha);
        READ8(la, ha, 2); WAITV(0, la, ha); PV4(2, la, ha); READ8(la, ha, 3); WAITV(0, la, ha); PV4(3, la, ha);
#else
        s16x4 la[4], ha[4], lb[4], hb[4];
        READ8(la, ha, 0); READ8(lb, hb, 1);
        WAITV(8, la, ha); PV4(0, la, ha);
        READ8(la, ha, 2);
        WAITV(8, lb, hb); PV4(1, lb, hb);
        READ8(lb, hb, 3);
        WAITV(8, la, ha); PV4(2, la, ha);
        WAITV(0, lb, hb); PV4(3, lb, hb);
#endif
#undef TRR
#undef READ8
#undef WAITV
#undef PV4
            }
            if (ms < NT) {
                const int t = TILE_OF(ms), cur = ms & 3;
        const LAS unsigned char* kc = kfb + cur * 32768;
#undef KA
#define KA(ks, kb) (*(const LAS bf16x8*)(kc + (ks) * 2048 + (kb) * 512))
        f32x16 p0, p1; float alpha = 1.0f;
        if (ms < 2) {
#pragma unroll
            for (int i = 0; i < 16; ++i) { p0[i] = 0.f; p1[i] = 0.f; }
#pragma unroll
            for (int kh = 0; kh < 2; ++kh) { const bf16x8 k00 = KA(2 * kh, 0), k01 = KA(2 * kh, 1), k10 = KA(2 * kh + 1, 0), k11 = KA(2 * kh + 1, 1);
                p0 = MFMA32(k00, qf[2 * kh], p0); p1 = MFMA32(k01, qf[2 * kh], p1); p0 = MFMA32(k10, qf[2 * kh + 1], p0); p1 = MFMA32(k11, qf[2 * kh + 1], p1); }
            const float dq = (float)(q0 + r - t * 64 - 4 * hi);
            float tmax = -1e30f;
#pragma unroll
            for (int i = 0; i < 16; ++i) {
                const float c0 = (float)((i & 3) + 8 * (i >> 2));
                p0[i] = __builtin_fmaf(-slope2, __builtin_fabsf(dq - c0), p0[i]);
                p1[i] = __builtin_fmaf(-slope2, __builtin_fabsf(dq - (c0 + 32.f)), p1[i]);
                tmax = fmaxf(tmax, fmaxf(p0[i], p1[i]));
            }
            tmax = fmaxf(tmax, __shfl_xor(tmax, 32));
            const float mnew = fmaxf(mrun, tmax); alpha = __builtin_amdgcn_exp2f(mrun - mnew); mrun = mnew;
#pragma unroll
            for (int i = 0; i < 16; ++i) { p0[i] -= mrun; p1[i] -= mrun; }
        } else {
            const bool right = t >= td0;
            const float xq = (float)(q0 + r - 64 * t), ss2 = right ? -slope2 : slope2;
            const float A0 = -ss2 * xq - mrun;
            bf16x8 qx;
            { const unsigned u1 = cvtpk(A0, 0.f) & 0xffffu; const float r1 = A0 - __uint_as_float(u1 << 16);
              const unsigned u2 = cvtpk(r1, 0.f) & 0xffffu; const float r2 = r1 - __uint_as_float(u2 << 16);
              const unsigned u3 = cvtpk(r2, 0.f) & 0xffffu;
              const unsigned sgnm = right ? 0x80008000u : 0u;
              u32x4 w; w.x = (sl12 ^ sgnm) & himask; w.y = (((sl3 ^ sgnm) & 0xffffu) | (u1 << 16)) & himask; w.z = (u2 | (u3 << 16)) & himask; w.w = 0u;
              qx = __builtin_bit_cast(bf16x8, w); }
#pragma unroll
            for (int i = 0; i < 16; ++i) { p0[i] = 0.f; p1[i] = 0.f; }
            p0 = MFMA32(kc0, qx, p0); p1 = MFMA32(kc1, qx, p1);
#pragma unroll
            for (int kh = 0; kh < 2; ++kh) { const bf16x8 k00 = KA(2 * kh, 0), k01 = KA(2 * kh, 1), k10 = KA(2 * kh + 1, 0), k11 = KA(2 * kh + 1, 1);
                p0 = MFMA32(k00, qf[2 * kh], p0); p1 = MFMA32(k01, qf[2 * kh], p1); p0 = MFMA32(k10, qf[2 * kh + 1], p0); p1 = MFMA32(k11, qf[2 * kh + 1], p1); }
            if (!nocheck) {
            float ma = __builtin_fmaxf(__builtin_fmaxf(p0[0], p0[1]), p1[0]), mb = __builtin_fmaxf(__builtin_fmaxf(p0[2], p0[3]), p1[1]);
            ma = __builtin_fmaxf(__builtin_fmaxf(ma, p1[2]), p1[3]);
#pragma unroll
            for (int i = 4; i < 16; i += 4) { ma = __builtin_fmaxf(__builtin_fmaxf(ma, p0[i]), p0[i + 1]); mb = __builtin_fmaxf(__builtin_fmaxf(mb, p0[i + 2]), p0[i + 3]);
                ma = __builtin_fmaxf(__builtin_fmaxf(ma, p1[i]), p1[i + 1]); mb = __builtin_fmaxf(__builtin_fmaxf(mb, p1[i + 2]), p1[i + 3]); }
            float tm = __builtin_fmaxf(ma, mb);
            { auto rr = __builtin_amdgcn_permlane32_swap(__float_as_uint(tm), __float_as_uint(tm), false, false); tm = __builtin_fmaxf(__uint_as_float(rr[0]), __uint_as_float(rr[1])); }
            if (__builtin_expect(__any(tm > ATT_THR), 0)) {
                const float dl = __builtin_fmaxf(tm, 0.f); alpha = __builtin_amdgcn_exp2f(-dl); mrun += dl;
#pragma unroll
                for (int i = 0; i < 16; ++i) { p0[i] -= dl; p1[i] -= dl; }
            }
            }
        }
        if (__any(alpha != 1.0f)) {
            lsum *= alpha;
            if (hi == 0) wsf[r] = alpha;
            asm volatile("s_waitcnt lgkmcnt(0)" ::: "memory");
#pragma unroll
            for (int i = 0; i < 16; ++i) { const float ai = wsf[crow(i, hi)];
#pragma unroll
                for (int cb = 0; cb < 4; ++cb) asm volatile("v_mul_f32 %0, %0, %1" : "+v"(o[cb][i]) : "v"(ai)); }
            asm volatile("s_waitcnt lgkmcnt(0)" ::: "memory");
        }
        f32x2_t ls2 = {0.f, 0.f};
#pragma unroll
        for (int j = 0; j < 8; ++j) { f32x2_t e0, e1; e0.x = __builtin_amdgcn_exp2f(p0[2 * j]); e0.y = __builtin_amdgcn_exp2f(p0[2 * j + 1]); e1.x = __builtin_amdgcn_exp2f(p1[2 * j]); e1.y = __builtin_amdgcn_exp2f(p1[2 * j + 1]);
            p0[2 * j] = e0.x; p0[2 * j + 1] = e0.y; p1[2 * j] = e1.x; p1[2 * j + 1] = e1.y; ls2 = ls2 + e0; ls2 = ls2 + e1; }
        lsum += ls2.x + ls2.y;
        { u32x4 w;
          w.x = cvtpk(p0[0], p0[1]); w.y = cvtpk(p0[2], p0[3]); w.z = cvtpk(p0[4], p0[5]); w.w = cvtpk(p0[6], p0[7]); pk[0] = __builtin_bit_cast(bf16x8, w);
          w.x = cvtpk(p0[8], p0[9]); w.y = cvtpk(p0[10], p0[11]); w.z = cvtpk(p0[12], p0[13]); w.w = cvtpk(p0[14], p0[15]); pk[1] = __builtin_bit_cast(bf16x8, w);
          w.x = cvtpk(p1[0], p1[1]); w.y = cvtpk(p1[2], p1[3]); w.z = cvtpk(p1[4], p1[5]); w.w = cvtpk(p1[6], p1[7]); pk[2] = __builtin_bit_cast(bf16x8, w);
          w.x = cvtpk(p1[8], p1[9]); w.y = cvtpk(p1[10], p1[11]); w.z = cvtpk(p1[12], p1[13]); w.w = cvtpk(p1[14], p1[15]); pk[3] = __builtin_bit_cast(bf16x8, w); }
                STEP_END(ms);
            } else asm volatile("s_waitcnt lgkmcnt(0)\n\ts_barrier" ::: "memory");
        }
        __builtin_amdgcn_s_setprio(0);
    }
#undef STEP_END
    if (DIAG && wid == DIAG_WAVE && lane == 0 && *(const LAS unsigned*)(lds + 131072 + 256 + 2048 + 12) != 0u) { if (DIAG_SEL == 0) tacc_ = (unsigned)clock64() - t0_;
        unsigned* dg_ = (unsigned*)((unsigned char*)Kt - WS_K) + 3000; dg_[0] = tacc_ / (unsigned)NT; }
#undef TILE_OF
#undef ISSUE
    lsum += __shfl_xor(lsum, 32);
    float inv = 1.0f / lsum; if (map == 1) inv *= *(const LAS float*)(lds + 131072 + 256 + 2048 + 8);
    if (hi == 0) wsf[r] = inv;
    asm volatile("s_waitcnt lgkmcnt(0)" ::: "memory");
#pragma unroll
    for (int i = 0; i < 16; ++i) { const float si = wsf[crow(i, hi)];
#pragma unroll
        for (int cb = 0; cb < 4; ++cb) o[cb][i] *= si; }
    LAS float* xch = (LAS float*)lds + qs * 4096;
    if (map == 1) {
#pragma unroll
        for (int cb = 0; cb < 4; ++cb)
#pragma unroll
            for (int i = 0; i < 16; ++i) xch[(cb * 16 + i) * 64 + lane] = o[cb][i];
    }
    __syncthreads();
    if (map == 0) {
        float ss[16];
#pragma unroll
        for (int i = 0; i < 16; ++i) { ss[i] = 0.f;
#pragma unroll
            for (int cb = 0; cb < 4; ++cb) { o[cb][i] -= xch[(cb * 16 + i) * 64 + lane]; ss[i] += o[cb][i] * o[cb][i]; } }
#pragma unroll
        for (int i = 0; i < 16; ++i) {
#pragma unroll
            for (int sft = 1; sft < 32; sft <<= 1) ss[i] += __shfl_xor(ss[i], sft);
            ss[i] = post / sqrtf(ss[i] * (1.0f / V_DIM) + EPS);
        }
#pragma unroll
        for (int cb = 0; cb < 4; ++cb) { const float g = subg[cb * 32 + r];
#pragma unroll
            for (int i = 0; i < 16; ++i) ((GAS bf16*)ON)[(tokbase + q0 + crow(i, hi)) * (CONV_W + ATTN_W) + h * 128 + cb * 32 + r] = (bf16)f2bf(o[cb][i] * ss[i] * g); }
    }
    __syncthreads();
}

#define XB_TMO      128
#define XB_XCNT(j)  (256  + 64 * (j))
#define XB_XSUB(j)  (1280 + 64 * (j))
#define XB_XGEN(j)  (2304 + 64 * (j))
#define XB_TOP      3328
#define XB_TOPGEN   3392
#define XCD_BAR_WORDS 3456
#define XB_SPIN_CAP (1u << 18)

__device__ __forceinline__ unsigned xb_ld(unsigned* p)              { return __hip_atomic_load(p, __ATOMIC_RELAXED, __HIP_MEMORY_SCOPE_AGENT); }
__device__ __forceinline__ unsigned xb_add(unsigned* p, unsigned v) { return __hip_atomic_fetch_add(p, v, __ATOMIC_RELAXED, __HIP_MEMORY_SCOPE_AGENT); }
__device__ __forceinline__ unsigned xb_xcc_id() { return (unsigned)__builtin_amdgcn_s_getreg((3 << 11) | 20) & 0xFu; }
#define XB_SPIN(cond, bar) do { unsigned _sp = 0; while (cond) { __builtin_amdgcn_s_sleep(1); \
    if ((++_sp & 255u) == 0u) { if (xb_ld(&(bar)[XB_TMO])) break; if (_sp > XB_SPIN_CAP) { atomicAdd(&(bar)[XB_TMO], 1u); break; } } } } while (0)

struct XcdBarrier {
    unsigned* bar; unsigned x;
    volatile LAS unsigned* st;
};

__device__ __forceinline__ XcdBarrier xcd_barrier_post(unsigned* bar, volatile LAS unsigned* st) {
    XcdBarrier b; b.bar = bar; b.x = xb_xcc_id(); b.st = st;
    if (threadIdx.x == 0) (void)xb_add(&bar[XB_XCNT(b.x)], 1u);
    return b;
}
__device__ __forceinline__ void xcd_barrier_complete(unsigned* bar, unsigned x, unsigned& nloc, unsigned& nx) {
    const unsigned G = gridDim.x * gridDim.y * gridDim.z;
    unsigned sum, cnt, mine, sp = 0u;
    for (;;) {
        sum = 0u; cnt = 0u; mine = 0u;
#pragma unroll
        for (unsigned j = 0; j < 16; ++j) { const unsigned c = xb_ld(&bar[XB_XCNT(j)]); sum += c; cnt += (c > 0u) ? 1u : 0u; mine = (j == x) ? c : mine; }
        if (sum == G) break;
        __builtin_amdgcn_s_sleep(1);
        if ((++sp & 255u) == 0u) { if (xb_ld(&bar[XB_TMO])) break; if (sp > XB_SPIN_CAP) { atomicAdd(&bar[XB_TMO], 1u); break; } }
    }
    nloc = mine > 0u ? mine : 1u; nx = cnt > 0u ? cnt : 1u;
}

__device__ __forceinline__ void xcd_barrier(const XcdBarrier& b) {
    asm volatile("s_waitcnt vmcnt(0)" ::: "memory");
    __syncthreads();
    if (threadIdx.x == 0) {
        unsigned* bar = b.bar;
        __builtin_amdgcn_s_waitcnt(0);
        unsigned nloc = b.st[0], nx = b.st[1];
        if (nloc == 0u) { xcd_barrier_complete(bar, b.x, nloc, nx); b.st[0] = nloc; b.st[1] = nx; }
        const unsigned old = xb_add(&bar[XB_XSUB(b.x)], 1u);
        const unsigned gen = old / nloc;
        if (old + 1u == (gen + 1u) * nloc) {
            __builtin_amdgcn_fence(__ATOMIC_RELEASE, "agent");
            asm volatile("s_waitcnt vmcnt(0)" ::: "memory");
            const unsigned og = xb_add(&bar[XB_TOP], 1u);
            const unsigned tg = og / nx;
            if (og + 1u == (tg + 1u) * nx) xb_add(&bar[XB_TOPGEN], 1u);
            else XB_SPIN(xb_ld(&bar[XB_TOPGEN]) == tg, bar);
            __builtin_amdgcn_fence(__ATOMIC_ACQUIRE, "agent");
            xb_add(&bar[XB_XGEN(b.x)], 1u);
            asm volatile("s_waitcnt vmcnt(0)" ::: "memory");
        } else {
            XB_SPIN(xb_ld(&bar[XB_XGEN(b.x)]) == gen, bar);
            __builtin_amdgcn_fence(__ATOMIC_ACQUIRE, "agent");
            asm volatile("s_waitcnt vmcnt(0)" ::: "memory");
        }
    }
    __syncthreads();
}


#ifndef REP_ATT
#define REP_ATT 1
#endif
#ifndef REP_GEMM
#define REP_GEMM 1
#endif
#ifndef PHM
#define PHM 127
#endif
__global__ void __launch_bounds__(512) mk_fwd(Args a) {
    extern __shared__ __attribute__((aligned(16))) unsigned char lds_raw[];
    LAS unsigned char* lds = (LAS unsigned char*)lds_raw;
    const int G = gridDim.x, bx = blockIdx.x;
    volatile LAS unsigned* MISC = (volatile LAS unsigned*)(lds + 131072 + 64);
    if (threadIdx.x < 4) MISC[threadIdx.x] = 0u;
    __syncthreads();
    XcdBarrier xbar = xcd_barrier_post((unsigned*)(a.ws + WS_CTL) + 4096, MISC);
    for (int p = a.ph_lo; p < a.ph_hi; ++p) {
        const int l = p >> 3, k = p & 7;
        int tid_ = threadIdx.x; asm volatile("" : "+v"(tid_));
        const int tid = tid_, wave = __builtin_amdgcn_readfirstlane(tid >> 6);
#define FRESH_LANE() ({ int t_ = threadIdx.x; asm volatile("" : "+v"(t_)); t_ & 63; })
        const int gw = bx * 8 + wave, NGW = G * 8;
    unsigned char* ws = a.ws; asm volatile("" : "+s"(ws));
    bf16* U = (bf16*)(ws + WS_U); bf16* CONV = (bf16*)(ws + WS_CONV); bf16* Qb = (bf16*)(ws + WS_Q); bf16* Kt = (bf16*)(ws + WS_K); bf16* Vt = (bf16*)(ws + WS_V);
    bf16* Gt = (bf16*)(ws + WS_G); bf16* Z = (bf16*)(ws + WS_Z); bf16* ON = Z + CONV_W;   bf16* MO = (bf16*)(ws + WS_MO);
    bf16* Ah = (bf16*)(ws + WS_A); bf16* Fo = (bf16*)(ws + WS_F); bf16* MERGED = U;
    const unsigned char* wb = ws + WS_W;
    float* hbuf = a.out;
    const float* norm_g = a.in[9];
        unsigned* ctl = (unsigned*)(ws + WS_CTL);
        if ((PHM & 1) && k == 0) {
            if (l < DEPTH) convert_weights(a, l, lds, gw, NGW, wave, FRESH_LANE());
            if (l == 0) row_phase<false, true>(a.in[0], nullptr, nullptr, hbuf, norm_g + (size_t)(0 * 4 + 0) * D_MODEL, U, gw, NGW, FRESH_LANE());
            else if (l < DEPTH) row_phase<true, true>(hbuf, Fo, norm_g + (size_t)((l - 1) * 4 + 3) * D_MODEL, hbuf, norm_g + (size_t)(l * 4 + 0) * D_MODEL, U, gw, NGW, FRESH_LANE());
            else row_phase<true, false>(hbuf, Fo, norm_g + (size_t)((l - 1) * 4 + 3) * D_MODEL, hbuf, nullptr, nullptr, gw, NGW, FRESH_LANE());
            if (DIAG && l == DEPTH) { __syncthreads(); if (bx == 0 && tid == 0) hbuf[0] += (float)ctl[3000] * DIAG_SCALE; }
        } else if ((PHM & 2) && k == 1) {
            pg8::Gemm g{U, (const bf16*)(wb + W_IN_OFF), M, IN_W, D_MODEL}; pg8::StaticOrder S; S.init(M, IN_W, G, bx);
            pg8::EpiWin E{CONV, Qb, Kt, Vt, Gt, a.in[2] + (size_t)l * 2 * D_MODEL, 0.125f * LOG2E, ctl + 1024 + l * 64};
            for (int rep = 0; rep < REP_GEMM; ++rep) pg8::gemm_phase<pg8::EpiWin, pg8::StaticOrder, true, true>(lds, g, S, E);
        } else if ((PHM & 4) && k == 2) {
            const float lam_init = 0.8f - 0.6f * expf(-0.3f * (float)l);
            const float* lq = a.in[5] + (size_t)l * 4 * HEAD_DIM;
            const int ln_ = FRESH_LANE(); const float s1 = wave_sum(lq[ln_] * lq[64 + ln_]), s2 = wave_sum(lq[128 + ln_] * lq[192 + ln_]);
            const float lam = expf(s1) - expf(s2) + lam_init;
            const float* subg = a.in[6] + (size_t)l * V_DIM;
            LAS unsigned* sq = (LAS unsigned*)(lds + 131072 + 256 + 2048);
            if (tid == 0) *(LAS float*)(lds + 131072 + 256 + 2048 + 8) = lam;
            const unsigned* nq = ctl + 1024 + l * 64; const unsigned* nk = nq + 32;
            const bool deal = (G == 256);
            bool first = deal;
            for (int rep = 0; rep < REP_ATT; ++rep)
            for (;;) {
                int h, b, qb;
                if (first) { first = false; const int g = bx & 7, j = bx >> 3; h = g < 4 ? 3 : 2; b = (g & 3) >> 1; const int jj = (g & 1) * 32 + j; qb = (jj & 1) ? 31 - (jj >> 1) : 32 + (jj >> 1); }
                else {
                __syncthreads();
                if (tid == 0) sq[0] = atomicAdd(ctl + l * 64 + rep * 16, 1u);
                __syncthreads();
                const int u = (int)sq[0] + ((deal && rep == 0) ? 256 : 0);
                if (u >= 512) {
                    const int v = u - 512;
                    if (v < M / 64) { conv_items(CONV, a.in[3] + (size_t)l * 3 * CONV_W, Z, v * 8 + wave, v * 8 + 8, 8, FRESH_LANE()); continue; }
                    break; }
                h = 3 - (u >> 7); const int idx = u & 127; b = idx & 1; const int jj = idx >> 1; qb = (jj & 1) ? 31 - (jj >> 1) : 32 + (jj >> 1);
                }
                const float slope2 = exp2f(-2.0f * (float)(h + 1)) * LOG2E;
                const unsigned* wq = nq + (b * 4 + h) * 4; const unsigned* wk = nk + (b * 4 + h) * 4;
                const float kn0 = __uint_as_float(wk[0]) + __uint_as_float(wk[1]), kn1 = __uint_as_float(wk[2]) + __uint_as_float(wk[3]);
                if (DIAG && tid == 0) sq[3] = (h == 3 && b == 0 && qb == 32) ? 1u : 0u;
                attn_unit(b, h, qb, kn0, kn1, Qb, Kt, Vt, ON, lds, slope2, subg, 1.0f - lam_init);
            }
        } else if ((PHM & 8) && k == 3) {
            pg8::Gemm g{Z, (const bf16*)(wb + W_CO_OFF), M, D_MODEL, CONV_W + ATTN_W}; pg8::StaticOrder S; S.init(M, D_MODEL, G, bx);
            pg8::EpiMerge E{Gt, MERGED};
            for (int rep = 0; rep < REP_GEMM; ++rep) pg8::gemm_phase<pg8::EpiMerge, pg8::StaticOrder, true, true>(lds, g, S, E);
        } else if ((PHM & 16) && (k == 4 || k == 7)) {
            const bool ff = (k == 7);
            pg8::Gemm g{ff ? Ah : MERGED, (const bf16*)(wb + (ff ? W_F2_OFF : W_O_OFF)), M, D_MODEL, ff ? D_FF : D_MODEL}; pg8::StaticOrder S; S.init(M, D_MODEL, G, bx);
            pg8::EpiBf16P E{ff ? Fo : MO, D_MODEL};
            for (int rep = 0; rep < REP_GEMM; ++rep) pg8::gemm_phase<pg8::EpiBf16P, pg8::StaticOrder, true, true>(lds, g, S, E);
        } else if ((PHM & 32) && k == 5) {
            row_phase<true, true>(hbuf, MO, norm_g + (size_t)(l * 4 + 1) * D_MODEL, hbuf, norm_g + (size_t)(l * 4 + 2) * D_MODEL, U, gw, NGW, FRESH_LANE());
        } else if ((PHM & 64) && k == 6) {
            pg8::Gemm g{U, (const bf16*)(wb + W_F1_OFF), M, D_FF, D_MODEL}; pg8::StaticOrder S; S.init(M, D_FF, G, bx);
            pg8::EpiRelu2 E{Ah, D_FF};
            for (int rep = 0; rep < REP_GEMM; ++rep) pg8::gemm_phase<pg8::EpiRelu2, pg8::StaticOrder, true, true>(lds, g, S, E);
        }
        if (p + 1 < a.ph_hi) {
            if (a.ph_lo < 0) cg::this_grid().sync();
            xcd_barrier(xbar);
        }
    }
}

constexpr int N_PHASES = DEPTH * 8 + 1;
#ifndef MK_MULTI
#define MK_MULTI 0
#endif

extern "C" void kernel_launch(void* const* d_in, const int* in_sizes, int n_in, void* d_out, int out_size, void* d_ws, size_t ws_size, hipStream_t stream) {
    static int grid = 0;
    if (grid == 0) {
        if (n_in != 12 || out_size != M * D_MODEL || ws_size < WS_END) { fprintf(stderr, "kernel_launch: unexpected shapes (n_in %d out %d ws %zu)\n", n_in, out_size, ws_size); grid = -1; return; }
        int dev = 0, cus = 0, per_cu = 0;
        hipGetDevice(&dev); hipDeviceGetAttribute(&cus, hipDeviceAttributeMultiprocessorCount, dev);
        hipFuncSetAttribute((const void*)mk_fwd, hipFuncAttributeMaxDynamicSharedMemorySize, LDS_BYTES);
        hipOccupancyMaxActiveBlocksPerMultiprocessor(&per_cu, (const void*)mk_fwd, 512, LDS_BYTES);
        (void)hipGetLastError();
        if (per_cu < 1) per_cu = 1;
        grid = cus * 1;
        if (grid != 256) fprintf(stderr, "kernel_launch: note: %d CUs\n", grid);
    }
    if (grid < 0) return;
    Args a{};
    for (int i = 0; i < 12; ++i) a.in[i] = (const float*)d_in[i];
    a.out = (float*)d_out; a.ws = (unsigned char*)d_ws;
#if MK_MULTI
    for (int p = 0; p < N_PHASES; ++p) {
        a.ph_lo = p; a.ph_hi = p + 1;
        hipLaunchKernelGGL(mk_fwd, dim3(grid), dim3(512), LDS_BYTES, stream, a);
    }
#else
    a.ph_lo = 0; a.ph_hi = N_PHASES;
    if (hipMemsetAsync((char*)d_ws + WS_CTL, 0, 8192 * 4, stream) != hipSuccess) { fprintf(stderr, "kernel_launch: hipMemsetAsync failed\n"); return; }
    void* args[] = {&a};
    hipError_t e = hipLaunchCooperativeKernel((const void*)mk_fwd, dim3(grid), dim3(512), args, LDS_BYTES, stream);
    if (e != hipSuccess) fprintf(stderr, "cooperative launch failed: %s (grid %d)\n", hipGetErrorString(e), grid);
#endif
}
```

```cpp
#include <hip/hip_runtime.h>
#include <hip/hip_cooperative_groups.h>
#include <cstdio>
#include <cstdint>
namespace cg = cooperative_groups;
namespace pg8 {
#define PG8_LAS __attribute__((address_space(3)))
#define PG8_GAS __attribute__((address_space(1)))
typedef unsigned short bf16_t;
typedef short bf16x8 __attribute__((ext_vector_type(8)));
typedef float f32x4 __attribute__((ext_vector_type(4)));
typedef unsigned u32x4 __attribute__((ext_vector_type(4)));
constexpr int BM = 256, BK = 64, HALF = 128, HTB = HALF * BK * 2  , STAGE_BYTES = 8 * HTB, NXCD = 8, WGM = 8;

__host__ __device__ __forceinline__ int lds_byte(int r, int c) { const int st = (r >> 4) * 2 + (c >> 5), rr = r & 15, cc = c & 31, ob = rr * 64 + cc * 2; return st * 1024 + (ob ^ (((ob >> 9) & 1) << 5)); }
__host__ __device__ __forceinline__ void stage_rc(int b, int& R, int& C) { const int st = b / 1024, sb = b % 1024, swz = sb ^ (((sb >> 9) & 1) << 5); R = (st >> 1) * 16 + swz / 64; C = (st & 1) * 32 + (swz % 64) / 2; }
__host__ __device__ __forceinline__ int perm32(int rho) { const int n = rho >> 4, i = rho & 15; return 8 * (i >> 2) + 4 * n + (i & 3); }

struct Unit { int pm, pn; };
struct Gemm { const bf16_t* A; const bf16_t* Bt; int M, N, K; };

struct StaticOrder {
    int nM, nN, nwg, G, c;
    __host__ __device__ void init(int M, int N, int G_, int c_) { nM = M / BM; nN = N / BM; nwg = nM * nN; G = G_; c = c_; }
    __host__ __device__ bool next(int i, Unit& u) const {
        const long L = (long)i * G + c; if (L >= nwg) return false;
        int wgid = (int)L; { const int q = nwg / NXCD, r = nwg % NXCD, xcd = wgid % NXCD, off = wgid / NXCD; wgid = (xcd < r ? xcd * (q + 1) : r * (q + 1) + (xcd - r) * q) + off; }
        const int nig = WGM * nN, gid = wgid / nig, fm = gid * WGM, gsz = (nM - fm) < WGM ? (nM - fm) : WGM;
        u.pm = fm + ((wgid % nig) % gsz); u.pn = (wgid % nig) / gsz; return true;
    }
    __device__ __forceinline__ void a_ready(const Unit&) const {}
    __device__ __forceinline__ void done(const Unit&) const {}
};

__device__ __forceinline__ unsigned cvt_pk_bf16(float lo, float hi) { unsigned r; asm volatile("v_cvt_pk_bf16_f32 %0, %1, %2" : "=v"(r) : "v"(lo), "v"(hi)); return r; }
typedef float f32x2 __attribute__((ext_vector_type(2)));

typedef unsigned u32x4 __attribute__((ext_vector_type(4)));
__device__ __forceinline__ float bf_lo(unsigned w) { return __uint_as_float(w << 16); }
__device__ __forceinline__ float bf_hi(unsigned w) { return __uint_as_float(w & 0xffff0000u); }
__device__ __forceinline__ float fast_sigmoid(float x) { return __builtin_amdgcn_rcpf(1.0f + __builtin_amdgcn_exp2f(-1.4426950408889634f * x)); }

constexpr int SEQ_ = 8192;
struct EpiWin {
    static constexpr bool PERM = true, AFTER_DRAIN = false, MID = false;
    bf16_t *CONV, *Q, *Kt, *Vt, *G; const float* bgate; float qscale; unsigned* nrm;
    __device__ __forceinline__ void operator()(const f32x4 (&acc)[2][2][4][2], const Unit& u, int wr, int wc, int fr_, int fq_) const {
        int fr = fr_, fq = fq_; asm volatile("" : "+v"(fr), "+v"(fq));
        const int pn = u.pn; const int row0 = u.pm * BM + wr * 64 + fr; const int cl0 = wc * 32 + 8 * fq;
        bf16_t* base; int s_ai, s_m, s_bj; float sc = 1.f; bool gate = false;
        if (pn < 6) { base = CONV + (size_t)row0 * 1536 + pn * 256 + cl0; s_ai = HALF * 1536; s_m = 16 * 1536; s_bj = HALF; }
        else if (pn < 8) { base = Q + (size_t)row0 * 512 + (pn - 6) * 256 + cl0; s_ai = HALF * 512; s_m = 16 * 512; s_bj = HALF; sc = qscale; }
        else if (pn < 10) { const int h0 = (pn - 8) * 2, chunk = cl0 >> 3; const int b = row0 >> 13, s = row0 & (SEQ_ - 1), t = s >> 6, key = s & 63;
            base = Kt + ((size_t)((b * 4 + h0) * 128 + t)) * 8192 + chunk * 512 + key * 8; s_ai = 2 * 8192; s_m = 16 * 8; s_bj = 128 * 8192; }
        else if (pn < 12) { const int h0 = (pn - 10) * 2; const int b = row0 >> 13, s = row0 & (SEQ_ - 1), t = s >> 6, key = s & 63, kg = key >> 3;
            base = Vt + ((size_t)((b * 4 + h0) * 128 + t)) * 8192 + (kg * 4 + wc) * 256 + (key & 7) * 32 + 8 * fq; s_ai = 2 * 8192; s_m = 2 * 4 * 256; s_bj = 128 * 8192; }
        else { base = G + (size_t)row0 * 2048 + (pn - 12) * 256 + cl0; s_ai = HALF * 2048; s_m = 16 * 2048; s_bj = HALF; gate = true; }
        const bool trk = (pn >= 6 && pn < 10); float mx0 = 0.f, mx1 = 0.f;
        f32x4 bv[2][2];
#pragma unroll
        for (int bj = 0; bj < 2; ++bj)
#pragma unroll
            for (int n = 0; n < 2; ++n) bv[bj][n] = gate ? *(const f32x4*)(bgate + (pn - 12) * 256 + cl0 + bj * HALF + 4 * n) : (f32x4){0.f, 0.f, 0.f, 0.f};
#pragma unroll
        for (int ai = 0; ai < 2; ++ai)
#pragma unroll
            for (int m = 0; m < 4; ++m) {
#pragma unroll
                for (int bj = 0; bj < 2; ++bj) {
                    f32x4 v0 = acc[ai][bj][m][0] * sc, v1 = acc[ai][bj][m][1] * sc;
                    if (gate) { v0 = v0 + bv[bj][0]; v1 = v1 + bv[bj][1];
#pragma unroll
                        for (int e = 0; e < 4; ++e) { v0[e] = fast_sigmoid(v0[e]); v1[e] = fast_sigmoid(v1[e]); } }
                    if (trk) { float s = (v0[0] * v0[0] + v0[1] * v0[1]) + (v0[2] * v0[2] + v0[3] * v0[3]) + (v1[0] * v1[0] + v1[1] * v1[1]) + (v1[2] * v1[2] + v1[3] * v1[3]);
                        s += __shfl_xor(s, 16); s += __shfl_xor(s, 32); if (bj == 0) mx0 = fmaxf(mx0, s); else mx1 = fmaxf(mx1, s); }
                    u32x4 w; w.x = cvt_pk_bf16(v0[0], v0[1]); w.y = cvt_pk_bf16(v0[2], v0[3]); w.z = cvt_pk_bf16(v1[0], v1[1]); w.w = cvt_pk_bf16(v1[2], v1[3]);
                    *(PG8_GAS u32x4*)(base + (size_t)ai * s_ai + (size_t)m * s_m + (size_t)bj * s_bj) = w;
                }
                asm volatile("" ::: "memory");
            }
        if (trk) {
#pragma unroll
            for (int sft = 1; sft < 16; sft <<= 1) { mx0 = fmaxf(mx0, __shfl_xor(mx0, sft)); mx1 = fmaxf(mx1, __shfl_xor(mx1, sft)); }
            if (fr == 0 && fq == 0) { const int isk = pn >= 8 ? 1 : 0, h0 = ((pn - 6) & 1) * 2, bb = row0 >> 13;
                unsigned* wp = nrm + isk * 32 + (bb * 4 + h0) * 4 + wc;
                atomicMax(wp, __float_as_uint(mx0)); atomicMax(wp + 4, __float_as_uint(mx1)); }
        }
    }
};
struct EpiGate1 {
    static constexpr bool PERM = true, AFTER_DRAIN = false, MID = false;
    float* T; const bf16_t* G;
    __device__ __forceinline__ void operator()(const f32x4 (&acc)[2][2][4][2], const Unit& u, int wr, int wc, int fr_, int fq_) const {
        int fr = fr_, fq = fq_; asm volatile("" : "+v"(fr), "+v"(fq));
        const int row0 = u.pm * BM + wr * 64 + fr;
#pragma unroll
        for (int ai = 0; ai < 2; ++ai)
#pragma unroll
            for (int m = 0; m < 4; ++m) {
                const int row = row0 + ai * HALF + m * 16;
#pragma unroll
                for (int bj = 0; bj < 2; ++bj) {
                    const int col = u.pn * BM + bj * HALF + wc * 32 + 8 * fq;
                    const u32x4 g = *(const u32x4*)(G + (size_t)row * 2048 + col);
                    f32x4 v0 = acc[ai][bj][m][0], v1 = acc[ai][bj][m][1];
                    v0[0] *= bf_lo(g.x); v0[1] *= bf_hi(g.x); v0[2] *= bf_lo(g.y); v0[3] *= bf_hi(g.y);
                    v1[0] *= bf_lo(g.z); v1[1] *= bf_hi(g.z); v1[2] *= bf_lo(g.w); v1[3] *= bf_hi(g.w);
                    float* d = T + (size_t)row * 1024 + col; *(f32x4*)d = v0; *(f32x4*)(d + 4) = v1;
                }
                asm volatile("" ::: "memory");
            }
    }
};
struct EpiGate2 {
    static constexpr bool PERM = true, AFTER_DRAIN = false, MID = false;
    const float* T; const bf16_t* G; bf16_t* O;
    __device__ __forceinline__ void operator()(const f32x4 (&acc)[2][2][4][2], const Unit& u, int wr, int wc, int fr_, int fq_) const {
        int fr = fr_, fq = fq_; asm volatile("" : "+v"(fr), "+v"(fq));
        const int row0 = u.pm * BM + wr * 64 + fr;
#pragma unroll
        for (int ai = 0; ai < 2; ++ai)
#pragma unroll
            for (int m = 0; m < 4; ++m) {
                const int row = row0 + ai * HALF + m * 16;
#pragma unroll
                for (int bj = 0; bj < 2; ++bj) {
                    const int col = u.pn * BM + bj * HALF + wc * 32 + 8 * fq;
                    const u32x4 g = *(const u32x4*)(G + (size_t)row * 2048 + 1024 + col);
                    const float* d = T + (size_t)row * 1024 + col; const f32x4 t0 = *(const f32x4*)d, t1 = *(const f32x4*)(d + 4);
                    f32x4 v0 = acc[ai][bj][m][0], v1 = acc[ai][bj][m][1];
                    v0[0] = t0[0] + v0[0] * bf_lo(g.x); v0[1] = t0[1] + v0[1] * bf_hi(g.x); v0[2] = t0[2] + v0[2] * bf_lo(g.y); v0[3] = t0[3] + v0[3] * bf_hi(g.y);
                    v1[0] = t1[0] + v1[0] * bf_lo(g.z); v1[1] = t1[1] + v1[1] * bf_hi(g.z); v1[2] = t1[2] + v1[2] * bf_lo(g.w); v1[3] = t1[3] + v1[3] * bf_hi(g.w);
                    u32x4 w; w.x = cvt_pk_bf16(v0[0], v0[1]); w.y = cvt_pk_bf16(v0[2], v0[3]); w.z = cvt_pk_bf16(v1[0], v1[1]); w.w = cvt_pk_bf16(v1[2], v1[3]);
                    *(u32x4*)(O + (size_t)row * 1024 + col) = w;
                }
                asm volatile("" ::: "memory");
            }
    }
};
struct EpiMerge {
    static constexpr bool PERM = true, AFTER_DRAIN = false, MID = true;
    const bf16_t* G; bf16_t* O;
    __device__ __forceinline__ void mid(f32x4 (&acc)[2][2][4][2], const Unit& u, int wr, int wc, int fr_, int fq_) const {
        int fr = fr_, fq = fq_; asm volatile("" : "+v"(fr), "+v"(fq));
        const int row0 = u.pm * BM + wr * 64 + fr;
#pragma unroll
        for (int ai = 0; ai < 2; ++ai)
#pragma unroll
            for (int m = 0; m < 4; ++m) {
                const int row = row0 + ai * HALF + m * 16;
#pragma unroll
                for (int bj = 0; bj < 2; ++bj) {
                    const int col = u.pn * BM + bj * HALF + wc * 32 + 8 * fq;
                    const u32x4 a = *(const PG8_GAS u32x4*)(G + (size_t)row * 2048 + col), b = *(const PG8_GAS u32x4*)(G + (size_t)row * 2048 + 1024 + col);
#define PG8_RATIO(x, y) ((x) * __builtin_amdgcn_rcpf(fmaxf((y), 1e-30f)))
                    acc[ai][bj][m][0][0] *= PG8_RATIO(bf_lo(a.x), bf_lo(b.x)); acc[ai][bj][m][0][1] *= PG8_RATIO(bf_hi(a.x), bf_hi(b.x));
                    acc[ai][bj][m][0][2] *= PG8_RATIO(bf_lo(a.y), bf_lo(b.y)); acc[ai][bj][m][0][3] *= PG8_RATIO(bf_hi(a.y), bf_hi(b.y));
                    acc[ai][bj][m][1][0] *= PG8_RATIO(bf_lo(a.z), bf_lo(b.z)); acc[ai][bj][m][1][1] *= PG8_RATIO(bf_hi(a.z), bf_hi(b.z));
                    acc[ai][bj][m][1][2] *= PG8_RATIO(bf_lo(a.w), bf_lo(b.w)); acc[ai][bj][m][1][3] *= PG8_RATIO(bf_hi(a.w), bf_hi(b.w));
#undef PG8_RATIO
                }
                asm volatile("" ::: "memory");
            }
    }
    __device__ __forceinline__ void operator()(const f32x4 (&acc)[2][2][4][2], const Unit& u, int wr, int wc, int fr_, int fq_) const {
        int fr = fr_, fq = fq_; asm volatile("" : "+v"(fr), "+v"(fq));
        const int row0 = u.pm * BM + wr * 64 + fr;
#pragma unroll
        for (int ai = 0; ai < 2; ++ai)
#pragma unroll
            for (int m = 0; m < 4; ++m) {
                const int row = row0 + ai * HALF + m * 16;
#pragma unroll
                for (int bj = 0; bj < 2; ++bj) {
                    const int col = u.pn * BM + bj * HALF + wc * 32 + 8 * fq;
                    const u32x4 g = *(const PG8_GAS u32x4*)(G + (size_t)row * 2048 + 1024 + col);
                    f32x4 v0 = acc[ai][bj][m][0], v1 = acc[ai][bj][m][1];
                    v0[0] *= fmaxf(bf_lo(g.x), 1e-30f); v0[1] *= fmaxf(bf_hi(g.x), 1e-30f); v0[2] *= fmaxf(bf_lo(g.y), 1e-30f); v0[3] *= fmaxf(bf_hi(g.y), 1e-30f);
                    v1[0] *= fmaxf(bf_lo(g.z), 1e-30f); v1[1] *= fmaxf(bf_hi(g.z), 1e-30f); v1[2] *= fmaxf(bf_lo(g.w), 1e-30f); v1[3] *= fmaxf(bf_hi(g.w), 1e-30f);
                    u32x4 w; w.x = cvt_pk_bf16(v0[0], v0[1]); w.y = cvt_pk_bf16(v0[2], v0[3]); w.z = cvt_pk_bf16(v1[0], v1[1]); w.w = cvt_pk_bf16(v1[2], v1[3]);
                    *(PG8_GAS u32x4*)(O + (size_t)row * 1024 + col) = w;
                }
                asm volatile("" ::: "memory");
            }
    }
};
struct EpiF32 {
    static constexpr bool PERM = false, AFTER_DRAIN = false, MID = false;
    float* O; int ldc;
    __device__ __forceinline__ void operator()(const f32x4 (&acc)[2][2][4][2], const Unit& u, int wr, int wc, int fr_, int fq_) const {
        int fr = fr_, fq = fq_; asm volatile("" : "+v"(fr), "+v"(fq));
        const int row0 = u.pm * BM + wr * 64 + fr, col0 = u.pn * BM + wc * 32 + 4 * fq;
#pragma unroll
        for (int ai = 0; ai < 2; ++ai)
#pragma unroll
            for (int m = 0; m < 4; ++m) {
                float* rowp = O + (size_t)(row0 + ai * HALF + m * 16) * ldc + col0;
#pragma unroll
                for (int bj = 0; bj < 2; ++bj)
#pragma unroll
                    for (int n = 0; n < 2; ++n) *(f32x4*)(rowp + bj * HALF + n * 16) = acc[ai][bj][m][n];
            }
    }
};
struct EpiRelu2 {
    static constexpr bool PERM = true, AFTER_DRAIN = false, MID = false;
    bf16_t* O; int ldc;
    __device__ __forceinline__ void operator()(const f32x4 (&acc)[2][2][4][2], const Unit& u, int wr, int wc, int fr_, int fq_) const {
        int fr = fr_, fq = fq_; asm volatile("" : "+v"(fr), "+v"(fq));
        const int row0 = u.pm * BM + wr * 64 + fr, col0 = u.pn * BM + wc * 32 + 8 * fq;
#pragma unroll
        for (int ai = 0; ai < 2; ++ai)
#pragma unroll
            for (int m = 0; m < 4; ++m) {
                bf16_t* rowp = O + (size_t)(row0 + ai * HALF + m * 16) * ldc + col0;
#pragma unroll
                for (int bj = 0; bj < 2; ++bj) {
                    f32x4 v0 = acc[ai][bj][m][0], v1 = acc[ai][bj][m][1];
#pragma unroll
                    for (int e = 0; e < 4; ++e) { const float a = fmaxf(v0[e], 0.f), b = fmaxf(v1[e], 0.f); v0[e] = a * a; v1[e] = b * b; }
                    u32x4 w; w.x = cvt_pk_bf16(v0[0], v0[1]); w.y = cvt_pk_bf16(v0[2], v0[3]); w.z = cvt_pk_bf16(v1[0], v1[1]); w.w = cvt_pk_bf16(v1[2], v1[3]);
                    *(PG8_GAS u32x4*)(rowp + bj * HALF) = w;
                }
            }
    }
};


struct EpiBf16P {
    static constexpr bool PERM = true, AFTER_DRAIN = false, MID = false;
    bf16_t* O; int ldc;
    __device__ __forceinline__ void operator()(const f32x4 (&acc)[2][2][4][2], const Unit& u, int wr, int wc, int fr_, int fq_) const {
        int fr = fr_, fq = fq_; asm volatile("" : "+v"(fr), "+v"(fq));
        const int row0 = u.pm * BM + wr * 64 + fr, col0 = u.pn * BM + wc * 32 + 8 * fq;
#pragma unroll
        for (int ai = 0; ai < 2; ++ai)
#pragma unroll
            for (int m = 0; m < 4; ++m) {
                bf16_t* rowp = O + (size_t)(row0 + ai * HALF + m * 16) * ldc + col0;
#pragma unroll
                for (int bj = 0; bj < 2; ++bj) {
                    const f32x4 v0 = acc[ai][bj][m][0], v1 = acc[ai][bj][m][1];
                    u32x4 w; w.x = cvt_pk_bf16(v0[0], v0[1]); w.y = cvt_pk_bf16(v0[2], v0[3]); w.z = cvt_pk_bf16(v1[0], v1[1]); w.w = cvt_pk_bf16(v1[2], v1[3]);
                    *(PG8_GAS u32x4*)(rowp + bj * HALF) = w;
                }
            }
    }
};
template <class Epi, class Sched, bool ALIGN_EPI = false, bool SP2 = false>
__device__ __forceinline__ void gemm_phase(PG8_LAS unsigned char* lds, const Gemm g, const Sched& S, const Epi& E) {
    int tid_ = threadIdx.x; asm volatile("" : "+v"(tid_));
    const int tid = tid_, wid = __builtin_amdgcn_readfirstlane(tid >> 6), lane = tid & 63, wr = wid >> 2, wc = wid & 3, fr = lane & 15, fq = lane >> 4;
    const int K = g.K, nt = K / BK;
    unsigned voffA[2], voffB[2];
#pragma unroll
    for (int i = 0; i < 2; ++i) { int R, C; stage_rc(tid * 16 + i * 8192, R, C); const int Rb = Epi::PERM ? ((R & ~31) + perm32(R & 31)) : R;
        voffA[i] = (unsigned)(R * K + C) * 2u; voffB[i] = (unsigned)(Rb * K + C) * 2u; }
    const size_t kstep = (size_t)(BK * 2);
    const size_t hstep = (size_t)HALF * K * 2;
    const size_t tstep = 2 * hstep;
    const unsigned ldsw = (unsigned)wid * 1024u;
    const int aoff = lds_byte(wr * 64 + fr, fq * 8), boff = lds_byte(wc * 32 + fr, fq * 8);
#define PG8_SA(b, h) (((b) * 2 + (h)) * HTB)
#define PG8_SB(b, h) ((4 + (b) * 2 + (h)) * HTB)
#define PG8_STAGE(bufoff, gbase, voff) do { _Pragma("unroll") for (int _i = 0; _i < 2; ++_i) \
        __builtin_amdgcn_global_load_lds((const unsigned*)((const char*)(gbase) + (voff)[_i]), (PG8_LAS unsigned*)(lds + (bufoff) + ldsw + _i * 8192), 16, 0, 0); } while (0)
#define PG8_LDA(dst, b, h) do { _Pragma("unroll") for (int m = 0; m < 4; ++m) _Pragma("unroll") for (int k = 0; k < 2; ++k) dst[m][k] = *(const PG8_LAS bf16x8*)(lds + PG8_SA(b, h) + aoff + m * 2048 + k * 1024); } while (0)
#define PG8_LDB(dst, b, h) do { _Pragma("unroll") for (int n = 0; n < 2; ++n) _Pragma("unroll") for (int k = 0; k < 2; ++k) dst[n][k] = *(const PG8_LAS bf16x8*)(lds + PG8_SB(b, h) + boff + n * 2048 + k * 1024); } while (0)
#define PG8_MMA(ai, bj, At, Bt) do { __builtin_amdgcn_s_setprio(1); _Pragma("unroll") for (int m = 0; m < 4; ++m) _Pragma("unroll") for (int n = 0; n < 2; ++n) _Pragma("unroll") for (int k = 0; k < 2; ++k) \
        acc[ai][bj][m][n] = __builtin_amdgcn_mfma_f32_16x16x32_bf16(Bt[n][k], At[m][k], acc[ai][bj][m][n], 0, 0, 0); __builtin_amdgcn_s_setprio(0); } while (0)
#define PG8_WAIT_V(n) asm volatile("s_waitcnt vmcnt(" #n ")" ::: "memory")
#define PG8_WAIT_L(n) asm volatile("s_waitcnt lgkmcnt(" #n ")" ::: "memory")
#define PG8_BAR __builtin_amdgcn_s_barrier()
#define PG8_SCHED __builtin_amdgcn_sched_barrier(0)
    Unit cur, nxt; int ui = 0;
    if (!S.next(0, cur)) return;
    f32x4 acc[2][2][4][2];
#pragma unroll
    for (int a = 0; a < 2; ++a)
#pragma unroll
        for (int b = 0; b < 2; ++b)
#pragma unroll
            for (int m = 0; m < 4; ++m)
#pragma unroll
                for (int n = 0; n < 2; ++n) acc[a][b][m][n] = (f32x4){0.f, 0.f, 0.f, 0.f};
    bf16x8 At[4][2], B0[2][2], B1[2][2];
    const char* cA = (const char*)g.A + (size_t)cur.pm * tstep; const char* cB = (const char*)g.Bt + (size_t)cur.pn * tstep;
    S.a_ready(cur);
    if constexpr (SP2) {
        PG8_STAGE(PG8_SB(0, 0), cB, voffB); PG8_STAGE(PG8_SB(0, 1), cB + hstep, voffB); PG8_STAGE(PG8_SA(0, 0), cA, voffA); PG8_STAGE(PG8_SA(0, 1), cA + hstep, voffA);
        if (wr == 1) PG8_BAR;
        PG8_WAIT_V(2); PG8_BAR;
        PG8_STAGE(PG8_SB(1, 0), cB + kstep, voffB); PG8_STAGE(PG8_SA(1, 0), cA + kstep, voffA); PG8_STAGE(PG8_SB(1, 1), cB + hstep + kstep, voffB);
        PG8_WAIT_V(6); PG8_BAR;
    } else {
        PG8_STAGE(PG8_SB(0, 0), cB, voffB); PG8_STAGE(PG8_SA(0, 0), cA, voffA); PG8_STAGE(PG8_SB(0, 1), cB + hstep, voffB); PG8_STAGE(PG8_SA(0, 1), cA + hstep, voffA);
        if (wr == 1) PG8_BAR;
        PG8_WAIT_V(4); PG8_BAR;
        PG8_STAGE(PG8_SB(1, 0), cB + kstep, voffB); PG8_STAGE(PG8_SA(1, 0), cA + kstep, voffA); PG8_STAGE(PG8_SB(1, 1), cB + hstep + kstep, voffB);
        PG8_WAIT_V(6); PG8_BAR;
    }
    for (;;) {
        const bool has_next = S.next(ui + 1, nxt);
        const char* nA = has_next ? (const char*)g.A + (size_t)nxt.pm * tstep : cA; const char* nB = has_next ? (const char*)g.Bt + (size_t)nxt.pn * tstep : cB;
        for (int t = 0; t < nt; t += 2) {
            if constexpr (Epi::MID) { if (t == (nt >> 1)) E.mid(acc, cur, wr, wc, fr, fq); }
            const bool last = (t == nt - 2);
            const char* a1 = cA + (size_t)(t + 1) * kstep;
            const char* a2 = last ? nA : cA + (size_t)(t + 2) * kstep; const char* b2 = last ? nB : cB + (size_t)(t + 2) * kstep;
            const char* a3 = a2 + kstep; const char* b3 = b2 + kstep;
            if (last && has_next) S.a_ready(nxt);
            if constexpr (SP2) {
            PG8_LDB(B0, 0, 0); PG8_LDB(B1, 0, 1); PG8_SCHED; PG8_LDA(At, 0, 0); PG8_STAGE(PG8_SA(1, 1), a1 + hstep, voffA);
            PG8_WAIT_V(8); PG8_WAIT_L(0); PG8_BAR; PG8_MMA(0, 0, At, B0); PG8_MMA(0, 1, At, B1); PG8_BAR; PG8_SCHED;
            PG8_LDA(At, 0, 1); PG8_STAGE(PG8_SB(0, 0), b2, voffB); PG8_STAGE(PG8_SB(0, 1), b2 + hstep, voffB); PG8_STAGE(PG8_SA(0, 0), a2, voffA);
            PG8_WAIT_V(8); PG8_WAIT_L(0); PG8_BAR; PG8_MMA(1, 0, At, B0); PG8_MMA(1, 1, At, B1); PG8_BAR; PG8_SCHED;
            PG8_LDB(B0, 1, 0); PG8_LDB(B1, 1, 1); PG8_SCHED; PG8_LDA(At, 1, 0); PG8_STAGE(PG8_SA(0, 1), a2 + hstep, voffA);
            PG8_WAIT_V(8); PG8_WAIT_L(0); PG8_BAR; PG8_MMA(0, 0, At, B0); PG8_MMA(0, 1, At, B1); PG8_BAR; PG8_SCHED;
            PG8_LDA(At, 1, 1); PG8_STAGE(PG8_SB(1, 0), b3, voffB); PG8_STAGE(PG8_SB(1, 1), b3 + hstep, voffB); PG8_STAGE(PG8_SA(1, 0), a3, voffA);
            PG8_WAIT_V(8); PG8_WAIT_L(0); PG8_BAR; PG8_MMA(1, 0, At, B0); PG8_MMA(1, 1, At, B1); PG8_BAR; PG8_SCHED;
            } else {
            PG8_LDB(B0, 0, 0); PG8_SCHED; PG8_LDA(At, 0, 0); PG8_STAGE(PG8_SA(1, 1), a1 + hstep, voffA);
            PG8_WAIT_L(8); PG8_BAR; PG8_WAIT_L(0); PG8_MMA(0, 0, At, B0); PG8_BAR; PG8_SCHED;
            PG8_LDB(B1, 0, 1); PG8_STAGE(PG8_SB(0, 0), b2, voffB);
            PG8_BAR; PG8_WAIT_L(0); PG8_MMA(0, 1, At, B1); PG8_BAR;
            PG8_LDA(At, 0, 1); PG8_STAGE(PG8_SA(0, 0), a2, voffA);
            PG8_BAR; PG8_WAIT_L(0); PG8_MMA(1, 0, At, B0); PG8_BAR; PG8_SCHED;
            PG8_STAGE(PG8_SB(0, 1), b2 + hstep, voffB);
            PG8_WAIT_V(6); PG8_BAR; PG8_MMA(1, 1, At, B1); PG8_BAR;
            PG8_LDB(B0, 1, 0); PG8_SCHED; PG8_LDA(At, 1, 0); PG8_STAGE(PG8_SA(0, 1), a2 + hstep, voffA);
            PG8_WAIT_L(8); PG8_BAR; PG8_WAIT_L(0); PG8_MMA(0, 0, At, B0); PG8_BAR; PG8_SCHED;
            PG8_LDB(B1, 1, 1); PG8_STAGE(PG8_SB(1, 0), b3, voffB);
            PG8_BAR; PG8_WAIT_L(0); PG8_MMA(0, 1, At, B1); PG8_BAR;
            PG8_LDA(At, 1, 1); PG8_STAGE(PG8_SA(1, 0), a3, voffA);
            PG8_BAR; PG8_WAIT_L(0); PG8_MMA(1, 0, At, B0); PG8_BAR; PG8_SCHED;
            PG8_STAGE(PG8_SB(1, 1), b3 + hstep, voffB);
            PG8_WAIT_V(6); PG8_BAR; PG8_MMA(1, 1, At, B1); PG8_BAR;
            }
        }
        if constexpr (ALIGN_EPI) { if (wr == 0) PG8_BAR; }
        if constexpr (!Epi::AFTER_DRAIN) { E(acc, cur, wr, wc, fr, fq); S.done(cur); }
        if (!has_next) break;
#pragma unroll
        for (int a = 0; a < 2; ++a)
#pragma unroll
            for (int b = 0; b < 2; ++b)
#pragma unroll
                for (int m = 0; m < 4; ++m)
#pragma unroll
                    for (int n = 0; n < 2; ++n) acc[a][b][m][n] = (f32x4){0.f, 0.f, 0.f, 0.f};
        cur = nxt; cA = nA; cB = nB; ++ui;
        if constexpr (ALIGN_EPI) { if (wr == 1) PG8_BAR; }
    }
    PG8_WAIT_V(0);
    if constexpr (!ALIGN_EPI) { if (wr == 0) PG8_BAR; }
    PG8_BAR;
    if constexpr (Epi::AFTER_DRAIN) { E.fused(acc, cur, wr, wc, fr, fq, lds, wid, lane); S.done(cur); }
#undef PG8_SA
#undef PG8_SB
#undef PG8_STAGE
#undef PG8_LDA
#undef PG8_LDB
#undef PG8_MMA
#undef PG8_WAIT_V
#undef PG8_WAIT_L
#undef PG8_BAR
#undef PG8_SCHED
}
}

constexpr int D_MODEL = 1024, BATCH = 2, SEQ = 8192, DEPTH = 4, M = BATCH * SEQ;
constexpr int CONV_W = 512, NHEAD = 4, HEAD_DIM = 64, V_DIM = 128, ATTN_W = 512, D_FF = 4096, IN_W = 5120;
constexpr float EPS = 1e-6f;
constexpr float LOG2E = 1.4426950408889634f;

#define LAS __attribute__((address_space(3)))
#define GAS __attribute__((address_space(1)))
typedef unsigned short bf16;
typedef short bf16x8 __attribute__((ext_vector_type(8)));
typedef short s16x4 __attribute__((ext_vector_type(4)));
typedef float f32x4 __attribute__((ext_vector_type(4)));
typedef float f32x16 __attribute__((ext_vector_type(16)));
typedef unsigned u32x4 __attribute__((ext_vector_type(4)));
typedef unsigned u32x2 __attribute__((ext_vector_type(2)));

constexpr size_t MiB = 1u << 20;
constexpr size_t WS_CTL = 0;
constexpr size_t WS_W = 1 * MiB;
constexpr size_t W_IN_OFF = 0, W_CO_OFF = W_IN_OFF + (size_t)IN_W * D_MODEL * 2, W_AO_OFF = W_CO_OFF + (size_t)D_MODEL * CONV_W * 2,
                 W_O_OFF = W_AO_OFF + (size_t)D_MODEL * ATTN_W * 2, W_F1_OFF = W_O_OFF + (size_t)D_MODEL * D_MODEL * 2,
                 W_F2_OFF = W_F1_OFF + (size_t)D_FF * D_MODEL * 2, W_END_OFF = W_F2_OFF + (size_t)D_MODEL * D_FF * 2;
static_assert(WS_W + W_END_OFF <= 32 * MiB, "weights region");
constexpr size_t WS_U = 32 * MiB;
constexpr size_t WS_CONV = 64 * MiB;
constexpr size_t WS_Q = 112 * MiB;
constexpr size_t WS_K = 128 * MiB;
constexpr size_t WS_V = 144 * MiB;
constexpr size_t WS_G = 160 * MiB;
constexpr size_t WS_Z = 224 * MiB;
constexpr size_t WS_ON = 240 * MiB;
constexpr size_t WS_T = 64 * MiB;
constexpr size_t WS_MO = 128 * MiB;
constexpr size_t WS_A = 64 * MiB;
constexpr size_t WS_F = 192 * MiB;
constexpr size_t WS_END = 256 * MiB;

constexpr int LDS_BYTES = 135168;

__device__ __forceinline__ float wave_sum(float v) {
#pragma unroll
    for (int o = 1; o < 64; o <<= 1) v += __shfl_xor(v, o);
    return v;
}
__device__ __forceinline__ unsigned f2bf(float f) { unsigned u = __builtin_bit_cast(unsigned, f); return (u + 0x7fffu + ((u >> 16) & 1u)) >> 16; }
__device__ __forceinline__ unsigned pk2(float lo, float hi) { return f2bf(lo) | (f2bf(hi) << 16); }
__device__ __forceinline__ float bflo(unsigned w) { return __uint_as_float(w << 16); }
__device__ __forceinline__ float bfhi(unsigned w) { return __uint_as_float(w & 0xffff0000u); }

__device__ __forceinline__ void transpose_item(const float* W, int K, int N, bf16* WT, LAS float* scr, int item, int lane, int ldk = 0) {
    if (ldk == 0) ldk = K;
    const int nblk = N / 64, kb = item / nblk, nb = item % nblk, k0 = 32 * kb, n0 = 64 * nb;
    const int n4 = (lane & 15) * 4, kr = lane >> 4;
    f32x4 v[8];
#pragma unroll
    for (int i = 0; i < 8; ++i) v[i] = *(const GAS f32x4*)(W + (size_t)(k0 + kr + 4 * i) * N + n0 + n4);
#pragma unroll
    for (int i = 0; i < 8; ++i) { LAS float* s = scr + (kr + 4 * i) * 66 + n4; typedef float f32x2v __attribute__((ext_vector_type(2)));
        *(LAS f32x2v*)s = (f32x2v){v[i].x, v[i].y}; *(LAS f32x2v*)(s + 2) = (f32x2v){v[i].z, v[i].w}; }
    asm volatile("s_waitcnt lgkmcnt(0)" ::: "memory");
    const int c = lane >> 4;
#pragma unroll
    for (int j = 0; j < 4; ++j) { const int n = (lane & 15) + 16 * j; const LAS float* s = scr + (8 * c) * 66 + n;
        u32x4 o; o.x = pk2(s[0 * 66], s[1 * 66]); o.y = pk2(s[2 * 66], s[3 * 66]); o.z = pk2(s[4 * 66], s[5 * 66]); o.w = pk2(s[6 * 66], s[7 * 66]);
        *(GAS u32x4*)(WT + (size_t)(n0 + n) * ldk + k0 + 8 * c) = o; }
    asm volatile("s_waitcnt lgkmcnt(0)" ::: "memory");
}

struct Args { const float* in[12]; float* out; unsigned char* ws; int ph_lo, ph_hi; };

__device__ __forceinline__ void convert_weights(const Args& a, int l, LAS unsigned char* lds, int gw, int NGW, int wave, int lane) {
    LAS float* scr = (LAS float*)(lds + wave * 16384);
    bf16* wb = (bf16*)(a.ws + WS_W);
    constexpr int I_IN = (D_MODEL / 32) * (IN_W / 64), I_CO = (CONV_W / 32) * (D_MODEL / 64), I_AO = (ATTN_W / 32) * (D_MODEL / 64),
                  I_O = (D_MODEL / 32) * (D_MODEL / 64), I_F1 = (D_MODEL / 32) * (D_FF / 64), I_F2 = (D_FF / 32) * (D_MODEL / 64);
    constexpr int NITEMS = I_IN + I_CO + I_AO + I_O + I_F1 + I_F2;
    const float* w_in = a.in[1] + (size_t)l * D_MODEL * IN_W;
    const float* w_co = a.in[4] + (size_t)l * CONV_W * D_MODEL;
    const float* w_ao = a.in[7] + (size_t)l * ATTN_W * D_MODEL;
    const float* w_o = a.in[8] + (size_t)l * D_MODEL * D_MODEL;
    const float* w_f1 = a.in[10] + (size_t)l * D_MODEL * D_FF;
    const float* w_f2 = a.in[11] + (size_t)l * D_FF * D_MODEL;
    for (int it = gw; it < NITEMS; it += NGW) {
        int r = it;
        if (r < I_IN) { transpose_item(w_in, D_MODEL, IN_W, (bf16*)((unsigned char*)wb + W_IN_OFF), scr, r, lane); continue; } r -= I_IN;
        if (r < I_CO) { transpose_item(w_co, CONV_W, D_MODEL, (bf16*)((unsigned char*)wb + W_CO_OFF), scr, r, lane, CONV_W + ATTN_W); continue; } r -= I_CO;
        if (r < I_AO) { transpose_item(w_ao, ATTN_W, D_MODEL, (bf16*)((unsigned char*)wb + W_CO_OFF) + CONV_W, scr, r, lane, CONV_W + ATTN_W); continue; } r -= I_AO;
        if (r < I_O) { transpose_item(w_o, D_MODEL, D_MODEL, (bf16*)((unsigned char*)wb + W_O_OFF), scr, r, lane); continue; } r -= I_O;
        if (r < I_F1) { transpose_item(w_f1, D_MODEL, D_FF, (bf16*)((unsigned char*)wb + W_F1_OFF), scr, r, lane); continue; } r -= I_F1;
        transpose_item(w_f2, D_FF, D_MODEL, (bf16*)((unsigned char*)wb + W_F2_OFF), scr, r, lane);
    }
}

template <bool ADD, bool NORM>
__device__ __forceinline__ void row_phase(const float* hin, const bf16* F, const float* gA, float* hout, const float* gB, bf16* U, int gw, int NGW, int lane) {
    f32x4 ga[4], gb[4];
#pragma unroll
    for (int j = 0; j < 4; ++j) { ga[j] = ADD ? ((const GAS f32x4*)gA)[lane + 64 * j] : (f32x4){0.f, 0.f, 0.f, 0.f}; gb[j] = NORM ? ((const GAS f32x4*)gB)[lane + 64 * j] : (f32x4){0.f, 0.f, 0.f, 0.f}; }
    for (int m = gw; m < M; m += NGW) {
        f32x4 v[4];
#pragma unroll
        for (int j = 0; j < 4; ++j) v[j] = ((const GAS f32x4*)(hin + (size_t)m * D_MODEL))[lane + 64 * j];
        if (ADD) {
            f32x4 f[4]; float ss = 0.f;
#pragma unroll
            for (int j = 0; j < 4; ++j) { const u32x2 w = ((const GAS u32x2*)(F + (size_t)m * D_MODEL))[lane + 64 * j]; f[j] = (f32x4){bflo(w.x), bfhi(w.x), bflo(w.y), bfhi(w.y)}; ss += (f[j].x * f[j].x + f[j].y * f[j].y) + (f[j].z * f[j].z + f[j].w * f[j].w); }
            const float r = 1.0f / sqrtf(wave_sum(ss) * (1.0f / D_MODEL) + EPS);
#pragma unroll
            for (int j = 0; j < 4; ++j) v[j] = v[j] + f[j] * r * ga[j];
        }
#pragma unroll
        for (int j = 0; j < 4; ++j) ((GAS f32x4*)(hout + (size_t)m * D_MODEL))[lane + 64 * j] = v[j];
        if (NORM) {
            float ss = 0.f;
#pragma unroll
            for (int j = 0; j < 4; ++j) ss += (v[j].x * v[j].x + v[j].y * v[j].y) + (v[j].z * v[j].z + v[j].w * v[j].w);
            const float r = 1.0f / sqrtf(wave_sum(ss) * (1.0f / D_MODEL) + EPS);
            GAS u32x2* o8 = (GAS u32x2*)(U + (size_t)m * D_MODEL) + lane;
#pragma unroll
            for (int j = 0; j < 4; ++j) { const f32x4 y = v[j] * r * gb[j]; u32x2 w; w.x = pk2(y.x, y.y); w.y = pk2(y.z, y.w); o8[64 * j] = w; }
        }
    }
}

__device__ __forceinline__ void conv_items(const bf16* CONV, const float* cw, bf16* Z, int it_begin, int it_end, int it_stride, int lane) {
    const int c = lane * 8;
    float w0[8], w1[8], w2[8];
#pragma unroll
    for (int e = 0; e < 8; ++e) { w0[e] = cw[c + e]; w1[e] = cw[CONV_W + c + e]; w2[e] = cw[2 * CONV_W + c + e]; }
    for (int it = it_begin; it < it_end; it += it_stride) {
        const int t0 = it * 8, s0 = t0 & (SEQ - 1);
        float prev[8], cur[8], nxt[8];
#define INNER(dst, t) do { const u32x4 hh = *(const GAS u32x4*)(CONV + (size_t)(t) * 1536 + c), cc = *(const GAS u32x4*)(CONV + (size_t)(t) * 1536 + 1024 + c); \
            dst[0] = bflo(hh.x) * bflo(cc.x); dst[1] = bfhi(hh.x) * bfhi(cc.x); dst[2] = bflo(hh.y) * bflo(cc.y); dst[3] = bfhi(hh.y) * bfhi(cc.y); \
            dst[4] = bflo(hh.z) * bflo(cc.z); dst[5] = bfhi(hh.z) * bfhi(cc.z); dst[6] = bflo(hh.w) * bflo(cc.w); dst[7] = bfhi(hh.w) * bfhi(cc.w); } while (0)
        if (s0 > 0) { INNER(prev, t0 - 1); } else {
#pragma unroll
            for (int e = 0; e < 8; ++e) prev[e] = 0.f; }
        INNER(cur, t0);
#pragma unroll
        for (int j = 0; j < 8; ++j) {
            const int t = t0 + j;
            if (s0 + j + 1 < SEQ) { INNER(nxt, t + 1); } else {
#pragma unroll
                for (int e = 0; e < 8; ++e) nxt[e] = 0.f; }
            const u32x4 bb = *(const GAS u32x4*)(CONV + (size_t)t * 1536 + 512 + c);
            float z[8];
#pragma unroll
            for (int e = 0; e < 8; ++e) z[e] = prev[e] * w0[e] + cur[e] * w1[e] + nxt[e] * w2[e];
            z[0] *= bflo(bb.x); z[1] *= bfhi(bb.x); z[2] *= bflo(bb.y); z[3] *= bfhi(bb.y); z[4] *= bflo(bb.z); z[5] *= bfhi(bb.z); z[6] *= bflo(bb.w); z[7] *= bfhi(bb.w);
            u32x4 o; o.x = pk2(z[0], z[1]); o.y = pk2(z[2], z[3]); o.z = pk2(z[4], z[5]); o.w = pk2(z[6], z[7]);
            *(GAS u32x4*)(Z + (size_t)t * (CONV_W + ATTN_W) + c) = o;
#pragma unroll
            for (int e = 0; e < 8; ++e) { prev[e] = cur[e]; cur[e] = nxt[e]; }
        }
#undef INNER
    }
}

__device__ __forceinline__ int crow(int r, int hi) { return (r & 3) + 8 * (r >> 2) + 4 * hi; }
typedef float f32x2_t __attribute__((ext_vector_type(2))); typedef __bf16 bf16x2_t __attribute__((ext_vector_type(2)));
__device__ __forceinline__ unsigned cvtpk(float lo, float hi) { f32x2_t v = {lo, hi}; bf16x2_t b = __builtin_convertvector(v, bf16x2_t); return __builtin_bit_cast(unsigned, b); }
typedef short v4i16_t __attribute__((ext_vector_type(4)));
__device__ __forceinline__ s16x4 vtr(const LAS unsigned char* p) { return __builtin_bit_cast(s16x4, __builtin_amdgcn_ds_read_tr16_b64_v4i16((LAS v4i16_t*)p)); }
constexpr float ATT_T = 24.0f, ATT_THR = 8.0f;
constexpr float ATT_NOCHK = 64.0f;
#ifndef DIAG
#define DIAG 0
#endif
#ifndef DIAG_LIGHT
#define DIAG_LIGHT 0
#endif
#ifndef DIAG_WAVE
#define DIAG_WAVE 0
#endif
#ifndef DIAG_SCALE
#define DIAG_SCALE 0.01f
#endif
#ifndef DIAG_SEL
#define DIAG_SEL 0
#endif
__device__ __forceinline__ void glds16(const void* gsrc, unsigned lds_dst) { unsigned keep;
    asm volatile("s_mov_b32 %0, m0\n\ts_mov_b32 m0, %2\n\ts_nop 0\n\tglobal_load_lds_dwordx4 %1, off\n\ts_mov_b32 m0, %0" : "=&s"(keep) : "v"(gsrc), "s"(lds_dst) : "memory"); }
#define MFMA32(a, b, c) __builtin_amdgcn_mfma_f32_32x32x16_bf16((a), (b), (c), 0, 0, 0)

__device__ __forceinline__ void attn_unit(int b, int h, int qb, float kn0, float kn1, const bf16* Q, const bf16* Kt, const bf16* Vt, bf16* ON, LAS unsigned char* lds,
                                          float slope2, const float* subg, float post) {
    int tid_ = threadIdx.x; asm volatile("" : "+v"(tid_));
    const int tid = tid_, lane = tid & 63, r = lane & 31, hi = lane >> 5;
    const int wid = __builtin_amdgcn_readfirstlane(tid >> 6), map = wid >> 2, qs = wid & 3;
    const int q0 = qb * 128 + qs * 32;
    const size_t tokbase = (size_t)b * SEQ;
    bf16x8 qf[4];
    { const bf16* qp = Q + (tokbase + q0 + r) * ATTN_W + h * 128 + map * 64 + hi * 8;
#pragma unroll
      for (int ks = 0; ks < 4; ++ks) qf[ks] = *(const GAS bf16x8*)(qp + ks * 16); }
    const unsigned char* ktg = (const unsigned char*)Kt + (size_t)((b * 4 + h) * 128) * 16384 + wid * 1024 + lane * 16;
    const unsigned char* vtg = (const unsigned char*)Vt + (size_t)((b * 4 + h) * 128) * 16384 + wid * 1024 + lane * 16;
    const unsigned lds0 = (unsigned)(uintptr_t)lds;
#define ISSUE(t, buf) do { const size_t go_ = (size_t)(t) * 16384; const unsigned lb_ = (unsigned)__builtin_amdgcn_readfirstlane(lds0 + (buf) * 32768 + wid * 1024); \
        glds16(ktg + go_, lb_); glds16(ktg + go_ + 8192, lb_ + 8192); glds16(vtg + go_, lb_ + 16384); glds16(vtg + go_ + 8192, lb_ + 16384 + 8192); } while (0)
    f32x16 o[4];
#pragma unroll
    for (int cb = 0; cb < 4; ++cb)
#pragma unroll
        for (int i = 0; i < 16; ++i) o[cb][i] = 0.f;
    float mrun = -1e30f, lsum = 0.f;
    LAS float* wsf = (LAS float*)(lds + 131072 + 256) + wid * 64;
    const LAS unsigned char* kfb = lds + (map * 8 + hi) * 1024 + r * 16;
    const LAS unsigned char* vfb = lds + 16384 + (4 * hi + ((lane & 15) >> 2)) * 64 + ((lane >> 4) & 1) * 32 + (lane & 3) * 8;
    const unsigned vfa = (unsigned)(uintptr_t)vfb;
    const int td0 = 2 * qb; int t_lo = 0, t_hi = 0;
#define TILE_OF(n) ((n) < 2 ? td0 + (n) : ((t_lo + (n) - 2) >= td0 ? t_lo + (n) : t_lo + (n) - 2))
    bf16x8 pk[4];
    const unsigned himask = hi ? 0u : 0xffffffffu;
    bf16x8 kc0, kc1;
    { const unsigned one = 0x3f80u, k0b = f2bf((float)r), k1b = f2bf((float)(32 + r));
      u32x4 w; w.x = (k0b | (k0b << 16)) & himask; w.y = (k0b | (one << 16)) & himask; w.z = (one | (one << 16)) & himask; w.w = 0u; kc0 = __builtin_bit_cast(bf16x8, w);
      w.x = (k1b | (k1b << 16)) & himask; w.y = (k1b | (one << 16)) & himask; kc1 = __builtin_bit_cast(bf16x8, w); }
    unsigned sl12, sl3;
    { const unsigned s1 = f2bf(slope2); const float f1 = __uint_as_float(s1 << 16); const unsigned s2 = f2bf(slope2 - f1); const float f2 = __uint_as_float(s2 << 16); const unsigned s3 = f2bf(slope2 - f1 - f2);
      sl12 = s1 | (s2 << 16); sl3 = s3; }
    ISSUE(TILE_OF(0), 0);
    ISSUE(TILE_OF(1), 1);
    asm volatile("" : "+v"(qf[0]), "+v"(qf[1]), "+v"(qf[2]), "+v"(qf[3]));
    bool nocheck;
    { float qs2 = 0.f;
#pragma unroll
      for (int ks = 0; ks < 4; ++ks)
#pragma unroll
          for (int j = 0; j < 8; ++j) { const float v = __uint_as_float((unsigned)(unsigned short)qf[ks][j] << 16); qs2 += v * v; }
      qs2 += __shfl_xor(qs2, 32);
#pragma unroll
      for (int sft = 1; sft < 32; sft <<= 1) qs2 = fmaxf(qs2, __shfl_xor(qs2, sft));
      LAS float* wsq = (LAS float*)(lds + 131072 + 256 + 2048 + 64);
      if (lane == 0) wsq[wid] = qs2;
      __syncthreads();
      const float qm0 = fmaxf(fmaxf(wsq[0], wsq[1]), fmaxf(wsq[2], wsq[3])), qm1 = fmaxf(fmaxf(wsq[4], wsq[5]), fmaxf(wsq[6], wsq[7]));
      const float Bb = 2.04f * fmaxf(sqrtf(qm0 * kn0), sqrtf(qm1 * kn1));
      const float Wf = (Bb + ATT_T) / slope2;
      const int W = Wf < 16384.f ? (int)Wf + 1 : 16384;
      const int q0b = qb * 128;
      t_lo = (q0b - W) >> 6; if (t_lo < 0) t_lo = 0;
      t_hi = ((q0b + 127 + W) >> 6) + 1; if (t_hi > SEQ / 64) t_hi = SEQ / 64;
      t_lo = __builtin_amdgcn_readfirstlane(t_lo); t_hi = __builtin_amdgcn_readfirstlane(t_hi);
      nocheck = Bb <= ATT_NOCHK; }
    const int NT = t_hi - t_lo;
    asm volatile("s_waitcnt vmcnt(0)\n\ts_barrier" ::: "memory");
    unsigned tacc_ = 0, t0_ = 0;
    if (DIAG && DIAG_SEL == 0) t0_ = (unsigned)clock64();
#define STEP_END(ms_) do { if ((ms_) + 2 < NT) asm volatile("s_waitcnt vmcnt(4) lgkmcnt(0)\n\ts_barrier" ::: "memory");     \
                           else asm volatile("s_waitcnt vmcnt(0) lgkmcnt(0)\n\ts_barrier" ::: "memory"); } while (0)
    if (wid < 8) {
        const int n_plain = nocheck ? 2 : NT;
        for (int ms = 0; ms < n_plain; ++ms) {
            const int msx = ms < 2 ? (ms ^ (qs >> 1)) : ms;
            const int t = TILE_OF(msx), cur = msx & 3;
            if (DIAG && DIAG_SEL == 1) t0_ = (unsigned)clock64();
            {
        const LAS unsigned char* kc = kfb + cur * 32768;
#undef KA
#define KA(ks, kb) (*(const LAS bf16x8*)(kc + (ks) * 2048 + (kb) * 512))
        f32x16 p0, p1; float alpha = 1.0f;
        if (ms < 1) {
#pragma unroll
            for (int i = 0; i < 16; ++i) { p0[i] = 0.f; p1[i] = 0.f; }
#pragma unroll
            for (int kh = 0; kh < 2; ++kh) { const bf16x8 k00 = KA(2 * kh, 0), k01 = KA(2 * kh, 1), k10 = KA(2 * kh + 1, 0), k11 = KA(2 * kh + 1, 1);
                p0 = MFMA32(k00, qf[2 * kh], p0); p1 = MFMA32(k01, qf[2 * kh], p1); p0 = MFMA32(k10, qf[2 * kh + 1], p0); p1 = MFMA32(k11, qf[2 * kh + 1], p1); }
            const float dq = (float)(q0 + r - t * 64 - 4 * hi);
            float tmax = -1e30f;
#pragma unroll
            for (int i = 0; i < 16; ++i) {
                const float c0 = (float)((i & 3) + 8 * (i >> 2));
                p0[i] = __builtin_fmaf(-slope2, __builtin_fabsf(dq - c0), p0[i]);
                p1[i] = __builtin_fmaf(-slope2, __builtin_fabsf(dq - (c0 + 32.f)), p1[i]);
                tmax = fmaxf(tmax, fmaxf(p0[i], p1[i]));
            }
            tmax = fmaxf(tmax, __shfl_xor(tmax, 32));
            const float mnew = fmaxf(mrun, tmax); alpha = __builtin_amdgcn_exp2f(mrun - mnew); mrun = mnew;
#pragma unroll
            for (int i = 0; i < 16; ++i) { p0[i] -= mrun; p1[i] -= mrun; }
        } else {
            const bool right = t > (q0 >> 6);
            const float xq = (float)(q0 + r - 64 * t), ss2 = right ? -slope2 : slope2;
            const float A0 = -ss2 * xq - mrun;
            bf16x8 qx;
            { const unsigned u1 = cvtpk(A0, 0.f) & 0xffffu; const float r1 = A0 - __uint_as_float(u1 << 16);
              const unsigned u2 = cvtpk(r1, 0.f) & 0xffffu; const float r2 = r1 - __uint_as_float(u2 << 16);
              const unsigned u3 = cvtpk(r2, 0.f) & 0xffffu;
              const unsigned sgnm = right ? 0x80008000u : 0u;
              u32x4 w; w.x = (sl12 ^ sgnm) & himask; w.y = (((sl3 ^ sgnm) & 0xffffu) | (u1 << 16)) & himask; w.z = (u2 | (u3 << 16)) & himask; w.w = 0u;
              qx = __builtin_bit_cast(bf16x8, w); }
#pragma unroll
            for (int i = 0; i < 16; ++i) { p0[i] = 0.f; p1[i] = 0.f; }
            p0 = MFMA32(kc0, qx, p0); p1 = MFMA32(kc1, qx, p1);
#pragma unroll
            for (int kh = 0; kh < 2; ++kh) { const bf16x8 k00 = KA(2 * kh, 0), k01 = KA(2 * kh, 1), k10 = KA(2 * kh + 1, 0), k11 = KA(2 * kh + 1, 1);
                p0 = MFMA32(k00, qf[2 * kh], p0); p1 = MFMA32(k01, qf[2 * kh], p1); p0 = MFMA32(k10, qf[2 * kh + 1], p0); p1 = MFMA32(k11, qf[2 * kh + 1], p1); }
            if (!nocheck) {
            float ma = __builtin_fmaxf(__builtin_fmaxf(p0[0], p0[1]), p1[0]), mb = __builtin_fmaxf(__builtin_fmaxf(p0[2], p0[3]), p1[1]);
            ma = __builtin_fmaxf(__builtin_fmaxf(ma, p1[2]), p1[3]);
#pragma unroll
            for (int i = 4; i < 16; i += 4) { ma = __builtin_fmaxf(__builtin_fmaxf(ma, p0[i]), p0[i + 1]); mb = __builtin_fmaxf(__builtin_fmaxf(mb, p0[i + 2]), p0[i + 3]);
                ma = __builtin_fmaxf(__builtin_fmaxf(ma, p1[i]), p1[i + 1]); mb = __builtin_fmaxf(__builtin_fmaxf(mb, p1[i + 2]), p1[i + 3]); }
            float tm = __builtin_fmaxf(ma, mb);
            { auto rr = __builtin_amdgcn_permlane32_swap(__float_as_uint(tm), __float_as_uint(tm), false, false); tm = __builtin_fmaxf(__uint_as_float(rr[0]), __uint_as_float(rr[1])); }
            if (__builtin_expect(__any(tm > ATT_THR), 0)) {
                const float dl = __builtin_fmaxf(tm, 0.f); alpha = __builtin_amdgcn_exp2f(-dl); mrun += dl;
#pragma unroll
                for (int i = 0; i < 16; ++i) { p0[i] -= dl; p1[i] -= dl; }
            }
            }
        }
        if (ms > 0 && __any(alpha != 1.0f)) {
            lsum *= alpha;
            if (hi == 0) wsf[r] = alpha;
            asm volatile("s_waitcnt lgkmcnt(0)" ::: "memory");
#pragma unroll
            for (int i = 0; i < 16; ++i) { const float ai = wsf[crow(i, hi)];
#pragma unroll
                for (int cb = 0; cb < 4; ++cb) asm volatile("v_mul_f32 %0, %0, %1" : "+v"(o[cb][i]) : "v"(ai)); }
            asm volatile("s_waitcnt lgkmcnt(0)" ::: "memory");
        }
#pragma unroll
        for (int i = 0; i < 16; ++i) { p0[i] = __builtin_amdgcn_exp2f(p0[i]); p1[i] = __builtin_amdgcn_exp2f(p1[i]); }
        { u32x4 w; float l0 = 0.f, l1 = 0.f, l2 = 0.f, l3 = 0.f;
#define DOT1(acc, x) do { const unsigned x_ = (x); acc = __builtin_amdgcn_fdot2_f32_bf16(__builtin_bit_cast(bf16x2_t, x_), __builtin_bit_cast(bf16x2_t, 0x3f803f80u), acc, false); } while (0)
          w.x = cvtpk(p0[0], p0[1]); w.y = cvtpk(p0[2], p0[3]); w.z = cvtpk(p0[4], p0[5]); w.w = cvtpk(p0[6], p0[7]); pk[0] = __builtin_bit_cast(bf16x8, w); DOT1(l0, w.x); DOT1(l1, w.y); DOT1(l2, w.z); DOT1(l3, w.w);
          w.x = cvtpk(p0[8], p0[9]); w.y = cvtpk(p0[10], p0[11]); w.z = cvtpk(p0[12], p0[13]); w.w = cvtpk(p0[14], p0[15]); pk[1] = __builtin_bit_cast(bf16x8, w); DOT1(l0, w.x); DOT1(l1, w.y); DOT1(l2, w.z); DOT1(l3, w.w);
          w.x = cvtpk(p1[0], p1[1]); w.y = cvtpk(p1[2], p1[3]); w.z = cvtpk(p1[4], p1[5]); w.w = cvtpk(p1[6], p1[7]); pk[2] = __builtin_bit_cast(bf16x8, w); DOT1(l0, w.x); DOT1(l1, w.y); DOT1(l2, w.z); DOT1(l3, w.w);
          w.x = cvtpk(p1[8], p1[9]); w.y = cvtpk(p1[10], p1[11]); w.z = cvtpk(p1[12], p1[13]); w.w = cvtpk(p1[14], p1[15]); pk[3] = __builtin_bit_cast(bf16x8, w); DOT1(l0, w.x); DOT1(l1, w.y); DOT1(l2, w.z); DOT1(l3, w.w);
          lsum += (l0 + l1) + (l2 + l3); }
#undef DOT1
            }
            if (DIAG && DIAG_SEL == 1) tacc_ += (unsigned)clock64() - t0_;
            if (DIAG && DIAG_SEL == 2) t0_ = (unsigned)clock64();
            if (ms + 2 < NT) ISSUE(TILE_OF(ms + 2), (ms + 2) & 3);
            {
        const unsigned va = vfa + cur * 32768;
#define TRR(dst, off) asm volatile("ds_read_b64_tr_b16 %0, %1 offset:%2" : "=&v"(dst) : "v"(va), "n"(off) : "memory")
#define READ8(L, H, S) do { TRR(L[0], ((2 * (S)) * 4 + 0) * 512); TRR(H[0], ((2 * (S) + 1) * 4 + 0) * 512); TRR(L[1], ((2 * (S)) * 4 + 1) * 512); TRR(H[1], ((2 * (S) + 1) * 4 + 1) * 512); \
                        TRR(L[2], ((2 * (S)) * 4 + 2) * 512); TRR(H[2], ((2 * (S) + 1) * 4 + 2) * 512); TRR(L[3], ((2 * (S)) * 4 + 3) * 512); TRR(H[3], ((2 * (S) + 1) * 4 + 3) * 512); } while (0)
#define WAITV(N, L, H) asm volatile("s_waitcnt lgkmcnt(" #N ")" : "+v"(L[0]), "+v"(H[0]), "+v"(L[1]), "+v"(H[1]), "+v"(L[2]), "+v"(H[2]), "+v"(L[3]), "+v"(H[3]) :: "memory")
#define PV4(S, L, H) do { _Pragma("unroll") for (int cb = 0; cb < 4; ++cb) { const bf16x8 vf = __builtin_shufflevector(L[cb], H[cb], 0, 1, 2, 3, 4, 5, 6, 7); o[cb] = MFMA32(pk[S], vf, o[cb]); } } while (0)
#if DIAG_LIGHT
        s16x4 la[4], ha[4];
        READ8(la, ha, 0); WAITV(0, la, ha); PV4(0, la, ha); READ8(la, ha, 1); WAITV(0, la, ha); PV4(1, la, ha);
        READ8(la, ha, 2); WAITV(0, la, ha); PV4(2, la, ha); READ8(la, ha, 3); WAITV(0, la, ha); PV4(3, la, ha);
#else
        s16x4 la[4], ha[4], lb[4], hb[4];
        READ8(la, ha, 0); READ8(lb, hb, 1);
        WAITV(8, la, ha); PV4(0, la, ha);
        READ8(la, ha, 2);
        WAITV(8, lb, hb); PV4(1, lb, hb);
        READ8(lb, hb, 3);
        WAITV(8, la, ha); PV4(2, la, ha);
        WAITV(0, lb, hb); PV4(3, lb, hb);
#endif
#undef TRR
#undef READ8
#undef WAITV
#undef PV4
            }
            if (DIAG && DIAG_SEL == 2) tacc_ += (unsigned)clock64() - t0_;
            if (DIAG && DIAG_SEL == 3) t0_ = (unsigned)clock64();
            STEP_END(ms);
            if (DIAG && DIAG_SEL == 3) tacc_ += (unsigned)clock64() - t0_;
        }
        if (n_plain < NT) {
            if (4 < NT) ISSUE(TILE_OF(4), 0);
            if (4 < NT) asm volatile("s_waitcnt vmcnt(4)\n\ts_barrier" ::: "memory"); else asm volatile("s_waitcnt vmcnt(0)\n\ts_barrier" ::: "memory");
            f32x16 pA0, pA1, pB0, pB1;
            {
              const int t_ = TILE_OF(2); const LAS unsigned char* kq_ = kfb + ((2) & 3) * 32768;
              const bool right_ = t_ >= td0; const float xq_ = (float)(q0 + r - 64 * t_), ss2_ = right_ ? -slope2 : slope2; const float A0_ = -ss2_ * xq_ - mrun;
              bf16x8 qx_;
              { const unsigned u1 = cvtpk(A0_, 0.f) & 0xffffu; const float r1 = A0_ - __uint_as_float(u1 << 16);
                const unsigned u2 = cvtpk(r1, 0.f) & 0xffffu; const float r2 = r1 - __uint_as_float(u2 << 16);
                const unsigned u3 = cvtpk(r2, 0.f) & 0xffffu; const unsigned sgnm = right_ ? 0x80008000u : 0u;
                u32x4 w; w.x = (sl12 ^ sgnm) & himask; w.y = (((sl3 ^ sgnm) & 0xffffu) | (u1 << 16)) & himask; w.z = (u2 | (u3 << 16)) & himask; w.w = 0u; qx_ = __builtin_bit_cast(bf16x8, w); }
#pragma unroll
              for (int i = 0; i < 16; ++i) { pA0[i] = 0.f; pA1[i] = 0.f; }
              pA0 = MFMA32(kc0, qx_, pA0); pA1 = MFMA32(kc1, qx_, pA1);
#pragma unroll
              for (int kh = 0; kh < 2; ++kh) { const bf16x8 k00 = *(const LAS bf16x8*)(kq_ + (2 * kh) * 2048), k01 = *(const LAS bf16x8*)(kq_ + (2 * kh) * 2048 + 512), k10 = *(const LAS bf16x8*)(kq_ + (2 * kh + 1) * 2048), k11 = *(const LAS bf16x8*)(kq_ + (2 * kh + 1) * 2048 + 512);
                  pA0 = MFMA32(k00, qf[2 * kh], pA0); pA1 = MFMA32(k01, qf[2 * kh], pA1); pA0 = MFMA32(k10, qf[2 * kh + 1], pA0); pA1 = MFMA32(k11, qf[2 * kh + 1], pA1); }
            }

            for (int msb = 2; msb < NT; msb += 2) {
          { const int ms_ = (msb);
            if (ms_ + 1 < NT) {
            {
              const int t_ = TILE_OF(ms_ + 1); const LAS unsigned char* kq_ = kfb + ((ms_ + 1) & 3) * 32768;
              const bool right_ = t_ >= td0; const float xq_ = (float)(q0 + r - 64 * t_), ss2_ = right_ ? -slope2 : slope2; const float A0_ = -ss2_ * xq_ - mrun;
              bf16x8 qx_;
              { const unsigned u1 = cvtpk(A0_, 0.f) & 0xffffu; const float r1 = A0_ - __uint_as_float(u1 << 16);
                const unsigned u2 = cvtpk(r1, 0.f) & 0xffffu; const float r2 = r1 - __uint_as_float(u2 << 16);
                const unsigned u3 = cvtpk(r2, 0.f) & 0xffffu; const unsigned sgnm = right_ ? 0x80008000u : 0u;
                u32x4 w; w.x = (sl12 ^ sgnm) & himask; w.y = (((sl3 ^ sgnm) & 0xffffu) | (u1 << 16)) & himask; w.z = (u2 | (u3 << 16)) & himask; w.w = 0u; qx_ = __builtin_bit_cast(bf16x8, w); }
#pragma unroll
              for (int i = 0; i < 16; ++i) { pB0[i] = 0.f; pB1[i] = 0.f; }
              pB0 = MFMA32(kc0, qx_, pB0); pB1 = MFMA32(kc1, qx_, pB1);
#pragma unroll
              for (int kh = 0; kh < 2; ++kh) { const bf16x8 k00 = *(const LAS bf16x8*)(kq_ + (2 * kh) * 2048), k01 = *(const LAS bf16x8*)(kq_ + (2 * kh) * 2048 + 512), k10 = *(const LAS bf16x8*)(kq_ + (2 * kh + 1) * 2048), k11 = *(const LAS bf16x8*)(kq_ + (2 * kh + 1) * 2048 + 512);
                  pB0 = MFMA32(k00, qf[2 * kh], pB0); pB1 = MFMA32(k01, qf[2 * kh], pB1); pB0 = MFMA32(k10, qf[2 * kh + 1], pB0); pB1 = MFMA32(k11, qf[2 * kh + 1], pB1); }
            }
            }
            {
#pragma unroll
        for (int i = 0; i < 16; ++i) { pA0[i] = __builtin_amdgcn_exp2f(pA0[i]); pA1[i] = __builtin_amdgcn_exp2f(pA1[i]); }
        { u32x4 w; float l0 = 0.f, l1 = 0.f, l2 = 0.f, l3 = 0.f;
#define DOT1(acc, x) do { const unsigned x_ = (x); acc = __builtin_amdgcn_fdot2_f32_bf16(__builtin_bit_cast(bf16x2_t, x_), __builtin_bit_cast(bf16x2_t, 0x3f803f80u), acc, false); } while (0)
          w.x = cvtpk(pA0[0], pA0[1]); w.y = cvtpk(pA0[2], pA0[3]); w.z = cvtpk(pA0[4], pA0[5]); w.w = cvtpk(pA0[6], pA0[7]); pk[0] = __builtin_bit_cast(bf16x8, w); DOT1(l0, w.x); DOT1(l1, w.y); DOT1(l2, w.z); DOT1(l3, w.w);
          w.x = cvtpk(pA0[8], pA0[9]); w.y = cvtpk(pA0[10], pA0[11]); w.z = cvtpk(pA0[12], pA0[13]); w.w = cvtpk(pA0[14], pA0[15]); pk[1] = __builtin_bit_cast(bf16x8, w); DOT1(l0, w.x); DOT1(l1, w.y); DOT1(l2, w.z); DOT1(l3, w.w);
          w.x = cvtpk(pA1[0], pA1[1]); w.y = cvtpk(pA1[2], pA1[3]); w.z = cvtpk(pA1[4], pA1[5]); w.w = cvtpk(pA1[6], pA1[7]); pk[2] = __builtin_bit_cast(bf16x8, w); DOT1(l0, w.x); DOT1(l1, w.y); DOT1(l2, w.z); DOT1(l3, w.w);
          w.x = cvtpk(pA1[8], pA1[9]); w.y = cvtpk(pA1[10], pA1[11]); w.z = cvtpk(pA1[12], pA1[13]); w.w = cvtpk(pA1[14], pA1[15]); pk[3] = __builtin_bit_cast(bf16x8, w); DOT1(l0, w.x); DOT1(l1, w.y); DOT1(l2, w.z); DOT1(l3, w.w);
          lsum += (l0 + l1) + (l2 + l3); }
#undef DOT1
            }
            if (ms_ + 3 < NT) ISSUE(TILE_OF(ms_ + 3), (ms_ + 3) & 3);
            { const int cur = ms_ & 3;
        const unsigned va = vfa + cur * 32768;
#define TRR(dst, off) asm volatile("ds_read_b64_tr_b16 %0, %1 offset:%2" : "=&v"(dst) : "v"(va), "n"(off) : "memory")
#define READ8(L, H, S) do { TRR(L[0], ((2 * (S)) * 4 + 0) * 512); TRR(H[0], ((2 * (S) + 1) * 4 + 0) * 512); TRR(L[1], ((2 * (S)) * 4 + 1) * 512); TRR(H[1], ((2 * (S) + 1) * 4 + 1) * 512); \
                        TRR(L[2], ((2 * (S)) * 4 + 2) * 512); TRR(H[2], ((2 * (S) + 1) * 4 + 2) * 512); TRR(L[3], ((2 * (S)) * 4 + 3) * 512); TRR(H[3], ((2 * (S) + 1) * 4 + 3) * 512); } while (0)
#define WAITV(N, L, H) asm volatile("s_waitcnt lgkmcnt(" #N ")" : "+v"(L[0]), "+v"(H[0]), "+v"(L[1]), "+v"(H[1]), "+v"(L[2]), "+v"(H[2]), "+v"(L[3]), "+v"(H[3]) :: "memory")
#define PV4(S, L, H) do { _Pragma("unroll") for (int cb = 0; cb < 4; ++cb) { const bf16x8 vf = __builtin_shufflevector(L[cb], H[cb], 0, 1, 2, 3, 4, 5, 6, 7); o[cb] = MFMA32(pk[S], vf, o[cb]); } } while (0)
#if DIAG_LIGHT
        s16x4 la[4], ha[4];
        READ8(la, ha, 0); WAITV(0, la, ha); PV4(0, la, ha); READ8(la, ha, 1); WAITV(0, la, ha); PV4(1, la, ha);
        READ8(la, ha, 2); WAITV(0, la, ha); PV4(2, la, ha); READ8(la, ha, 3); WAITV(0, la, ha); PV4(3, la, ha);
#else
        s16x4 la[4], ha[4], lb[4], hb[4];
        READ8(la, ha, 0); READ8(lb, hb, 1);
        WAITV(8, la, ha); PV4(0, la, ha);
        READ8(la, ha, 2);
        WAITV(8, lb, hb); PV4(1, lb, hb);
        READ8(lb, hb, 3);
        WAITV(8, la, ha); PV4(2, la, ha);
        WAITV(0, lb, hb); PV4(3, lb, hb);
#endif
#undef TRR
#undef READ8
#undef WAITV
#undef PV4
            }
            if (ms_ + 3 < NT) asm volatile("s_waitcnt vmcnt(4) lgkmcnt(0)\n\ts_barrier" ::: "memory");
            else asm volatile("s_waitcnt vmcnt(0) lgkmcnt(0)\n\ts_barrier" ::: "memory");
          }

              if (msb + 1 < NT) {
          { const int ms_ = (msb + 1);
            if (ms_ + 1 < NT) {
            {
              const int t_ = TILE_OF(ms_ + 1); const LAS unsigned char* kq_ = kfb + ((ms_ + 1) & 3) * 32768;
              const bool right_ = t_ >= td0; const float xq_ = (float)(q0 + r - 64 * t_), ss2_ = right_ ? -slope2 : slope2; const float A0_ = -ss2_ * xq_ - mrun;
              bf16x8 qx_;
              { const unsigned u1 = cvtpk(A0_, 0.f) & 0xffffu; const float r1 = A0_ - __uint_as_float(u1 << 16);
                const unsigned u2 = cvtpk(r1, 0.f) & 0xffffu; const float r2 = r1 - __uint_as_float(u2 << 16);
                const unsigned u3 = cvtpk(r2, 0.f) & 0xffffu; const unsigned sgnm = right_ ? 0x80008000u : 0u;
                u32x4 w; w.x = (sl12 ^ sgnm) & himask; w.y = (((sl3 ^ sgnm) & 0xffffu) | (u1 << 16)) & himask; w.z = (u2 | (u3 << 16)) & himask; w.w = 0u; qx_ = __builtin_bit_cast(bf16x8, w); }
#pragma unroll
              for (int i = 0; i < 16; ++i) { pA0[i] = 0.f; pA1[i] = 0.f; }
              pA0 = MFMA32(kc0, qx_, pA0); pA1 = MFMA32(kc1, qx_, pA1);
#pragma unroll
              for (int kh = 0; kh < 2; ++kh) { const bf16x8 k00 = *(const LAS bf16x8*)(kq_ + (2 * kh) * 2048), k01 = *(const LAS bf16x8*)(kq_ + (2 * kh) * 2048 + 512), k10 = *(const LAS bf16x8*)(kq_ + (2 * kh + 1) * 2048), k11 = *(const LAS bf16x8*)(kq_ + (2 * kh + 1) * 2048 + 512);
                  pA0 = MFMA32(k00, qf[2 * kh], pA0); pA1 = MFMA32(k01, qf[2 * kh], pA1); pA0 = MFMA32(k10, qf[2 * kh + 1], pA0); pA1 = MFMA32(k11, qf[2 * kh + 1], pA1); }
            }
            }
            {
#pragma unroll
        for (int i = 0; i < 16; ++i) { pB0[i] = __builtin_amdgcn_exp2f(pB0[i]); pB1[i] = __builtin_amdgcn_exp2f(pB1[i]); }
        { u32x4 w; float l0 = 0.f, l1 = 0.f, l2 = 0.f, l3 = 0.f;
#define DOT1(acc, x) do { const unsigned x_ = (x); acc = __builtin_amdgcn_fdot2_f32_bf16(__builtin_bit_cast(bf16x2_t, x_), __builtin_bit_cast(bf16x2_t, 0x3f803f80u), acc, false); } while (0)
          w.x = cvtpk(pB0[0], pB0[1]); w.y = cvtpk(pB0[2], pB0[3]); w.z = cvtpk(pB0[4], pB0[5]); w.w = cvtpk(pB0[6], pB0[7]); pk[0] = __builtin_bit_cast(bf16x8, w); DOT1(l0, w.x); DOT1(l1, w.y); DOT1(l2, w.z); DOT1(l3, w.w);
          w.x = cvtpk(pB0[8], pB0[9]); w.y = cvtpk(pB0[10], pB0[11]); w.z = cvtpk(pB0[12], pB0[13]); w.w = cvtpk(pB0[14], pB0[15]); pk[1] = __builtin_bit_cast(bf16x8, w); DOT1(l0, w.x); DOT1(l1, w.y); DOT1(l2, w.z); DOT1(l3, w.w);
          w.x = cvtpk(pB1[0], pB1[1]); w.y = cvtpk(pB1[2], pB1[3]); w.z = cvtpk(pB1[4], pB1[5]); w.w = cvtpk(pB1[6], pB1[7]); pk[2] = __builtin_bit_cast(bf16x8, w); DOT1(l0, w.x); DOT1(l1, w.y); DOT1(l2, w.z); DOT1(l3, w.w);
          w.x = cvtpk(pB1[8], pB1[9]); w.y = cvtpk(pB1[10], pB1[11]); w.z = cvtpk(pB1[12], pB1[13]); w.w = cvtpk(pB1[14], pB1[15]); pk[3] = __builtin_bit_cast(bf16x8, w); DOT1(l0, w.x); DOT1(l1, w.y); DOT1(l2, w.z); DOT1(l3, w.w);
          lsum += (l0 + l1) + (l2 + l3); }
#undef DOT1
            }
            if (ms_ + 3 < NT) ISSUE(TILE_OF(ms_ + 3), (ms_ + 3) & 3);
            { const int cur = ms_ & 3;
        const unsigned va = vfa + cur * 32768;
#define TRR(dst, off) asm volatile("ds_read_b64_tr_b16 %0, %1 offset:%2" : "=&v"(dst) : "v"(va), "n"(off) : "memory")
#define READ8(L, H, S) do { TRR(L[0], ((2 * (S)) * 4 + 0) * 512); TRR(H[0], ((2 * (S) + 1) * 4 + 0) * 512); TRR(L[1], ((2 * (S)) * 4 + 1) * 512); TRR(H[1], ((2 * (S) + 1) * 4 + 1) * 512); \
                        TRR(L[2], ((2 * (S)) * 4 + 2) * 512); TRR(H[2], ((2 * (S) + 1) * 4 + 2) * 512); TRR(L[3], ((2 * (S)) * 4 + 3) * 512); TRR(H[3], ((2 * (S) + 1) * 4 + 3) * 512); } while (0)
#define WAITV(N, L, H) asm volatile("s_waitcnt lgkmcnt(" #N ")" : "+v"(L[0]), "+v"(H[0]), "+v"(L[1]), "+v"(H[1]), "+v"(L[2]), "+v"(H[2]), "+v"(L[3]), "+v"(H[3]) :: "memory")
#define PV4(S, L, H) do { _Pragma("unroll") for (int cb = 0; cb < 4; ++cb) { const bf16x8 vf = __builtin_shufflevector(L[cb], H[cb], 0, 1, 2, 3, 4, 5, 6, 7); o[cb] = MFMA32(pk[S], vf, o[cb]); } } while (0)
#if DIAG_LIGHT
        s16x4 la[4], ha[4];
        READ8(la, ha, 0); WAITV(0, la, ha); PV4(0, la, ha); READ8(la, ha, 1); WAITV(0, la, ha); PV4(1, la, ha);
        READ8(la, ha, 2); WAITV(0, la, ha); PV4(2, la, ha); READ8(la, ha, 3); WAITV(0, la, ha); PV4(3, la, ha);
#else
        s16x4 la[4], ha[4], lb[4], hb[4];
        READ8(la, ha, 0); READ8(lb, hb, 1);
        WAITV(8, la, ha); PV4(0, la, ha);
        READ8(la, ha, 2);
        WAITV(8, lb, hb); PV4(1, lb, hb);
        READ8(lb, hb, 3);
        WAITV(8, la, ha); PV4(2, la, ha);
        WAITV(0, lb, hb); PV4(3, lb, hb);
#endif
#undef TRR
#undef READ8
#undef WAITV
#undef PV4
            }
            if (ms_ + 3 < NT) asm volatile("s_waitcnt vmcnt(4) lgkmcnt(0)\n\ts_barrier" ::: "memory");
            else asm volatile("s_waitcnt vmcnt(0) lgkmcnt(0)\n\ts_barrier" ::: "memory");
          }

              }
            }
        }
        asm volatile("s_waitcnt lgkmcnt(0)\n\ts_barrier" ::: "memory");
    } else {
        __builtin_amdgcn_s_setprio(1);
        for (int ms = 0; ms <= NT; ++ms) {
            if (ms + 2 < NT) ISSUE(TILE_OF(ms + 2), (ms + 2) & 3);
            if (ms > 0) {
                const int cur = (ms - 1) & 3;
        const unsigned va = vfa + cur * 32768;
#define TRR(dst, off) asm volatile("ds_read_b64_tr_b16 %0, %1 offset:%2" : "=&v"(dst) : "v"(va), "n"(off) : "memory")
#define READ8(L, H, S) do { TRR(L[0], ((2 * (S)) * 4 + 0) * 512); TRR(H[0], ((2 * (S) + 1) * 4 + 0) * 512); TRR(L[1], ((2 * (S)) * 4 + 1) * 512); TRR(H[1], ((2 * (S) + 1) * 4 + 1) * 512); \
                        TRR(L[2], ((2 * (S)) * 4 + 2) * 512); TRR(H[2], ((2 * (S) + 1) * 4 + 2) * 512); TRR(L[3], ((2 * (S)) * 4 + 3) * 512); TRR(H[3], ((2 * (S) + 1) * 4 + 3) * 512); } while (0)
#define WAITV(N, L, H) asm volatile("s_waitcnt lgkmcnt(" #N ")" : "+v"(L[0]), "+v"(H[0]), "+v"(L[1]), "+v"(H[1]), "+v"(L[2]), "+v"(H[2]), "+v"(L[3]), "+v"(H[3]) :: "memory")
#define PV4(S, L, H) do { _Pragma("unroll") for (int cb = 0; cb < 4; ++cb) { const bf16x8 vf = __builtin_shufflevector(L[cb], H[cb], 0, 1, 2, 3, 4, 5, 6, 7); o[cb] = MFMA32(pk[S], vf, o[cb]); } } while (0)
#if DIAG_LIGHT
        s16x4 la[4], ha[4];
        READ8(la, ha, 0); WAITV(0, la, ha); PV4(0, la, ha); READ8(la, ha, 1); WAITV(0, la, ha); PV4(1, la, ha);
        READ8(la, ha, 2); WAITV(0, la, ha); PV4(2, la, ha); READ8(la, ha, 3); WAITV(0, la, ha); PV4(3, la, ha);
#else
        s16x4 la[4], ha[4], lb[4], hb[4];
        READ8(la, ha, 0); READ8(lb, hb, 1);
        WAITV(8, la, ha); PV4(0, la, ha);
        READ8(la, ha, 2);
        WAITV(8, lb, hb); PV4(1, lb, hb);
        READ8(lb, hb, 3);
        WAITV(8, la, ha); PV4(2, la, ha);
        WAITV(0, lb, hb); PV4(3, lb, hb);
#endif
#undef TRR
#undef READ8
#undef WAITV
#undef PV4
            }
            if (ms < NT) {
                const int t = TILE_OF(ms), cur = ms & 3;
        const LAS unsigned char* kc = kfb + cur * 32768;
#undef KA
#define KA(ks, kb) (*(const LAS bf16x8*)(kc + (ks) * 2048 + (kb) * 512))
        f32x16 p0, p1; float alpha = 1.0f;
        if (ms < 2) {
#pragma unroll
            for (int i = 0; i < 16; ++i) { p0[i] = 0.f; p1[i] = 0.f; }
#pragma unroll
            for (int kh = 0; kh < 2; ++kh) { const bf16x8 k00 = KA(2 * kh, 0), k01 = KA(2 * kh, 1), k10 = KA(2 * kh + 1, 0), k11 = KA(2 * kh + 1, 1);
                p0 = MFMA32(k00, qf[2 * kh], p0); p1 = MFMA32(k01, qf[2 * kh], p1); p0 = MFMA32(k10, qf[2 * kh + 1], p0); p1 = MFMA32(k11, qf[2 * kh + 1], p1); }
            const float dq = (float)(q0 + r - t * 64 - 4 * hi);
            float tmax = -1e30f;
#pragma unroll
            for (int i = 0; i < 16; ++i) {
                const float c0 = (float)((i & 3) + 8 * (i >> 2));
                p0[i] = __builtin_fmaf(-slope2, __builtin_fabsf(dq - c0), p0[i]);
                p1[i] = __builtin_fmaf(-slope2, __builtin_fabsf(dq - (c0 + 32.f)), p1[i]);
                tmax = fmaxf(tmax, fmaxf(p0[i], p1[i]));
            }
            tmax = fmaxf(tmax, __shfl_xor(tmax, 32));
            const float mnew = fmaxf(mrun, tmax); alpha = __builtin_amdgcn_exp2f(mrun - mnew); mrun = mnew;
#pragma unroll
            for (int i = 0; i < 16; ++i) { p0[i] -= mrun; p1[i] -= mrun; }
        } else {
            const bool right = t >= td0;
            const float xq = (float)(q0 + r - 64 * t), ss2 = right ? -slope2 : slope2;
            const float A0 = -ss2 * xq - mrun;
            bf16x8 qx;
            { const unsigned u1 = cvtpk(A0, 0.f) & 0xffffu; const float r1 = A0 - __uint_as_float(u1 << 16);
              const unsigned u2 = cvtpk(r1, 0.f) & 0xffffu; const float r2 = r1 - __uint_as_float(u2 << 16);
              const unsigned u3 = cvtpk(r2, 0.f) & 0xffffu;
              const unsigned sgnm = right ? 0x80008000u : 0u;
              u32x4 w; w.x = (sl12 ^ sgnm) & himask; w.y = (((sl3 ^ sgnm) & 0xffffu) | (u1 << 16)) & himask; w.z = (u2 | (u3 << 16)) & himask; w.w = 0u;
              qx = __builtin_bit_cast(bf16x8, w); }
#pragma unroll
            for (int i = 0; i < 16; ++i) { p0[i] = 0.f; p1[i] = 0.f; }
            p0 = MFMA32(kc0, qx, p0); p1 = MFMA32(kc1, qx, p1);
#pragma unroll
            for (int kh = 0; kh < 2; ++kh) { const bf16x8 k00 = KA(2 * kh, 0), k01 = KA(2 * kh, 1), k10 = KA(2 * kh + 1, 0), k11 = KA(2 * kh + 1, 1);
                p0 = MFMA32(k00, qf[2 * kh], p0); p1 = MFMA32(k01, qf[2 * kh], p1); p0 = MFMA32(k10, qf[2 * kh + 1], p0); p1 = MFMA32(k11, qf[2 * kh + 1], p1); }
            if (!nocheck) {
            float ma = __builtin_fmaxf(__builtin_fmaxf(p0[0], p0[1]), p1[0]), mb = __builtin_fmaxf(__builtin_fmaxf(p0[2], p0[3]), p1[1]);
            ma = __builtin_fmaxf(__builtin_fmaxf(ma, p1[2]), p1[3]);
#pragma unroll
            for (int i = 4; i < 16; i += 4) { ma = __builtin_fmaxf(__builtin_fmaxf(ma, p0[i]), p0[i + 1]); mb = __builtin_fmaxf(__builtin_fmaxf(mb, p0[i + 2]), p0[i + 3]);
                ma = __builtin_fmaxf(__builtin_fmaxf(ma, p1[i]), p1[i + 1]); mb = __builtin_fmaxf(__builtin_fmaxf(mb, p1[i + 2]), p1[i + 3]); }
            float tm = __builtin_fmaxf(ma, mb);
            { auto rr = __builtin_amdgcn_permlane32_swap(__float_as_uint(tm), __float_as_uint(tm), false, false); tm = __builtin_fmaxf(__uint_as_float(rr[0]), __uint_as_float(rr[1])); }
            if (__builtin_expect(__any(tm > ATT_THR), 0)) {
                const float dl = __builtin_fmaxf(tm, 0.f); alpha = __builtin_amdgcn_exp2f(-dl); mrun += dl;
#pragma unroll
                for (int i = 0; i < 16; ++i) { p0[i] -= dl; p1[i] -= dl; }
            }
            }
        }
        if (__any(alpha != 1.0f)) {
            lsum *= alpha;
            if (hi == 0) wsf[r] = alpha;
            asm volatile("s_waitcnt lgkmcnt(0)" ::: "memory");
#pragma unroll
            for (int i = 0; i < 16; ++i) { const float ai = wsf[crow(i, hi)];
#pragma unroll
                for (int cb = 0; cb < 4; ++cb) asm volatile("v_mul_f32 %0, %0, %1" : "+v"(o[cb][i]) : "v"(ai)); }
            asm volatile("s_waitcnt lgkmcnt(0)" ::: "memory");
        }
#pragma unroll
        for (int i = 0; i < 16; ++i) { p0[i] = __builtin_amdgcn_exp2f(p0[i]); p1[i] = __builtin_amdgcn_exp2f(p1[i]); }
        { u32x4 w; float l0 = 0.f, l1 = 0.f, l2 = 0.f, l3 = 0.f;
#define DOT1(acc, x) do { const unsigned x_ = (x); acc = __builtin_amdgcn_fdot2_f32_bf16(__builtin_bit_cast(bf16x2_t, x_), __builtin_bit_cast(bf16x2_t, 0x3f803f80u), acc, false); } while (0)
          w.x = cvtpk(p0[0], p0[1]); w.y = cvtpk(p0[2], p0[3]); w.z = cvtpk(p0[4], p0[5]); w.w = cvtpk(p0[6], p0[7]); pk[0] = __builtin_bit_cast(bf16x8, w); DOT1(l0, w.x); DOT1(l1, w.y); DOT1(l2, w.z); DOT1(l3, w.w);
          w.x = cvtpk(p0[8], p0[9]); w.y = cvtpk(p0[10], p0[11]); w.z = cvtpk(p0[12], p0[13]); w.w = cvtpk(p0[14], p0[15]); pk[1] = __builtin_bit_cast(bf16x8, w); DOT1(l0, w.x); DOT1(l1, w.y); DOT1(l2, w.z); DOT1(l3, w.w);
          w.x = cvtpk(p1[0], p1[1]); w.y = cvtpk(p1[2], p1[3]); w.z = cvtpk(p1[4], p1[5]); w.w = cvtpk(p1[6], p1[7]); pk[2] = __builtin_bit_cast(bf16x8, w); DOT1(l0, w.x); DOT1(l1, w.y); DOT1(l2, w.z); DOT1(l3, w.w);
          w.x = cvtpk(p1[8], p1[9]); w.y = cvtpk(p1[10], p1[11]); w.z = cvtpk(p1[12], p1[13]); w.w = cvtpk(p1[14], p1[15]); pk[3] = __builtin_bit_cast(bf16x8, w); DOT1(l0, w.x); DOT1(l1, w.y); DOT1(l2, w.z); DOT1(l3, w.w);
          lsum += (l0 + l1) + (l2 + l3); }
#undef DOT1
                STEP_END(ms);
            } else asm volatile("s_waitcnt lgkmcnt(0)\n\ts_barrier" ::: "memory");
        }
        __builtin_amdgcn_s_setprio(0);
    }
#undef STEP_END
    if (DIAG && wid == DIAG_WAVE && lane == 0 && *(const LAS unsigned*)(lds + 131072 + 256 + 2048 + 12) != 0u) { if (DIAG_SEL == 0) tacc_ = (unsigned)clock64() - t0_;
        unsigned* dg_ = (unsigned*)((unsigned char*)Kt - WS_K) + 3000; dg_[0] = tacc_ / (unsigned)NT; }
#undef TILE_OF
#undef ISSUE
    lsum += __shfl_xor(lsum, 32);
    float inv = 1.0f / lsum; if (map == 1) inv *= *(const LAS float*)(lds + 131072 + 256 + 2048 + 8);
    if (hi == 0) wsf[r] = inv;
    asm volatile("s_waitcnt lgkmcnt(0)" ::: "memory");
#pragma unroll
    for (int i = 0; i < 16; ++i) { const float si = wsf[crow(i, hi)];
#pragma unroll
        for (int cb = 0; cb < 4; ++cb) o[cb][i] *= si; }
    LAS float* xch = (LAS float*)lds + qs * 4096;
    if (map == 1) {
#pragma unroll
        for (int cb = 0; cb < 4; ++cb)
#pragma unroll
            for (int i = 0; i < 16; ++i) xch[(cb * 16 + i) * 64 + lane] = o[cb][i];
    }
    __syncthreads();
    if (map == 0) {
        float ss[16];
#pragma unroll
        for (int i = 0; i < 16; ++i) { ss[i] = 0.f;
#pragma unroll
            for (int cb = 0; cb < 4; ++cb) { o[cb][i] -= xch[(cb * 16 + i) * 64 + lane]; ss[i] += o[cb][i] * o[cb][i]; } }
#pragma unroll
        for (int i = 0; i < 16; ++i) {
#pragma unroll
            for (int sft = 1; sft < 32; sft <<= 1) ss[i] += __shfl_xor(ss[i], sft);
            ss[i] = post / sqrtf(ss[i] * (1.0f / V_DIM) + EPS);
        }
#pragma unroll
        for (int cb = 0; cb < 4; ++cb) { const float g = subg[cb * 32 + r];
#pragma unroll
            for (int i = 0; i < 16; ++i) ((GAS bf16*)ON)[(tokbase + q0 + crow(i, hi)) * (CONV_W + ATTN_W) + h * 128 + cb * 32 + r] = (bf16)f2bf(o[cb][i] * ss[i] * g); }
    }
    __syncthreads();
}

#define XB_TMO      128
#define XB_XCNT(j)  (256  + 64 * (j))
#define XB_XSUB(j)  (1280 + 64 * (j))
#define XB_XGEN(j)  (2304 + 64 * (j))
#define XB_TOP      3328
#define XB_TOPGEN   3392
#define XCD_BAR_WORDS 3456
#define XB_SPIN_CAP (1u << 18)

__device__ __forceinline__ unsigned xb_ld(unsigned* p)              { return __hip_atomic_load(p, __ATOMIC_RELAXED, __HIP_MEMORY_SCOPE_AGENT); }
__device__ __forceinline__ unsigned xb_add(unsigned* p, unsigned v) { return __hip_atomic_fetch_add(p, v, __ATOMIC_RELAXED, __HIP_MEMORY_SCOPE_AGENT); }
__device__ __forceinline__ unsigned xb_xcc_id() { return (unsigned)__builtin_amdgcn_s_getreg((3 << 11) | 20) & 0xFu; }
#define XB_SPIN(cond, bar) do { unsigned _sp = 0; while (cond) { __builtin_amdgcn_s_sleep(1); \
    if ((++_sp & 255u) == 0u) { if (xb_ld(&(bar)[XB_TMO])) break; if (_sp > XB_SPIN_CAP) { atomicAdd(&(bar)[XB_TMO], 1u); break; } } } } while (0)

struct XcdBarrier {
    unsigned* bar; unsigned x;
    volatile LAS unsigned* st;
};

__device__ __forceinline__ XcdBarrier xcd_barrier_post(unsigned* bar, volatile LAS unsigned* st) {
    XcdBarrier b; b.bar = bar; b.x = xb_xcc_id(); b.st = st;
    if (threadIdx.x == 0) (void)xb_add(&bar[XB_XCNT(b.x)], 1u);
    return b;
}
__device__ __forceinline__ void xcd_barrier_complete(unsigned* bar, unsigned x, unsigned& nloc, unsigned& nx) {
    const unsigned G = gridDim.x * gridDim.y * gridDim.z;
    unsigned sum, cnt, mine, sp = 0u;
    for (;;) {
        sum = 0u; cnt = 0u; mine = 0u;
#pragma unroll
        for (unsigned j = 0; j < 16; ++j) { const unsigned c = xb_ld(&bar[XB_XCNT(j)]); sum += c; cnt += (c > 0u) ? 1u : 0u; mine = (j == x) ? c : mine; }
        if (sum == G) break;
        __builtin_amdgcn_s_sleep(1);
        if ((++sp & 255u) == 0u) { if (xb_ld(&bar[XB_TMO])) break; if (sp > XB_SPIN_CAP) { atomicAdd(&bar[XB_TMO], 1u); break; } }
    }
    nloc = mine > 0u ? mine : 1u; nx = cnt > 0u ? cnt : 1u;
}

__device__ __forceinline__ void xcd_barrier(const XcdBarrier& b) {
    asm volatile("s_waitcnt vmcnt(0)" ::: "memory");
    __syncthreads();
    if (threadIdx.x == 0) {
        unsigned* bar = b.bar;
        __builtin_amdgcn_s_waitcnt(0);
        unsigned nloc = b.st[0], nx = b.st[1];
        if (nloc == 0u) { xcd_barrier_complete(bar, b.x, nloc, nx); b.st[0] = nloc; b.st[1] = nx; }
        const unsigned old = xb_add(&bar[XB_XSUB(b.x)], 1u);
        const unsigned gen = old / nloc;
        if (old + 1u == (gen + 1u) * nloc) {
            __builtin_amdgcn_fence(__ATOMIC_RELEASE, "agent");
            asm volatile("s_waitcnt vmcnt(0)" ::: "memory");
            const unsigned og = xb_add(&bar[XB_TOP], 1u);
            const unsigned tg = og / nx;
            if (og + 1u == (tg + 1u) * nx) xb_add(&bar[XB_TOPGEN], 1u);
            else XB_SPIN(xb_ld(&bar[XB_TOPGEN]) == tg, bar);
            __builtin_amdgcn_fence(__ATOMIC_ACQUIRE, "agent");
            xb_add(&bar[XB_XGEN(b.x)], 1u);
            asm volatile("s_waitcnt vmcnt(0)" ::: "memory");
        } else {
            XB_SPIN(xb_ld(&bar[XB_XGEN(b.x)]) == gen, bar);
            __builtin_amdgcn_fence(__ATOMIC_ACQUIRE, "agent");
            asm volatile("s_waitcnt vmcnt(0)" ::: "memory");
        }
    }
    __syncthreads();
}


#ifndef REP_ATT
#define REP_ATT 1
#endif
#ifndef REP_GEMM
#define REP_GEMM 1
#endif
#ifndef PHM
#define PHM 127
#endif
__global__ void __launch_bounds__(512) mk_fwd(Args a) {
    extern __shared__ __attribute__((aligned(16))) unsigned char lds_raw[];
    LAS unsigned char* lds = (LAS unsigned char*)lds_raw;
    const int G = gridDim.x, bx = blockIdx.x;
    volatile LAS unsigned* MISC = (volatile LAS unsigned*)(lds + 131072 + 64);
    if (threadIdx.x < 4) MISC[threadIdx.x] = 0u;
    __syncthreads();
    XcdBarrier xbar = xcd_barrier_post((unsigned*)(a.ws + WS_CTL) + 4096, MISC);
    for (int p = a.ph_lo; p < a.ph_hi; ++p) {
        const int l = p >> 3, k = p & 7;
        int tid_ = threadIdx.x; asm volatile("" : "+v"(tid_));
        const int tid = tid_, wave = __builtin_amdgcn_readfirstlane(tid >> 6);
#define FRESH_LANE() ({ int t_ = threadIdx.x; asm volatile("" : "+v"(t_)); t_ & 63; })
        const int gw = bx * 8 + wave, NGW = G * 8;
    unsigned char* ws = a.ws; asm volatile("" : "+s"(ws));
    bf16* U = (bf16*)(ws + WS_U); bf16* CONV = (bf16*)(ws + WS_CONV); bf16* Qb = (bf16*)(ws + WS_Q); bf16* Kt = (bf16*)(ws + WS_K); bf16* Vt = (bf16*)(ws + WS_V);
    bf16* Gt = (bf16*)(ws + WS_G); bf16* Z = (bf16*)(ws + WS_Z); bf16* ON = Z + CONV_W;   bf16* MO = (bf16*)(ws + WS_MO);
    bf16* Ah = (bf16*)(ws + WS_A); bf16* Fo = (bf16*)(ws + WS_F); bf16* MERGED = U;
    const unsigned char* wb = ws + WS_W;
    float* hbuf = a.out;
    const float* norm_g = a.in[9];
        unsigned* ctl = (unsigned*)(ws + WS_CTL);
        if ((PHM & 1) && k == 0) {
            if (l < DEPTH) convert_weights(a, l, lds, gw, NGW, wave, FRESH_LANE());
            if (l == 0) row_phase<false, true>(a.in[0], nullptr, nullptr, hbuf, norm_g + (size_t)(0 * 4 + 0) * D_MODEL, U, gw, NGW, FRESH_LANE());
            else if (l < DEPTH) row_phase<true, true>(hbuf, Fo, norm_g + (size_t)((l - 1) * 4 + 3) * D_MODEL, hbuf, norm_g + (size_t)(l * 4 + 0) * D_MODEL, U, gw, NGW, FRESH_LANE());
            else row_phase<true, false>(hbuf, Fo, norm_g + (size_t)((l - 1) * 4 + 3) * D_MODEL, hbuf, nullptr, nullptr, gw, NGW, FRESH_LANE());
            if (DIAG && l == DEPTH) { __syncthreads(); if (bx == 0 && tid == 0) hbuf[0] += (float)ctl[3000] * DIAG_SCALE; }
        } else if ((PHM & 2) && k == 1) {
            pg8::Gemm g{U, (const bf16*)(wb + W_IN_OFF), M, IN_W, D_MODEL}; pg8::StaticOrder S; S.init(M, IN_W, G, bx);
            pg8::EpiWin E{CONV, Qb, Kt, Vt, Gt, a.in[2] + (size_t)l * 2 * D_MODEL, 0.125f * LOG2E, ctl + 1024 + l * 64};
            for (int rep = 0; rep < REP_GEMM; ++rep) pg8::gemm_phase<pg8::EpiWin, pg8::StaticOrder, true, true>(lds, g, S, E);
        } else if ((PHM & 4) && k == 2) {
            const float lam_init = 0.8f - 0.6f * expf(-0.3f * (float)l);
            const float* lq = a.in[5] + (size_t)l * 4 * HEAD_DIM;
            const int ln_ = FRESH_LANE(); const float s1 = wave_sum(lq[ln_] * lq[64 + ln_]), s2 = wave_sum(lq[128 + ln_] * lq[192 + ln_]);
            const float lam = expf(s1) - expf(s2) + lam_init;
            const float* subg = a.in[6] + (size_t)l * V_DIM;
            LAS unsigned* sq = (LAS unsigned*)(lds + 131072 + 256 + 2048);
            if (tid == 0) *(LAS float*)(lds + 131072 + 256 + 2048 + 8) = lam;
            const unsigned* nq = ctl + 1024 + l * 64; const unsigned* nk = nq + 32;
            for (int rep = 0; rep < REP_ATT; ++rep)
            for (;;) {
                __syncthreads();
                if (tid == 0) sq[0] = atomicAdd(ctl + l * 64 + rep * 16, 1u);
                __syncthreads();
                const int u = (int)sq[0];
                if (u >= 512) {
                    const int v = u - 512;
                    if (v < M / 64) { conv_items(CONV, a.in[3] + (size_t)l * 3 * CONV_W, Z, v * 8 + wave, v * 8 + 8, 8, FRESH_LANE()); continue; }
                    break; }
                const int h = 3 - (u >> 7), idx = u & 127, b = idx & 1, jj = idx >> 1, qb = (jj & 1) ? 31 - (jj >> 1) : 32 + (jj >> 1);
                const float slope2 = exp2f(-2.0f * (float)(h + 1)) * LOG2E;
                const unsigned* wq = nq + (b * 4 + h) * 4; const unsigned* wk = nk + (b * 4 + h) * 4;
                const float kn0 = __uint_as_float(wk[0]) + __uint_as_float(wk[1]), kn1 = __uint_as_float(wk[2]) + __uint_as_float(wk[3]);
                if (DIAG && tid == 0) sq[3] = (u == 0) ? 1u : 0u;
                attn_unit(b, h, qb, kn0, kn1, Qb, Kt, Vt, ON, lds, slope2, subg, 1.0f - lam_init);
            }
        } else if ((PHM & 8) && k == 3) {
            pg8::Gemm g{Z, (const bf16*)(wb + W_CO_OFF), M, D_MODEL, CONV_W + ATTN_W}; pg8::StaticOrder S; S.init(M, D_MODEL, G, bx);
            pg8::EpiMerge E{Gt, MERGED};
            for (int rep = 0; rep < REP_GEMM; ++rep) pg8::gemm_phase<pg8::EpiMerge, pg8::StaticOrder, true, true>(lds, g, S, E);
        } else if ((PHM & 16) && (k == 4 || k == 7)) {
            const bool ff = (k == 7);
            pg8::Gemm g{ff ? Ah : MERGED, (const bf16*)(wb + (ff ? W_F2_OFF : W_O_OFF)), M, D_MODEL, ff ? D_FF : D_MODEL}; pg8::StaticOrder S; S.init(M, D_MODEL, G, bx);
            pg8::EpiBf16P E{ff ? Fo : MO, D_MODEL};
            for (int rep = 0; rep < REP_GEMM; ++rep) pg8::gemm_phase<pg8::EpiBf16P, pg8::StaticOrder, true, true>(lds, g, S, E);
        } else if ((PHM & 32) && k == 5) {
            row_phase<true, true>(hbuf, MO, norm_g + (size_t)(l * 4 + 1) * D_MODEL, hbuf, norm_g + (size_t)(l * 4 + 2) * D_MODEL, U, gw, NGW, FRESH_LANE());
        } else if ((PHM & 64) && k == 6) {
            pg8::Gemm g{U, (const bf16*)(wb + W_F1_OFF), M, D_FF, D_MODEL}; pg8::StaticOrder S; S.init(M, D_FF, G, bx);
            pg8::EpiRelu2 E{Ah, D_FF};
            for (int rep = 0; rep < REP_GEMM; ++rep) pg8::gemm_phase<pg8::EpiRelu2, pg8::StaticOrder, true, true>(lds, g, S, E);
        }
        if (p + 1 < a.ph_hi) {
            if (a.ph_lo < 0) cg::this_grid().sync();
            xcd_barrier(xbar);
        }
    }
}

constexpr int N_PHASES = DEPTH * 8 + 1;
#ifndef MK_MULTI
#define MK_MULTI 0
#endif

extern "C" void kernel_launch(void* const* d_in, const int* in_sizes, int n_in, void* d_out, int out_size, void* d_ws, size_t ws_size, hipStream_t stream) {
    static int grid = 0;
    if (grid == 0) {
        if (n_in != 12 || out_size != M * D_MODEL || ws_size < WS_END) { fprintf(stderr, "kernel_launch: unexpected shapes (n_in %d out %d ws %zu)\n", n_in, out_size, ws_size); grid = -1; return; }
        int dev = 0, cus = 0, per_cu = 0;
        hipGetDevice(&dev); hipDeviceGetAttribute(&cus, hipDeviceAttributeMultiprocessorCount, dev);
        hipFuncSetAttribute((const void*)mk_fwd, hipFuncAttributeMaxDynamicSharedMemorySize, LDS_BYTES);
        hipOccupancyMaxActiveBlocksPerMultiprocessor(&per_cu, (const void*)mk_fwd, 512, LDS_BYTES);
        (void)hipGetLastError();
        if (per_cu < 1) per_cu = 1;
        grid = cus * 1;
        if (grid != 256) fprintf(stderr, "kernel_launch: note: %d CUs\n", grid);
    }
    if (grid < 0) return;
    Args a{};
    for (int i = 0; i < 12; ++i) a.in[i] = (const float*)d_in[i];
    a.out = (float*)d_out; a.ws = (unsigned char*)d_ws;
#if MK_MULTI
    for (int p = 0; p < N_PHASES; ++p) {
        a.ph_lo = p; a.ph_hi = p + 1;
        hipLaunchKernelGGL(mk_fwd, dim3(grid), dim3(512), LDS_BYTES, stream, a);
    }
#else
    a.ph_lo = 0; a.ph_hi = N_PHASES;
    if (hipMemsetAsync((char*)d_ws + WS_CTL, 0, 8192 * 4, stream) != hipSuccess) { fprintf(stderr, "kernel_launch: hipMemsetAsync failed\n"); return; }
    void* args[] = {&a};
    hipError_t e = hipLaunchCooperativeKernel((const void*)mk_fwd, dim3(grid), dim3(512), args, LDS_BYTES, stream);
    if (e != hipSuccess) fprintf(stderr, "cooperative launch failed: %s (grid %d)\n", hipGetErrorString(e), grid);
#endif
}
```
